# Optimizing an MI355X kernel written in HIP

```python
import math
import jax
import jax.numpy as jnp
from jax import lax
import numpy as np


D_MODEL = 1024
BATCH = 16
SEQ = 256
DEPTH = 2
DEC_BATCH = 2
DEC_SEQ = 1024
PAST_LEN = 512

GRID_W = 64
D_MIX = D_MODEL
CHUNK = 128
N_DIR = 2
EPS = 1e-6
SSD_INNER = D_MIX // 2
SSD_HEAD_DIM = 64
SSD_HEADS = SSD_INNER // SSD_HEAD_DIM
SSD_GROUPS = 2
SSD_STATE = 128
SSD_CONV = 5
SSD_CONV_DIM = SSD_INNER + 2 * SSD_GROUPS * SSD_STATE
SGU_DIM = D_MIX // 4
SGU_HEADS = 4
SGU_HEAD_DIM = SGU_DIM // SGU_HEADS
S5_DIM = D_MIX // 4
S5_GROUP_CH = 16
S5_GROUPS = S5_DIM // S5_GROUP_CH
S5_STATE = 64
D_FF = 4 * D_MODEL
OFF_Z = 0
OFF_XBC = OFF_Z + SSD_INNER
OFF_DT = OFF_XBC + SSD_CONV_DIM
OFF_SGU = OFF_DT + N_DIR * SSD_HEADS
OFF_S5 = OFF_SGU + 2 * SGU_DIM
IN_DIM = OFF_S5 + S5_DIM

kernel_name = 'hybrid_ssd_sgu_s5_diffusion_step'


def rmsnorm(x, g):
    xf = x.astype(jnp.float32)
    y = xf * lax.rsqrt(jnp.mean(xf * xf, axis=-1, keepdims=True) + EPS)
    return (y * g.astype(jnp.float32)).astype(x.dtype)


def centred_depthwise_conv(x, w, b):
    pad = (SSD_CONV - 1) // 2
    y = lax.conv_general_dilated(x, w[:, None, :], window_strides=(1,), padding=[(pad, pad)],
                                 dimension_numbers=('NWC', 'WIO', 'NWC'),
                                 feature_group_count=x.shape[-1])
    return y + b


def ssd_scan(x, dt, a, bm, cm, h0):
    b_, L, H, P = x.shape
    nc = L // CHUNK
    R = H // SSD_GROUPS
    x = x.reshape(b_, nc, CHUNK, SSD_GROUPS, R, P)
    dt = dt.reshape(b_, nc, CHUNK, SSD_GROUPS, R)
    bm = bm.reshape(b_, nc, CHUNK, SSD_GROUPS, SSD_STATE)
    cm = cm.reshape(b_, nc, CHUNK, SSD_GROUPS, SSD_STATE)
    a_cum = jnp.cumsum(dt * a.reshape(SSD_GROUPS, R), axis=2)
    xdt = x * dt[..., None]
    seg = a_cum[:, :, :, None] - a_cum[:, :, None, :]
    lower = jnp.tril(jnp.ones((CHUNK, CHUNK), dtype=bool))[:, :, None, None]
    lmat = jnp.exp(jnp.where(lower, seg, -jnp.inf))
    cb = jnp.einsum('bcqgn,bckgn->bcqkg', cm, bm)
    y_diag = jnp.einsum('bcqkg,bcqkgr,bckgrp->bcqgrp', cb, lmat, xdt)
    decay_to_end = jnp.exp(a_cum[:, :, -1:] - a_cum)
    chunk_states = jnp.einsum('bckgn,bckgr,bckgrp->bcgrpn', bm, decay_to_end, xdt)
    chunk_decay = jnp.exp(a_cum[:, :, -1])

    def step(h, inp):
        dec, st = inp
        return dec[..., None, None] * h + st, h

    h_final, h_prev = lax.scan(step, h0.reshape(b_, SSD_GROUPS, R, P, SSD_STATE),
                               (jnp.moveaxis(chunk_decay, 1, 0), jnp.moveaxis(chunk_states, 1, 0)))
    h_prev = jnp.moveaxis(h_prev, 0, 1)
    y_off = jnp.einsum('bcqgn,bcgrpn,bcqgr->bcqgrp', cm, h_prev, jnp.exp(a_cum))
    y = (y_diag + y_off).reshape(b_, L, H, P)
    return y, h_final.reshape(b_, H, P, SSD_STATE)


def ssd_mixer(s, p, h0):
    dtype = s.dtype
    b_, L, _ = s.shape
    f32 = jnp.float32
    z = s[..., OFF_Z:OFF_XBC]
    xbc = jax.nn.silu(centred_depthwise_conv(s[..., OFF_XBC:OFF_DT], p['ssd_conv_w'], p['ssd_conv_b'])).astype(f32)
    gn = SSD_GROUPS * SSD_STATE
    xs = xbc[..., :SSD_INNER].reshape(b_, L, SSD_HEADS, SSD_HEAD_DIM)
    bm = xbc[..., SSD_INNER:SSD_INNER + gn].reshape(b_, L, SSD_GROUPS, SSD_STATE)
    cm = xbc[..., SSD_INNER + gn:].reshape(b_, L, SSD_GROUPS, SSD_STATE)
    dt = jax.nn.softplus(s[..., OFF_DT:OFF_SGU].astype(f32).reshape(b_, L, N_DIR, SSD_HEADS)
                         + p['ssd_dt_bias'].astype(f32))
    a = -jnp.exp(p['ssd_a_log'].astype(f32))
    flip = lambda t: jnp.flip(t, axis=1)
    y_f, h_f = ssd_scan(xs, dt[:, :, 0], a[0], bm, cm, h0[:, 0])
    y_b, h_b = ssd_scan(flip(xs), flip(dt[:, :, 1]), a[1], flip(bm), flip(cm), h0[:, 1])
    y = y_f + flip(y_b) + p['ssd_d'].astype(f32)[:, None] * xs
    y = y.reshape(b_, L, SSD_INNER) * jax.nn.silu(z.astype(f32))
    y = rmsnorm(y, p['ssd_norm_g']).astype(dtype)
    return y, jnp.stack([h_f, h_b], axis=1)


def sgu_mixer(uv, p):
    uv = jax.nn.gelu(uv)
    u, v = uv[..., :SGU_DIM], uv[..., SGU_DIM:]
    v = rmsnorm(v, p['sgu_norm_g'])
    b_, L, _ = v.shape
    v = v.reshape(b_, L // CHUNK, CHUNK, SGU_HEADS, SGU_HEAD_DIM)
    mix = (jnp.einsum('hqk,bckhd->bcqhd', p['sgu_w'], v)
           + jnp.swapaxes(p['sgu_b'], 0, 1)[None, None, :, :, None])
    return u * mix.reshape(b_, L, SGU_DIM)


def to_col_major(u):
    b_, L, C = u.shape
    rows = L // GRID_W
    return u.reshape(b_, rows, GRID_W, C).transpose(0, 2, 1, 3).reshape(b_, L, C)


def from_col_major(u):
    b_, L, C = u.shape
    rows = L // GRID_W
    return u.reshape(b_, GRID_W, rows, C).transpose(0, 2, 1, 3).reshape(b_, L, C)


def s5_scan(bu, lam_bar, h0):
    a = jnp.broadcast_to(lam_bar, bu.shape)

    def combine(left, right):
        a_l, b_l = left
        a_r, b_r = right
        return a_r * a_l, a_r * b_l + b_r

    a_cum, b_cum = lax.associative_scan(combine, (a, bu), axis=1)
    h = a_cum * h0[:, None] + b_cum
    return h, h[:, -1]


def s5_mixer(u, p, h0, column_major):
    dtype = u.dtype
    f32 = jnp.float32
    if column_major:
        u = to_col_major(u)
    b_, L, _ = u.shape
    uf = u.astype(f32).reshape(b_, L, S5_GROUPS, S5_GROUP_CH)
    b_mat = lax.complex(p['s5_b_re'].astype(f32), p['s5_b_im'].astype(f32))
    c_mat = lax.complex(p['s5_c_re'].astype(f32), p['s5_c_im'].astype(f32))
    h_sum = 0.0
    finals = []
    for d in range(N_DIR):
        lam = lax.complex(p['s5_lambda_re'][d].astype(f32), p['s5_lambda_im'][d].astype(f32))
        step = jnp.exp(p['s5_log_dt'][d].astype(f32))[:, None]
        lam_bar = jnp.exp(lam * step)
        b_bar = ((lam_bar - 1.0) / lam)[..., None] * b_mat
        u_d = uf if d == 0 else jnp.flip(uf, axis=1)
        bu = jnp.einsum('gsc,blgc->blgs', b_bar, u_d.astype(jnp.complex64))
        h, h_last = s5_scan(bu, lam_bar, h0[:, d])
        h_sum = h_sum + (h if d == 0 else jnp.flip(h, axis=1))
        finals.append(h_last)
    y = jnp.real(jnp.einsum('gcs,blgs->blgc', c_mat, h_sum))
    y = y + p['s5_d'].astype(f32).reshape(S5_GROUPS, S5_GROUP_CH) * uf
    y = jax.nn.gelu(y.reshape(b_, L, S5_DIM))
    y = y * jax.nn.sigmoid(y @ p['s5_glu_w'].astype(f32) + p['s5_glu_b'].astype(f32))
    y = y.astype(dtype)
    if column_major:
        y = from_col_major(y)
    return y, jnp.stack(finals, axis=1)


def trunk_layer(x, mod, p, h0_ssd, h0_s5, latent):
    shift1, scale1, gate1, shift2, scale2, gate2 = jnp.split(mod, 6, axis=-1)
    h = rmsnorm(x, p['norm1_g']) * (1 + scale1) + shift1
    proj = h @ p['w_in']
    y_ssd, hs_ssd = ssd_mixer(proj[..., :OFF_SGU], p, h0_ssd)
    y_sgu = sgu_mixer(proj[..., OFF_SGU:OFF_S5], p)
    y_s5, hs_s5 = s5_mixer(proj[..., OFF_S5:], p, h0_s5, latent)
    mixed = jnp.concatenate([y_ssd, y_sgu, y_s5], axis=-1)
    x = x + gate1 * (mixed @ p['w_out'])
    h = rmsnorm(x, p['norm2_g']) * (1 + scale2) + shift2
    x = x + gate2 * (jnp.square(jax.nn.relu(h @ p['ffn_w1'])) @ p['ffn_w2'])
    return x, hs_ssd, hs_s5


def setup_inputs(seed: int = 0) -> dict:
    key = jax.random.key(seed)
    ks = iter(jax.random.split(key, 48))
    f32 = jnp.float32

    def nrm(shape, scale):
        return scale * jax.random.normal(next(ks), shape, f32)

    lo, hi = math.log(1e-3), math.log(1e-1)
    x_prompt = nrm((BATCH, SEQ, D_MODEL), 1.0)
    x_sample = nrm((DEC_BATCH, DEC_SEQ, D_MODEL), 1.0)
    state_ssd = nrm((DEC_BATCH, DEPTH, N_DIR, SSD_HEADS, SSD_HEAD_DIM, SSD_STATE), 0.5)
    state_s5_re = nrm((DEC_BATCH, DEPTH, N_DIR, S5_GROUPS, S5_STATE), 0.5)
    state_s5_im = nrm((DEC_BATCH, DEPTH, N_DIR, S5_GROUPS, S5_STATE), 0.5)
    c = nrm((DEC_BATCH, D_MODEL), 1.0)
    c_ctx = nrm((D_MODEL,), 1.0)
    ada_w = nrm((DEPTH, D_MODEL, 6 * D_MODEL), 0.3 * D_MODEL ** -0.5)
    ada_b = nrm((DEPTH, 6 * D_MODEL), 0.01)
    norm1_g = 1.0 + nrm((DEPTH, D_MODEL), 0.01)
    norm2_g = 1.0 + nrm((DEPTH, D_MODEL), 0.01)
    w_in = nrm((DEPTH, D_MODEL, IN_DIM), D_MODEL ** -0.5)
    ssd_conv_w = nrm((DEPTH, SSD_CONV, SSD_CONV_DIM), SSD_CONV ** -0.5)
    ssd_conv_b = nrm((DEPTH, SSD_CONV_DIM), 0.01)
    dt0 = jnp.exp(jax.random.uniform(next(ks), (DEPTH, N_DIR, SSD_HEADS), f32, lo, hi))
    ssd_dt_bias = dt0 + jnp.log(-jnp.expm1(-dt0))
    ssd_a_log = jnp.log(jax.random.uniform(next(ks), (DEPTH, N_DIR, SSD_HEADS), f32, 1.0, 16.0))
    ssd_d = 1.0 + nrm((DEPTH, SSD_HEADS), 0.01)
    ssd_norm_g = 1.0 + nrm((DEPTH, SSD_INNER), 0.01)
    sgu_norm_g = 1.0 + nrm((DEPTH, SGU_DIM), 0.01)
    sgu_w = nrm((DEPTH, SGU_HEADS, CHUNK, CHUNK), CHUNK ** -0.5)
    sgu_b = 1.0 + nrm((DEPTH, SGU_HEADS, CHUNK), 0.01)
    s5_lambda_re = -0.5 + nrm((DEPTH, N_DIR, S5_GROUPS, S5_STATE), 0.01)
    s5_lambda_im = math.pi * jnp.arange(S5_STATE, dtype=f32) + nrm((DEPTH, N_DIR, S5_GROUPS, S5_STATE), 0.01)
    s5_log_dt = jax.random.uniform(next(ks), (DEPTH, N_DIR, S5_GROUPS), f32, lo, hi)
    s5_b_re = nrm((DEPTH, S5_GROUPS, S5_STATE, S5_GROUP_CH), (2 * S5_GROUP_CH) ** -0.5)
    s5_b_im = nrm((DEPTH, S5_GROUPS, S5_STATE, S5_GROUP_CH), (2 * S5_GROUP_CH) ** -0.5)
    s5_c_re = nrm((DEPTH, S5_GROUPS, S5_GROUP_CH, S5_STATE), (2 * S5_STATE) ** -0.5)
    s5_c_im = nrm((DEPTH, S5_GROUPS, S5_GROUP_CH, S5_STATE), (2 * S5_STATE) ** -0.5)
    s5_d = nrm((DEPTH, S5_DIM), 1.0)
    s5_glu_w = nrm((DEPTH, S5_DIM, S5_DIM), S5_DIM ** -0.5)
    s5_glu_b = nrm((DEPTH, S5_DIM), 0.01)
    w_out = nrm((DEPTH, D_MIX, D_MODEL), D_MIX ** -0.5)
    ffn_w1 = nrm((DEPTH, D_MODEL, D_FF), D_MODEL ** -0.5)
    ffn_w2 = nrm((DEPTH, D_FF, D_MODEL), D_FF ** -0.5)
    final_norm_g = 1.0 + nrm((D_MODEL,), 0.01)
    return {'x_prompt': x_prompt, 'x_sample': x_sample, 'state_ssd': state_ssd,
            'state_s5_re': state_s5_re, 'state_s5_im': state_s5_im, 'c': c, 'c_ctx': c_ctx,
            'ada_w': ada_w, 'ada_b': ada_b, 'norm1_g': norm1_g, 'norm2_g': norm2_g, 'w_in': w_in,
            'ssd_conv_w': ssd_conv_w, 'ssd_conv_b': ssd_conv_b, 'ssd_dt_bias': ssd_dt_bias,
            'ssd_a_log': ssd_a_log, 'ssd_d': ssd_d, 'ssd_norm_g': ssd_norm_g,
            'sgu_norm_g': sgu_norm_g, 'sgu_w': sgu_w, 'sgu_b': sgu_b,
            's5_lambda_re': s5_lambda_re, 's5_lambda_im': s5_lambda_im, 's5_log_dt': s5_log_dt,
            's5_b_re': s5_b_re, 's5_b_im': s5_b_im, 's5_c_re': s5_c_re, 's5_c_im': s5_c_im,
            's5_d': s5_d, 's5_glu_w': s5_glu_w, 's5_glu_b': s5_glu_b, 'w_out': w_out,
            'ffn_w1': ffn_w1, 'ffn_w2': ffn_w2, 'final_norm_g': final_norm_g}


def reference(x_prompt, x_sample, state_ssd, state_s5_re, state_s5_im, c, c_ctx,
              ada_w, ada_b, norm1_g, norm2_g, w_in, ssd_conv_w, ssd_conv_b, ssd_dt_bias,
              ssd_a_log, ssd_d, ssd_norm_g, sgu_norm_g, sgu_w, sgu_b,
              s5_lambda_re, s5_lambda_im, s5_log_dt, s5_b_re, s5_b_im, s5_c_re, s5_c_im,
              s5_d, s5_glu_w, s5_glu_b, w_out, ffn_w1, ffn_w2, final_norm_g):
    f32 = jnp.float32

    def params_of(l):
        return dict(norm1_g=norm1_g[l], norm2_g=norm2_g[l], w_in=w_in[l],
                    ssd_conv_w=ssd_conv_w[l], ssd_conv_b=ssd_conv_b[l], ssd_dt_bias=ssd_dt_bias[l],
                    ssd_a_log=ssd_a_log[l], ssd_d=ssd_d[l], ssd_norm_g=ssd_norm_g[l],
                    sgu_norm_g=sgu_norm_g[l], sgu_w=sgu_w[l], sgu_b=sgu_b[l],
                    s5_lambda_re=s5_lambda_re[l], s5_lambda_im=s5_lambda_im[l], s5_log_dt=s5_log_dt[l],
                    s5_b_re=s5_b_re[l], s5_b_im=s5_b_im[l], s5_c_re=s5_c_re[l], s5_c_im=s5_c_im[l],
                    s5_d=s5_d[l], s5_glu_w=s5_glu_w[l], s5_glu_b=s5_glu_b[l], w_out=w_out[l],
                    ffn_w1=ffn_w1[l], ffn_w2=ffn_w2[l])

    bp = x_prompt.shape[0]
    x = x_prompt
    ctx_ssd, ctx_s5 = [], []
    zero_ssd = jnp.zeros((bp, N_DIR, SSD_HEADS, SSD_HEAD_DIM, SSD_STATE), f32)
    zero_s5 = jnp.zeros((bp, N_DIR, S5_GROUPS, S5_STATE), jnp.complex64)
    for l in range(DEPTH):
        mod = (jax.nn.silu(c_ctx)[None, :] @ ada_w[l] + ada_b[l])[:, None, :]
        x, hs_ssd, hs_s5 = trunk_layer(x, mod, params_of(l), zero_ssd, zero_s5, False)
        ctx_ssd.append(hs_ssd)
        ctx_s5.append(hs_s5)
    y_prompt = rmsnorm(x, final_norm_g)
    new_state_ssd = jnp.stack(ctx_ssd, axis=1).astype(x_prompt.dtype)
    s5_all = jnp.stack(ctx_s5, axis=1)
    new_state_s5_re = jnp.real(s5_all).astype(x_prompt.dtype)
    new_state_s5_im = jnp.imag(s5_all).astype(x_prompt.dtype)

    x = x_sample
    for l in range(DEPTH):
        mod = (jax.nn.silu(c) @ ada_w[l] + ada_b[l])[:, None, :]
        h0_ssd = state_ssd[:, l].astype(f32)
        h0_s5 = lax.complex(state_s5_re[:, l].astype(f32), state_s5_im[:, l].astype(f32))
        x, _, _ = trunk_layer(x, mod, params_of(l), h0_ssd, h0_s5, True)
    y_sample = rmsnorm(x, final_norm_g)

    return (y_prompt, y_sample, new_state_ssd, new_state_s5_re, new_state_s5_im)
```

```cpp
#include <hip/hip_runtime.h>
#include <hip/hip_cooperative_groups.h>
#include <cstdio>
namespace cg = cooperative_groups;

#define DUP 0
#ifndef COOP
#define COOP 1
#endif

typedef unsigned short u16;
typedef __attribute__((ext_vector_type(8))) short bf16x8;
typedef __attribute__((ext_vector_type(4))) float f32x4;
typedef __attribute__((ext_vector_type(4))) unsigned int u32x4;
typedef __attribute__((ext_vector_type(2))) unsigned int u32x2;

constexpr int T_TOK = 6144;
constexpr int DM = 1024;
constexpr int IN_DIM = 2320;
constexpr int IN_PAD = 2432;
constexpr int DFF = 4096;
constexpr int SMEM_BYTES = 143360;

constexpr size_t OFF_WIN_T = 0;
constexpr size_t OFF_WOUT_T = OFF_WIN_T + (size_t)2 * IN_PAD * 1024 * 2;
constexpr size_t OFF_W1_T = OFF_WOUT_T + (size_t)2 * 1024 * 1024 * 2;
constexpr size_t OFF_W2_T = OFF_W1_T + (size_t)2 * 4096 * 1024 * 2;
constexpr size_t OFF_GLU_T = OFF_W2_T + (size_t)2 * 4096 * 1024 * 2;
constexpr size_t OFF_SGUW = OFF_GLU_T + (size_t)2 * 256 * 256 * 2;
constexpr size_t OFF_MOD = OFF_SGUW + (size_t)2 * 4 * 128 * 128 * 2;
constexpr size_t OFF_H = OFF_MOD + (size_t)2 * 3 * 6144 * 4;
constexpr size_t OFF_PROJ = OFF_H + (size_t)T_TOK * 1024 * 2;
constexpr size_t OFF_MIXED = OFF_PROJ + (size_t)T_TOK * IN_DIM * 4;
constexpr size_t OFF_XA = OFF_MIXED + (size_t)T_TOK * 1024 * 2;
constexpr size_t OFF_XB = OFF_XA + (size_t)T_TOK * 1024 * 4;
constexpr size_t OFF_HPREV = OFF_XB + (size_t)T_TOK * 1024 * 4;
constexpr size_t OFF_BM = OFF_HPREV + (size_t)48 * 2 * 8 * 64 * 128 * 2;
constexpr size_t OFF_CM = OFF_BM + (size_t)T_TOK * 256 * 2;
constexpr size_t OFF_BMT = OFF_CM + (size_t)T_TOK * 256 * 2;
constexpr size_t OFF_XST = OFF_BMT + (size_t)48 * 2 * 128 * 128 * 2;
constexpr size_t OFF_VT = OFF_XST + (size_t)48 * 8 * 64 * 128 * 2;
constexpr size_t OFF_DT = OFF_VT + (size_t)48 * 256 * 128 * 2;
constexpr size_t OFF_CUM = OFF_DT + (size_t)48 * 2 * 8 * 128 * 4;
constexpr size_t OFF_WDEC = OFF_CUM + (size_t)48 * 2 * 8 * 128 * 4;
constexpr size_t OFF_S5E = OFF_WDEC + (size_t)48 * 2 * 8 * 128 * 4;
constexpr size_t OFF_Y1B = OFF_S5E + (size_t)192 * 16 * 2 * 64 * 8;
constexpr size_t OFF_S5TAB = OFF_Y1B + (size_t)T_TOK * 256 * 2;
constexpr size_t OFF_S5BB = OFF_S5TAB + (size_t)4096 * 32;
constexpr size_t OFF_BAR = OFF_S5BB + (size_t)64 * 128 * 16 * 2;
constexpr size_t WS_TOTAL = OFF_BAR + 65536;

constexpr size_t OUT_SSD = (size_t)T_TOK * 1024;
constexpr size_t OUT_S5RE = OUT_SSD + (size_t)16 * 2 * 2 * 8 * 64 * 128;
constexpr size_t OUT_S5IM = OUT_S5RE + (size_t)16 * 2 * 2 * 16 * 64;

struct P {
  const float* in[35];
  float* out;
  char* ws;
};

enum { I_XP = 0, I_XS, I_SSSD, I_SS5R, I_SS5I, I_C, I_CCTX, I_ADAW, I_ADAB, I_N1G, I_N2G, I_WIN, I_CONVW, I_CONVB,
       I_DTB, I_ALOG, I_SSDD, I_SSDNG, I_SGUNG, I_SGUW, I_SGUB, I_LRE, I_LIM, I_LOGDT, I_BRE, I_BIM, I_CRE, I_CIM,
       I_S5D, I_GLUW, I_GLUB, I_WOUT, I_W1, I_W2, I_FNG };

__device__ __forceinline__ int otid() { int t = threadIdx.x; asm volatile("" : "+v"(t)); return t; }
__device__ __forceinline__ int obid() { int t = blockIdx.x; asm volatile("" : "+s"(t)); return t; }
__device__ __forceinline__ u16 f2bf(float f) {
  unsigned u = __float_as_uint(f);
  u += 0x7fffu + ((u >> 16) & 1u);
  return (u16)(u >> 16);
}
__device__ __forceinline__ float bf2f(u16 h) { return __uint_as_float(((unsigned)h) << 16); }
__device__ __forceinline__ unsigned pack2(float a, float b) { return (unsigned)f2bf(a) | ((unsigned)f2bf(b) << 16); }

__device__ __forceinline__ float gelu_t(float x) {
  float y = 0.7978845608028654f * (x + 0.044715f * x * x * x);
  float t = __expf(2.f * y);
  float th = 1.f - 2.f / (t + 1.f);
  return 0.5f * x * (1.f + th);
}
__device__ __forceinline__ float sigmoid_f(float x) { return 1.f / (1.f + __expf(-x)); }
__device__ __forceinline__ float silu_f(float x) { return x / (1.f + __expf(-x)); }
__device__ __forceinline__ float softplus_f(float x) { return x > 20.f ? x : log1pf(expf(x)); }

__device__ __forceinline__ f32x4 mfma16(bf16x8 a, bf16x8 b, f32x4 c) {
  return __builtin_amdgcn_mfma_f32_16x16x32_bf16(a, b, c, 0, 0, 0);
}
__device__ __forceinline__ bf16x8 ld_frag(const u16* ptr) {
  return __builtin_bit_cast(bf16x8, *(const u32x4*)ptr);
}

__device__ __forceinline__ void mod_item(const P& p, int it, char* smem) {
  float* red = (float*)smem;
  const int tid = otid();
  const int l = it / 48, jb = it % 48;
  const int j0 = jb * 128;
  const int jq = tid & 31, kg = tid >> 5;
  const float* aw = p.in[I_ADAW] + (size_t)l * 1024 * 6144;
  float acc[3][4];
#pragma unroll
  for (int m = 0; m < 3; ++m)
#pragma unroll
    for (int j = 0; j < 4; ++j) acc[m][j] = 0.f;
  for (int kk = 0; kk < 64; ++kk) {
    int k = kg * 64 + kk;
    f32x4 w = *(const f32x4*)(aw + (size_t)k * 6144 + j0 + jq * 4);
    float c0 = silu_f(p.in[I_CCTX][k]);
    float c1 = silu_f(p.in[I_C][k]);
    float c2 = silu_f(p.in[I_C][1024 + k]);
#pragma unroll
    for (int j = 0; j < 4; ++j) {
      acc[0][j] += c0 * w[j];
      acc[1][j] += c1 * w[j];
      acc[2][j] += c2 * w[j];
    }
  }
#pragma unroll
  for (int m = 0; m < 3; ++m)
#pragma unroll
    for (int j = 0; j < 4; ++j) red[(kg * 3 + m) * 128 + jq * 4 + j] = acc[m][j];
  __syncthreads();
  if (tid < 384) {
    int m = tid >> 7, j = tid & 127;
    float s = p.in[I_ADAB][l * 6144 + j0 + j];
    for (int g = 0; g < 16; ++g) s += red[(g * 3 + m) * 128 + j];
    float* mod = (float*)(p.ws + OFF_MOD);
    mod[(l * 3 + m) * 6144 + j0 + j] = s;
  }
  __syncthreads();
}

__device__ __forceinline__ void transpose_tile(const float* src, int K, int N, u16* dst, int k0, int n0, char* smem) {
  float* tile = (float*)smem;
  const int tid = otid();
#pragma unroll
  for (int i = 0; i < 4; ++i) {
    int k = (tid >> 4) + 32 * i, n4 = tid & 15;
    int n = n0 + n4 * 4;
    f32x4 v = {0.f, 0.f, 0.f, 0.f};
    if (n < N) v = *(const f32x4*)(src + (size_t)(k0 + k) * N + n);
    float* d = tile + k * 65 + n4 * 4;
    d[0] = v[0]; d[1] = v[1]; d[2] = v[2]; d[3] = v[3];
  }
  __syncthreads();
#pragma unroll
  for (int i = 0; i < 2; ++i) {
    int slot = tid + i * 512;
    int n = slot >> 4, kg = slot & 15;
    u32x4 o;
#pragma unroll
    for (int j = 0; j < 4; ++j)
      o[j] = pack2(tile[(kg * 8 + 2 * j) * 65 + n], tile[(kg * 8 + 2 * j + 1) * 65 + n]);
    *(u32x4*)(dst + (size_t)(n0 + n) * K + k0 + kg * 8) = o;
  }
  __syncthreads();
}

struct TrDesc { const float* src; u16* dst; int K, N, k0, n0; };
__device__ __forceinline__ TrDesc tr_decode(const P& p, int it) {
  TrDesc d;
  int l = it / 1464, r = it % 1464, nt;
  if (r < 304) { d.src = p.in[I_WIN] + (size_t)l * 1024 * IN_DIM; d.dst = (u16*)(p.ws + OFF_WIN_T) + (size_t)l * IN_PAD * 1024; d.K = 1024; d.N = IN_DIM; nt = 38; }
  else if (r < 432) { r -= 304; d.src = p.in[I_WOUT] + (size_t)l * 1024 * 1024; d.dst = (u16*)(p.ws + OFF_WOUT_T) + (size_t)l * 1024 * 1024; d.K = 1024; d.N = 1024; nt = 16; }
  else if (r < 944) { r -= 432; d.src = p.in[I_W1] + (size_t)l * 1024 * 4096; d.dst = (u16*)(p.ws + OFF_W1_T) + (size_t)l * 4096 * 1024; d.K = 1024; d.N = 4096; nt = 64; }
  else if (r < 1456) { r -= 944; d.src = p.in[I_W2] + (size_t)l * 4096 * 1024; d.dst = (u16*)(p.ws + OFF_W2_T) + (size_t)l * 1024 * 4096; d.K = 4096; d.N = 1024; nt = 16; }
  else { r -= 1456; d.src = p.in[I_GLUW] + (size_t)l * 256 * 256; d.dst = (u16*)(p.ws + OFF_GLU_T) + (size_t)l * 256 * 256; d.K = 256; d.N = 256; nt = 4; }
  d.k0 = (r / nt) * 128; d.n0 = (r % nt) * 64;
  return d;
}
__device__ __forceinline__ void tr_load(const TrDesc& d, int tid, f32x4 (&v)[4]) {
#pragma unroll
  for (int i = 0; i < 4; ++i) {
    const int k = (tid >> 4) + 32 * i, n = d.n0 + (tid & 15) * 4;
    v[i] = (f32x4){0.f, 0.f, 0.f, 0.f};
    if (n < d.N) v[i] = *(const f32x4*)(d.src + (size_t)(d.k0 + k) * d.N + n);
  }
}
__device__ __forceinline__ void p0_transposes(const P& p, char* smem) {
  float* tile = (float*)smem;
  const int tid = otid(), nb = gridDim.x;
  int cur = obid();
  if (cur >= 2928) return;
  f32x4 v[4];
  TrDesc d = tr_decode(p, cur);
  tr_load(d, tid, v);
  while (cur < 2928) {
    __syncthreads();
#pragma unroll
    for (int i = 0; i < 4; ++i) {
      float* q = tile + ((tid >> 4) + 32 * i) * 65 + (tid & 15) * 4;
      q[0] = v[i][0]; q[1] = v[i][1]; q[2] = v[i][2]; q[3] = v[i][3];
    }
    __syncthreads();
    const int nxt = cur + nb;
    TrDesc dn = d;
    if (nxt < 2928) { dn = tr_decode(p, nxt); tr_load(dn, tid, v); }
#pragma unroll
    for (int i = 0; i < 2; ++i) {
      const int slot = tid + i * 512;
      const int n = slot >> 4, kg = slot & 15;
      u32x4 o;
#pragma unroll
      for (int j = 0; j < 4; ++j) o[j] = pack2(tile[(kg * 8 + 2 * j) * 65 + n], tile[(kg * 8 + 2 * j + 1) * 65 + n]);
      *(u32x4*)(d.dst + (size_t)(d.n0 + n) * d.K + d.k0 + kg * 8) = o;
    }
    d = dn; cur = nxt;
  }
  __syncthreads();
}
__device__ __forceinline__ void p0_sgu_item(const P& p, int it) {
  const float* src = p.in[I_SGUW] + (size_t)it * 8192;
  u16* dst = (u16*)(p.ws + OFF_SGUW) + (size_t)it * 8192;
  const int tid = otid();
#pragma unroll
  for (int i = 0; i < 2; ++i) {
    int e = (tid + i * 512) * 8;
    f32x4 a = *(const f32x4*)(src + e), b = *(const f32x4*)(src + e + 4);
    u32x4 o = {pack2(a[0], a[1]), pack2(a[2], a[3]), pack2(b[0], b[1]), pack2(b[2], b[3])};
    *(u32x4*)(dst + e) = o;
  }
}

__device__ __forceinline__ float shx(float v, int o, int lane) {
  return __int_as_float(__builtin_amdgcn_ds_bpermute((lane ^ o) << 2, __float_as_int(v)));
}
__device__ __forceinline__ float wave_sum(float v, int lane) {
#pragma unroll
  for (int o = 32; o > 0; o >>= 1) v += shx(v, o, lane);
  return v;
}

__device__ __forceinline__ void norm_phase(const P& p, int l, int mode, const float* xa, const float* xb) {
  const int tid = otid(), w = tid >> 6, lane = tid & 63;
  const float* mod = (const float*)(p.ws + OFF_MOD);
  u16* H = (u16*)(p.ws + OFF_H);
  const float* g = mode == 0 ? p.in[I_N1G] + l * 1024 : mode == 1 ? p.in[I_N2G] + l * 1024 : p.in[I_FNG];
  for (int row = obid() * 8 + w; row < T_TOK; row += gridDim.x * 8) {
    const float* x = row < 4096 ? xa + (size_t)row * 1024 : xb + (size_t)(row - 4096) * 1024;
    f32x4 v[4];
    float ss = 0.f;
#pragma unroll
    for (int i = 0; i < 4; ++i) {
      v[i] = *(const f32x4*)(x + i * 256 + lane * 4);
#pragma unroll
      for (int j = 0; j < 4; ++j) ss += v[i][j] * v[i][j];
    }
    ss = wave_sum(ss, lane);
    float rinv = rsqrtf(ss * (1.f / 1024.f) + 1e-6f);
    int m = row < 4096 ? 0 : 1 + ((row - 4096) >> 10);
    const float* mb = mod + (size_t)(l * 3 + m) * 6144 + (mode == 1 ? 3072 : 0);
#pragma unroll
    for (int i = 0; i < 4; ++i) {
      int c = i * 256 + lane * 4;
      f32x4 gg = *(const f32x4*)(g + c);
      if (mode == 2) {
        f32x4 o;
#pragma unroll
        for (int j = 0; j < 4; ++j) o[j] = v[i][j] * rinv * gg[j];
        *(f32x4*)(p.out + (size_t)row * 1024 + c) = o;
      } else {
        f32x4 sh = *(const f32x4*)(mb + c);
        f32x4 sc = *(const f32x4*)(mb + 1024 + c);
        float o[4];
#pragma unroll
        for (int j = 0; j < 4; ++j) o[j] = v[i][j] * rinv * gg[j] * (1.f + sc[j]) + sh[j];
        u32x2 pk = {pack2(o[0], o[1]), pack2(o[2], o[3])};
        *(u32x2*)(H + (size_t)row * 1024 + c) = pk;
      }
    }
  }
}

struct Epi {
  float* outf;
  u16* outb;
  const float* xa;
  const float* xb;
  const float* gate;
  const u16* y1;
  const float* bias;
};

template <int EPI, int K>
__device__ __forceinline__ void gemm_phase(const u16* A, const u16* Bt, int ntn, const Epi& e, char* smem) {
  constexpr int LS = 72;
  constexpr int nk = K >> 6;
  u16* sA = (u16*)smem;
  u16* sB = sA + 2 * 192 * LS;
  const int tid = otid(), w = tid >> 6, lane = tid & 63, quad = lane >> 4, l15 = lane & 15;
  const int wm = w >> 1, wn = w & 1;
  const int lrow = tid >> 3, lkc = tid & 7;
  const int ntiles = 32 * ntn;
  const int bid = obid(), nb = gridDim.x;
  if (bid >= ntiles) return;
  const int total = ((ntiles - bid + nb - 1) / nb) * nk;
  u32x4 ra0[3], rb0[2], ra1[3], rb1[2];
  f32x4 acc[3][4];
#pragma unroll
  for (int i = 0; i < 3; ++i)
#pragma unroll
    for (int j = 0; j < 4; ++j) acc[i][j] = (f32x4){0.f, 0.f, 0.f, 0.f};
  auto issue = [&](u32x4 (&ra)[3], u32x4 (&rb)[2], int pos) {
    const int t = bid + (pos / nk) * nb, ks = pos % nk;
    const u16* ap = A + (size_t)((t & 31) * 192 + lrow) * K + lkc * 8 + ks * 64;
    const u16* bp = Bt + (size_t)((t >> 5) * 128 + lrow) * K + lkc * 8 + ks * 64;
#pragma unroll
    for (int i = 0; i < 3; ++i) ra[i] = *(const u32x4*)(ap + (size_t)i * 64 * K);
#pragma unroll
    for (int i = 0; i < 2; ++i) rb[i] = *(const u32x4*)(bp + (size_t)i * 64 * K);
  };
  auto stash = [&](u32x4 (&ra)[3], u32x4 (&rb)[2], int buf) {
#pragma unroll
    for (int i = 0; i < 3; ++i) *(u32x4*)(sA + buf * 192 * LS + (lrow + i * 64) * LS + lkc * 8) = ra[i];
#pragma unroll
    for (int i = 0; i < 2; ++i) *(u32x4*)(sB + buf * 128 * LS + (lrow + i * 64) * LS + lkc * 8) = rb[i];
  };
  auto body = [&](u32x4 (&ra)[3], u32x4 (&rb)[2], int pos) {
    if (pos + 1 < total) stash(ra, rb, (pos + 1) & 1);
    if (pos + 3 < total) issue(ra, rb, pos + 3);
    const int buf = pos & 1;
    const u16* cA = sA + buf * 192 * LS + (wm * 48 + l15) * LS + quad * 8;
    const u16* cB = sB + buf * 128 * LS + (wn * 64 + l15) * LS + quad * 8;
    {
      bf16x8 af[2][3], bq[2][4];
#pragma unroll
      for (int kk = 0; kk < 2; ++kk) {
#pragma unroll
        for (int i = 0; i < 3; ++i) af[kk][i] = ld_frag(cA + i * 16 * LS + kk * 32);
#pragma unroll
        for (int j = 0; j < 4; ++j) bq[kk][j] = ld_frag(cB + j * 16 * LS + kk * 32);
      }
      __builtin_amdgcn_s_setprio(1);
#pragma unroll
      for (int kk = 0; kk < 2; ++kk)
#pragma unroll
        for (int j = 0; j < 4; ++j)
#pragma unroll
          for (int i = 0; i < 3; ++i) acc[i][j] = mfma16(af[kk][i], bq[kk][j], acc[i][j]);
      __builtin_amdgcn_s_setprio(0);
    }
    if ((pos % nk) == nk - 1) {
      const int t = bid + (pos / nk) * nb;
      const int m0 = (t & 31) * 192, n0 = (t >> 5) * 128;
#pragma unroll
      for (int i = 0; i < 3; ++i)
#pragma unroll
        for (int j = 0; j < 4; ++j) {
#pragma unroll
          for (int r = 0; r < 4; ++r) {
            const int row = m0 + wm * 48 + i * 16 + quad * 4 + r;
            const int col = n0 + wn * 64 + j * 16 + l15;
            const float a = acc[i][j][r];
            if (EPI == 0) {
              if (col < IN_DIM) e.outf[(size_t)row * IN_DIM + col] = a;
            } else if (EPI == 1) {
              const float x = row < 4096 ? e.xa[(size_t)row * 1024 + col] : e.xb[(size_t)(row - 4096) * 1024 + col];
              const int m = row < 4096 ? 0 : 1 + ((row - 4096) >> 10);
              e.outf[(size_t)row * 1024 + col] = x + e.gate[m * 6144 + col] * a;
            } else if (EPI == 2) {
              const float rl = a > 0.f ? a : 0.f;
              e.outb[(size_t)row * DFF + col] = f2bf(rl * rl);
            } else {
              const float g = sigmoid_f(a + e.bias[col]);
              const float y = bf2f(e.y1[(size_t)row * 256 + col]);
              e.outb[(size_t)row * 1024 + 768 + col] = f2bf(y * g);
            }
          }
          acc[i][j] = (f32x4){0.f, 0.f, 0.f, 0.f};
        }
    }
    __syncthreads();
  };
  issue(ra0, rb0, 0);
  if (1 < total) issue(ra1, rb1, 1);
  stash(ra0, rb0, 0);
  if (2 < total) issue(ra0, rb0, 2);
  __syncthreads();
  for (int pos = 0; pos < total; pos += 2) {
    body(ra1, rb1, pos);
    if (pos + 1 < total) body(ra0, rb0, pos + 1);
  }
}

__device__ __forceinline__ void prep_conv(const P& p, int l, int ck, int s, char* smem) {
  float* tile = (float*)smem;
  const int tid = otid();
  const int row0 = ck * 128;
  int seq_lo, seq_hi;
  if (ck < 32) { seq_lo = (ck >> 1) * 256; seq_hi = seq_lo + 256; }
  else { seq_lo = 4096 + ((ck - 32) >> 3) * 1024; seq_hi = seq_lo + 1024; }
  const float* proj = (const float*)(p.ws + OFF_PROJ);
  const int c0 = s * 64;
  for (int id = tid; id < 132 * 16; id += 512) {
    int r = id >> 4, c4 = id & 15;
    int row = row0 - 2 + r;
    f32x4 v = {0.f, 0.f, 0.f, 0.f};
    if (row >= seq_lo && row < seq_hi) v = *(const f32x4*)(proj + (size_t)row * IN_DIM + 512 + c0 + c4 * 4);
    float* d = tile + r * 65 + c4 * 4;
    d[0] = v[0]; d[1] = v[1]; d[2] = v[2]; d[3] = v[3];
  }
  __syncthreads();
  const float* cw = p.in[I_CONVW] + (size_t)l * 5 * 1024;
  const float* cb = p.in[I_CONVB] + (size_t)l * 1024;
  if (s < 12) {
    u16* dstbase;
    if (s < 8) dstbase = (u16*)(p.ws + OFF_XST) + (size_t)(ck * 8 + s) * 64 * 128;
    else dstbase = (u16*)(p.ws + OFF_BMT) + ((size_t)(ck * 2 + ((s - 8) >> 1)) * 128 + ((s - 8) & 1) * 64) * 128;
#pragma unroll
    for (int it = 0; it < 2; ++it) {
      int slot = tid + it * 512;
      int pl = slot & 63, ig = slot >> 6;
      int c = c0 + pl;
      float w0 = cw[c], w1 = cw[1024 + c], w2 = cw[2048 + c], w3 = cw[3072 + c], w4 = cw[4096 + c], bb = cb[c];
      float o[8];
#pragma unroll
      for (int j = 0; j < 8; ++j) {
        int i = ig * 8 + j;
        float a = bb + tile[i * 65 + pl] * w0 + tile[(i + 1) * 65 + pl] * w1 + tile[(i + 2) * 65 + pl] * w2 +
                  tile[(i + 3) * 65 + pl] * w3 + tile[(i + 4) * 65 + pl] * w4;
        o[j] = silu_f(a);
      }
      u32x4 pk = {pack2(o[0], o[1]), pack2(o[2], o[3]), pack2(o[4], o[5]), pack2(o[6], o[7])};
      *(u32x4*)(dstbase + (size_t)pl * 128 + ig * 8) = pk;
    }
  }
  if (s >= 8) {
    u16* dstbase = s < 12 ? (u16*)(p.ws + OFF_BM) + (s - 8) * 64 : (u16*)(p.ws + OFF_CM) + (s - 12) * 64;
#pragma unroll
    for (int it = 0; it < 2; ++it) {
      int slot = tid + it * 512;
      int cg8 = slot & 7, i = slot >> 3;
      float o[8];
#pragma unroll
      for (int j = 0; j < 8; ++j) {
        int pl = cg8 * 8 + j;
        int c = c0 + pl;
        float a = cb[c] + tile[i * 65 + pl] * cw[c] + tile[(i + 1) * 65 + pl] * cw[1024 + c] +
                  tile[(i + 2) * 65 + pl] * cw[2048 + c] + tile[(i + 3) * 65 + pl] * cw[3072 + c] +
                  tile[(i + 4) * 65 + pl] * cw[4096 + c];
        o[j] = silu_f(a);
      }
      u32x4 pk = {pack2(o[0], o[1]), pack2(o[2], o[3]), pack2(o[4], o[5]), pack2(o[6], o[7])};
      *(u32x4*)(dstbase + (size_t)(row0 + i) * 256 + cg8 * 8) = pk;
    }
  }
  __syncthreads();
}

__device__ __forceinline__ void prep_dt(const P& p, int l, int ck, char* smem) {
  float* dts = (float*)smem;
  const int tid = otid();
  const float* proj = (const float*)(p.ws + OFF_PROJ);
  const int row0 = ck * 128;
#pragma unroll
  for (int it = 0; it < 4; ++it) {
    int i = (tid >> 4) + it * 32, col = tid & 15;
    float x = proj[(size_t)(row0 + i) * IN_DIM + 1536 + col] + p.in[I_DTB][l * 16 + col];
    dts[i * 16 + col] = softplus_f(x);
  }
  __syncthreads();
  if (tid < 16) {
    const int dir = tid >> 3, h = tid & 7;
    const float a = -expf(p.in[I_ALOG][l * 16 + tid]);
    float* DT = (float*)(p.ws + OFF_DT) + (size_t)((ck * 2 + dir) * 8 + h) * 128;
    float* CUM = (float*)(p.ws + OFF_CUM) + (size_t)((ck * 2 + dir) * 8 + h) * 128;
    float* WD = (float*)(p.ws + OFF_WDEC) + (size_t)((ck * 2 + dir) * 8 + h) * 128;
    float run = 0.f;
    if (dir == 0) {
      for (int i = 0; i < 128; ++i) { float d = dts[i * 16 + tid]; run += d * a; DT[i] = d; CUM[i] = run; dts[i * 16 + tid] = run; }
    } else {
      for (int i = 127; i >= 0; --i) { float d = dts[i * 16 + tid]; run += d * a; DT[i] = d; CUM[i] = run; dts[i * 16 + tid] = run; }
    }
    for (int i = 0; i < 128; ++i) WD[i] = DT[i] * __expf(run - dts[i * 16 + tid]);
  }
  __syncthreads();
}

__device__ __forceinline__ void prep_v(const P& p, int l, int ck, char* smem) {
  u16* tl = (u16*)smem;
  const int tid = otid(), w = tid >> 6, lane = tid & 63;
  const float* proj = (const float*)(p.ws + OFF_PROJ);
  const int row0 = ck * 128;
  const f32x4 g = *(const f32x4*)(p.in[I_SGUNG] + l * 256 + lane * 4);
  for (int rr = 0; rr < 16; ++rr) {
    int i = w * 16 + rr;
    f32x4 v = *(const f32x4*)(proj + (size_t)(row0 + i) * IN_DIM + 1552 + 256 + lane * 4);
    float ss = 0.f;
#pragma unroll
    for (int j = 0; j < 4; ++j) { v[j] = gelu_t(v[j]); ss += v[j] * v[j]; }
    ss = wave_sum(ss, lane);
    float rinv = rsqrtf(ss * (1.f / 256.f) + 1e-6f);
    u32x2 pk = {pack2(v[0] * rinv * g[0], v[1] * rinv * g[1]), pack2(v[2] * rinv * g[2], v[3] * rinv * g[3])};
    *(u32x2*)(tl + i * 264 + lane * 4) = pk;
  }
  __syncthreads();
  u16* VT = (u16*)(p.ws + OFF_VT) + (size_t)ck * 256 * 128;
#pragma unroll
  for (int it = 0; it < 8; ++it) {
    int c = tid & 255, ig = (tid >> 8) + 2 * it;
    u32x4 pk;
#pragma unroll
    for (int j = 0; j < 4; ++j)
      pk[j] = (unsigned)tl[(ig * 8 + 2 * j) * 264 + c] | ((unsigned)tl[(ig * 8 + 2 * j + 1) * 264 + c] << 16);
    *(u32x4*)(VT + (size_t)c * 128 + ig * 8) = pk;
  }
  __syncthreads();
}

template <int NT, bool PIPE>
__device__ __forceinline__ void ssd_state_chain(const P& p, int l, int sq, int h, int dir, int pt, int ntile0) {
  const int g = h >> 2;
  const bool lat = sq >= 16;
  const int nck = lat ? 8 : 2;
  const int ck0 = lat ? 32 + (sq - 16) * 8 : sq * 2;
  const int tid = otid(), w = tid >> 6, lane = tid & 63, quad = lane >> 4, l15 = lane & 15;
  const int lane_off = (pt * 16 + quad * 4) * 128 + ntile0 * 16 + l15;
  f32x4 acc[NT];
  if (lat) {
    const float* s0 = p.in[I_SSSD] + ((size_t)((((sq - 16) * 2 + l) * 2 + dir) * 8 + h) * 64) * 128;
#pragma unroll
    for (int nt = 0; nt < NT; ++nt)
#pragma unroll
      for (int r = 0; r < 4; ++r) acc[nt][r] = (s0 + lane_off)[r * 128 + nt * 16];
  } else {
#pragma unroll
    for (int nt = 0; nt < NT; ++nt) acc[nt] = (f32x4){0.f, 0.f, 0.f, 0.f};
  }
  const u16* XST = (const u16*)(p.ws + OFF_XST);
  const u16* BMT = (const u16*)(p.ws + OFF_BMT);
  u16* HPREV = (u16*)(p.ws + OFF_HPREV);
  u32x4 xr[4];
  f32x4 ww[4][2];
  bf16x8 bfr[4][NT];
  float cum_end = 0.f;
  auto issue = [&](int step) {
    const int ck = dir == 0 ? ck0 + step : ck0 + nck - 1 - step;
    const float* WD = (const float*)(p.ws + OFF_WDEC) + (size_t)((ck * 2 + dir) * 8 + h) * 128;
    const float* CUM = (const float*)(p.ws + OFF_CUM) + (size_t)((ck * 2 + dir) * 8 + h) * 128;
    cum_end = CUM[dir == 0 ? 127 : 0];
    const u16* xa = XST + ((size_t)(ck * 8 + h) * 64 + pt * 16 + l15) * 128;
    const u16* bb = BMT + ((size_t)(ck * 2 + g) * 128 + ntile0 * 16 + l15) * 128;
#pragma unroll
    for (int ks = 0; ks < 4; ++ks) {
      const int k0 = ks * 32 + quad * 8;
      xr[ks] = *(const u32x4*)(xa + k0);
      ww[ks][0] = *(const f32x4*)(WD + k0); ww[ks][1] = *(const f32x4*)(WD + k0 + 4);
#pragma unroll
      for (int nt = 0; nt < NT; ++nt) bfr[ks][nt] = ld_frag(bb + (size_t)nt * 16 * 128 + k0);
    }
  };
  if (PIPE) issue(0);
  for (int step = 0; step < nck; ++step) {
    const int ck = dir == 0 ? ck0 + step : ck0 + nck - 1 - step;
    u16* hp = HPREV + ((size_t)((ck * 2 + dir) * 8 + h) * 64) * 128;
    if (!PIPE) issue(step);
    const float decay = __expf(cum_end);
    bf16x8 af[4];
    bf16x8 bcur[4][NT];
#pragma unroll
    for (int ks = 0; ks < 4; ++ks) {
      u32x4 xs;
#pragma unroll
      for (int j = 0; j < 4; ++j) {
        float lo = __uint_as_float(xr[ks][j] << 16) * ww[ks][j >> 1][(j & 1) * 2];
        float hi = __uint_as_float(xr[ks][j] & 0xffff0000u) * ww[ks][j >> 1][(j & 1) * 2 + 1];
        xs[j] = pack2(lo, hi);
      }
      af[ks] = __builtin_bit_cast(bf16x8, xs);
#pragma unroll
      for (int nt = 0; nt < NT; ++nt) bcur[ks][nt] = bfr[ks][nt];
    }
    if (PIPE && step + 1 < nck) issue(step + 1);
#pragma unroll
    for (int nt = 0; nt < NT; ++nt)
#pragma unroll
      for (int r = 0; r < 4; ++r) (hp + lane_off)[r * 128 + nt * 16] = f2bf(acc[nt][r]);
#pragma unroll
    for (int nt = 0; nt < NT; ++nt)
#pragma unroll
      for (int r = 0; r < 4; ++r) acc[nt][r] *= decay;
#pragma unroll
    for (int ks = 0; ks < 4; ++ks)
#pragma unroll
      for (int nt = 0; nt < NT; ++nt) acc[nt] = mfma16(af[ks], bcur[ks][nt], acc[nt]);
  }
  if (!lat) {
    float* o = p.out + OUT_SSD + ((size_t)(((sq * 2 + l) * 2 + dir) * 8 + h) * 64) * 128;
#pragma unroll
    for (int nt = 0; nt < NT; ++nt)
#pragma unroll
      for (int r = 0; r < 4; ++r) (o + lane_off)[r * 128 + nt * 16] = acc[nt][r];
  }
}
__device__ __forceinline__ void ssd_state_item(const P& p, int l, int item) {
  const int w = otid() >> 6;
  if (item < 128) {
    const int idx = item >> 2, nq = item & 3;
    ssd_state_chain<1, false>(p, l, 16 + (idx >> 4), (idx & 15) >> 1, idx & 1, nq, w);
  } else {
    const int idx = item - 128;
    ssd_state_chain<4, false>(p, l, idx >> 4, (idx & 15) >> 1, idx & 1, w & 3, (w >> 2) * 4);
  }
}

__device__ __forceinline__ void s5_table_item(const P& p) {
  const int tid = otid();
  for (int e = tid; e < 4096; e += 512) {
    const float are = p.in[I_LRE][e], aim = p.in[I_LIM][e];
    const float step = expf(p.in[I_LOGDT][e >> 6]);
    const float er = expf(are * step), th = aim * step;
    const float lr = er * cosf(th), li = er * sinf(th);
    const float nr = lr - 1.f, ni = li;
    const float den = 1.f / (are * are + aim * aim);
    const float kr = (nr * are + ni * aim) * den, ki = (ni * are - nr * aim) * den;
    float pr = lr, pi = li;
#pragma unroll
    for (int k = 0; k < 5; ++k) { float a = pr * pr - pi * pi, b = 2.f * pr * pi; pr = a; pi = b; }
    f32x4* tab = (f32x4*)(p.ws + OFF_S5TAB) + (size_t)e * 2;
    tab[0] = (f32x4){lr, li, kr, ki};
    tab[1] = (f32x4){pr, pi, 0.f, 0.f};
    const int l = e >> 11, g = (e >> 6) & 15, n = e & 63;
    const float* Br = p.in[I_BRE] + ((size_t)(l * 16 + g) * 64 + n) * 16;
    const float* Bi = p.in[I_BIM] + ((size_t)(l * 16 + g) * 64 + n) * 16;
    u16* bb = (u16*)(p.ws + OFF_S5BB) + ((size_t)(e >> 6) * 128 + n * 2) * 16;
#pragma unroll
    for (int c4 = 0; c4 < 4; ++c4) {
      const f32x4 a = *(const f32x4*)(Br + c4 * 4), b = *(const f32x4*)(Bi + c4 * 4);
      u32x2 re = {pack2(kr * a[0] - ki * b[0], kr * a[1] - ki * b[1]), pack2(kr * a[2] - ki * b[2], kr * a[3] - ki * b[3])};
      u32x2 im = {pack2(kr * b[0] + ki * a[0], kr * b[1] + ki * a[1]), pack2(kr * b[2] + ki * a[2], kr * b[3] + ki * a[3])};
      *(u32x2*)(bb + c4 * 4) = re;
      *(u32x2*)(bb + 16 + c4 * 4) = im;
    }
  }
}
__device__ __forceinline__ void s5_sc_info(int sc, int& sq, int& j, int& nsc, int& sc0, int& row0) {
  if (sc < 128) { sq = sc >> 3; j = sc & 7; nsc = 8; sc0 = sq * 8; row0 = sq * 256; }
  else { int lb = (sc - 128) >> 5; sq = 16 + lb; j = (sc - 128) & 31; nsc = 32; sc0 = 128 + lb * 32; row0 = 4096 + lb * 1024; }
}
__device__ __forceinline__ int s5_row(bool lat, int row0, int s) { return lat ? row0 + (s & 15) * 64 + (s >> 4) : row0 + s; }

__device__ __forceinline__ void s5_load_u(const P& p, int sc, int gq, float* us) {
  int sq, j, nsc, sc0, row0;
  s5_sc_info(sc, sq, j, nsc, sc0, row0);
  const int tid = otid();
  const int gi = tid >> 7, i = (tid & 127) >> 2, c4 = tid & 3;
  const int row = s5_row(sq >= 16, row0, j * 32 + i);
  const float* proj = (const float*)(p.ws + OFF_PROJ);
  f32x4 v = *(const f32x4*)(proj + (size_t)row * IN_DIM + 2064 + (gq * 4 + gi) * 16 + c4 * 4);
  *(f32x4*)(us + (gi * 32 + i) * 16 + c4 * 4) = v;
}
__device__ __forceinline__ void s5_bu_mfma(const P& p, int l, int dir, int g, const float* us_g, float* hb, int lane) {
  const int quad = lane >> 4, l15 = lane & 15;
  bf16x8 af[2];
#pragma unroll
  for (int mt = 0; mt < 2; ++mt) {
    u32x4 pk = {0u, 0u, 0u, 0u};
    if (quad < 2) {
      const f32x4 a = *(const f32x4*)(us_g + (mt * 16 + l15) * 16 + quad * 8), b = *(const f32x4*)(us_g + (mt * 16 + l15) * 16 + quad * 8 + 4);
      pk = (u32x4){pack2(a[0], a[1]), pack2(a[2], a[3]), pack2(b[0], b[1]), pack2(b[2], b[3])};
    }
    af[mt] = __builtin_bit_cast(bf16x8, pk);
  }
  const u16* bb = (const u16*)(p.ws + OFF_S5BB) + ((size_t)((l * 2 + dir) * 16 + g) * 128 + l15) * 16 + (quad & 1) * 8;
#pragma unroll
  for (int nt = 0; nt < 8; ++nt) {
    u32x4 bv = *(const u32x4*)(bb + (size_t)nt * 16 * 16);
    if (quad >= 2) bv = (u32x4){0u, 0u, 0u, 0u};
    const bf16x8 bq = __builtin_bit_cast(bf16x8, bv);
#pragma unroll
    for (int mt = 0; mt < 2; ++mt) {
      f32x4 acc = {0.f, 0.f, 0.f, 0.f};
      acc = mfma16(af[mt], bq, acc);
#pragma unroll
      for (int r = 0; r < 4; ++r) hb[(mt * 16 + quad * 4 + r) * 132 + nt * 16 + l15] = acc[r];
    }
  }
}

__device__ __forceinline__ void s5_local_item(const P& p, int l, int item, char* smem) {
  float* us = (float*)smem;
  float* HB = (float*)(smem + 8192);
  const int sc = item >> 2, gq = item & 3;
  s5_load_u(p, sc, gq, us);
  __syncthreads();
  const int tid = otid(), w = tid >> 6, n = tid & 63;
  const int gi = w >> 1, dir = w & 1, g = gq * 4 + gi;
  float* hb = HB + (gi * 2 + dir) * 32 * 132;
  s5_bu_mfma(p, l, dir, g, us + gi * 32 * 16, hb, n);
  __syncthreads();
  const f32x4 t0 = *((const f32x4*)(p.ws + OFF_S5TAB) + (size_t)(((l * 2 + dir) * 16 + g) * 64 + n) * 2);
  const float lr = t0[0], li = t0[1];
  float hr = 0.f, hi = 0.f;
#pragma unroll 8
  for (int ii = 0; ii < 32; ++ii) {
    const int i = dir == 0 ? ii : 31 - ii;
    const float2 bu = *(const float2*)(hb + i * 132 + n * 2);
    const float a = lr * hr - li * hi + bu.x, b = lr * hi + li * hr + bu.y;
    hr = a; hi = b;
  }
  float* E = (float*)(p.ws + OFF_S5E);
  *(float2*)(E + ((size_t)((sc * 16 + g) * 2 + dir) * 64 + n) * 2) = make_float2(hr, hi);
  __syncthreads();
}

__device__ __forceinline__ void s5_out_item(const P& p, int l, int item, char* smem) {
  float* us = (float*)smem;
  float* HB = (float*)(smem + 8192);
  const int sc = item >> 2, gq = item & 3;
  int sq, j, nsc, sc0, row0;
  s5_sc_info(sc, sq, j, nsc, sc0, row0);
  const bool lat = sq >= 16;
  s5_load_u(p, sc, gq, us);
  __syncthreads();
  const int tid = otid(), w = tid >> 6, lane = tid & 63;
  {
    const int n = lane;
    const int gi = w >> 1, dir = w & 1, g = gq * 4 + gi;
    float* hb = HB + (gi * 2 + dir) * 32 * 132;
    s5_bu_mfma(p, l, dir, g, us + gi * 32 * 16, hb, lane);
    __syncthreads();
    const f32x4* tab = (const f32x4*)(p.ws + OFF_S5TAB) + (size_t)(((l * 2 + dir) * 16 + g) * 64 + n) * 2;
    const f32x4 t0 = tab[0], t1 = tab[1];
    const float lr = t0[0], li = t0[1], pr = t1[0], pi = t1[1];
    float hr = 0.f, hi = 0.f;
    if (lat) {
      const int si = ((((sq - 16) * 2 + l) * 2 + dir) * 16 + g) * 64 + n;
      hr = p.in[I_SS5R][si];
      hi = p.in[I_SS5I][si];
    }
    const float* E = (const float*)(p.ws + OFF_S5E);
    const int nprev = dir == 0 ? j : nsc - 1 - j;
    for (int jj0 = 0; jj0 < nprev; jj0 += 8) {
      float2 ev[8];
#pragma unroll
      for (int u = 0; u < 8; ++u) {
        const int jj = jj0 + u < nprev ? jj0 + u : nprev - 1;
        const int scp = dir == 0 ? sc0 + jj : sc0 + nsc - 1 - jj;
        ev[u] = *(const float2*)(E + ((size_t)((scp * 16 + g) * 2 + dir) * 64 + n) * 2);
      }
#pragma unroll
      for (int u = 0; u < 8; ++u) {
        if (jj0 + u < nprev) {
          const float a = pr * hr - pi * hi + ev[u].x, b = pr * hi + pi * hr + ev[u].y;
          hr = a; hi = b;
        }
      }
    }
#pragma unroll 8
    for (int ii = 0; ii < 32; ++ii) {
      const int i = dir == 0 ? ii : 31 - ii;
      float2* cell = (float2*)(hb + i * 132 + n * 2);
      const float2 bu = *cell;
      const float a = lr * hr - li * hi + bu.x, b = lr * hi + li * hr + bu.y;
      hr = a; hi = b;
      *cell = make_float2(hr, hi);
    }
    if (!lat && ((dir == 0 && j == nsc - 1) || (dir == 1 && j == 0))) {
      const int oi = (((sq * 2 + l) * 2 + dir) * 16 + g) * 64 + n;
      p.out[OUT_S5RE + oi] = hr;
      p.out[OUT_S5IM + oi] = hi;
    }
  }
  __syncthreads();
  {
    const int quad = lane >> 4, l15 = lane & 15;
    const int gi = w >> 1, mt = w & 1, g = gq * 4 + gi;
    const float* Cr = p.in[I_CRE] + ((size_t)(l * 16 + g) * 16 + l15) * 64;
    const float* Ci = p.in[I_CIM] + ((size_t)(l * 16 + g) * 16 + l15) * 64;
    bf16x8 bfr[4];
#pragma unroll
    for (int k4 = 0; k4 < 4; ++k4) {
      f32x4 cr = *(const f32x4*)(Cr + k4 * 16 + quad * 4), ci = *(const f32x4*)(Ci + k4 * 16 + quad * 4);
      u32x4 pk = {pack2(cr[0], -ci[0]), pack2(cr[1], -ci[1]), pack2(cr[2], -ci[2]), pack2(cr[3], -ci[3])};
      bfr[k4] = __builtin_bit_cast(bf16x8, pk);
    }
    f32x4 acc = {0.f, 0.f, 0.f, 0.f};
#pragma unroll
    for (int ks = 0; ks < 8; ++ks) {
      const float* ha = HB + ((gi * 2 + (ks >> 2)) * 32 + mt * 16 + l15) * 132 + (ks & 3) * 32 + quad * 8;
      const f32x4 h0 = *(const f32x4*)ha, h1 = *(const f32x4*)(ha + 4);
      u32x4 pk = {pack2(h0[0], h0[1]), pack2(h0[2], h0[3]), pack2(h1[0], h1[1]), pack2(h1[2], h1[3])};
      acc = mfma16(__builtin_bit_cast(bf16x8, pk), bfr[ks & 3], acc);
    }
    const float dsk = p.in[I_S5D][l * 256 + g * 16 + l15];
    u16* Y1B = (u16*)(p.ws + OFF_Y1B);
#pragma unroll
    for (int r = 0; r < 4; ++r) {
      const int i = mt * 16 + quad * 4 + r;
      const float y = acc[r] + dsk * us[(gi * 32 + i) * 16 + l15];
      const int row = s5_row(lat, row0, j * 32 + i);
      Y1B[(size_t)row * 256 + g * 16 + l15] = f2bf(gelu_t(y));
    }
  }
  __syncthreads();
}

__device__ __forceinline__ void sgu_item(const P& p, int l, int item) {
  const int ck = item >> 2, hd = item & 3;
  const int tid = otid(), w = tid >> 6, lane = tid & 63, quad = lane >> 4, l15 = lane & 15;
  const u16* W = (const u16*)(p.ws + OFF_SGUW) + ((size_t)(l * 4 + hd) * 128 + w * 16 + l15) * 128;
  const u16* VT = (const u16*)(p.ws + OFF_VT) + ((size_t)ck * 256 + hd * 64 + l15) * 128;
  f32x4 acc[4];
#pragma unroll
  for (int d = 0; d < 4; ++d) acc[d] = (f32x4){0.f, 0.f, 0.f, 0.f};
#pragma unroll
  for (int ks = 0; ks < 4; ++ks) {
    const int k0 = ks * 32 + quad * 8;
    bf16x8 af = ld_frag(W + k0);
#pragma unroll
    for (int d = 0; d < 4; ++d) acc[d] = mfma16(af, ld_frag(VT + (size_t)d * 16 * 128 + k0), acc[d]);
  }
  const float* proj = (const float*)(p.ws + OFF_PROJ);
  u16* MIX = (u16*)(p.ws + OFF_MIXED);
#pragma unroll
  for (int r = 0; r < 4; ++r) {
    const int q = w * 16 + quad * 4 + r;
    const float b = p.in[I_SGUB][(l * 4 + hd) * 128 + q];
    const size_t row = (size_t)ck * 128 + q;
#pragma unroll
    for (int d = 0; d < 4; ++d) {
      const int col = hd * 64 + d * 16 + l15;
      const float u = gelu_t(proj[row * IN_DIM + 1552 + col]);
      MIX[row * 1024 + 512 + col] = f2bf(u * (acc[d][r] + b));
    }
  }
}

__device__ __forceinline__ void ssd_out_item(const P& p, int l, int item, char* smem) {
  float* red = (float*)smem;
  const int ck = item >> 3, qb = item & 7;
  const int tid = otid(), h = tid >> 6, lane = tid & 63, quad = lane >> 4, l15 = lane & 15;
  const int g = h >> 2, q0 = qb * 16;
  const size_t row0 = (size_t)ck * 128;
  const u16* BM = (const u16*)(p.ws + OFF_BM);
  const u16* CM = (const u16*)(p.ws + OFF_CM);
  const float* DTf = (const float*)(p.ws + OFF_DT) + (size_t)((ck * 2 + 0) * 8 + h) * 128;
  const float* DTb = (const float*)(p.ws + OFF_DT) + (size_t)((ck * 2 + 1) * 8 + h) * 128;
  const float* CF = (const float*)(p.ws + OFF_CUM) + (size_t)((ck * 2 + 0) * 8 + h) * 128;
  const float* CB = (const float*)(p.ws + OFF_CUM) + (size_t)((ck * 2 + 1) * 8 + h) * 128;
  bf16x8 cmf[4];
#pragma unroll
  for (int ns = 0; ns < 4; ++ns) cmf[ns] = ld_frag(CM + (row0 + q0 + l15) * 256 + g * 128 + ns * 32 + quad * 8);
  const int q = q0 + l15;
  const float cfq = CF[q], cbq = CB[q];
  const float dsum = DTf[q] + DTb[q];
  const float Dh = p.in[I_SSDD][l * 8 + h];
  u32x4 As[4];
#pragma unroll
  for (int kt = 0; kt < 8; ++kt) {
    f32x4 aT = {0.f, 0.f, 0.f, 0.f};
#pragma unroll
    for (int ns = 0; ns < 4; ++ns)
      aT = mfma16(ld_frag(BM + (row0 + kt * 16 + l15) * 256 + g * 128 + ns * 32 + quad * 8), cmf[ns], aT);
    const int kb = kt * 16 + quad * 4;
    float m[4];
    if (kt < qb) {
      f32x4 c = *(const f32x4*)(CF + kb), d = *(const f32x4*)(DTf + kb);
#pragma unroll
      for (int r = 0; r < 4; ++r) m[r] = aT[r] * __expf(cfq - c[r]) * d[r];
    } else if (kt > qb) {
      f32x4 c = *(const f32x4*)(CB + kb), d = *(const f32x4*)(DTb + kb);
#pragma unroll
      for (int r = 0; r < 4; ++r) m[r] = aT[r] * __expf(cbq - c[r]) * d[r];
    } else {
      f32x4 c = *(const f32x4*)(CF + kb), d = *(const f32x4*)(DTf + kb);
      f32x4 c2 = *(const f32x4*)(CB + kb), d2 = *(const f32x4*)(DTb + kb);
#pragma unroll
      for (int r = 0; r < 4; ++r) {
        const int k = kb + r;
        float f;
        if (k < q) f = __expf(cfq - c[r]) * d[r];
        else if (k > q) f = __expf(cbq - c2[r]) * d2[r];
        else f = dsum;
        m[r] = aT[r] * f + (k == q ? Dh : 0.f);
      }
    }
    As[kt >> 1][(kt & 1) * 2 + 0] = pack2(m[0], m[1]);
    As[kt >> 1][(kt & 1) * 2 + 1] = pack2(m[2], m[3]);
  }
  asm volatile("" ::: "memory");
#pragma unroll
  for (int ns = 0; ns < 4; ++ns) cmf[ns] = ld_frag(CM + (row0 + q0 + l15) * 256 + g * 128 + ns * 32 + quad * 8);
  const u16* XST = (const u16*)(p.ws + OFF_XST) + ((size_t)(ck * 8 + h) * 64 + l15) * 128;
  const u16* HPf = (const u16*)(p.ws + OFF_HPREV) + ((size_t)((ck * 2 + 0) * 8 + h) * 64 + l15) * 128;
  const u16* HPb = (const u16*)(p.ws + OFF_HPREV) + ((size_t)((ck * 2 + 1) * 8 + h) * 64 + l15) * 128;
  const float* proj = (const float*)(p.ws + OFF_PROJ);
  float* ybuf = (float*)(smem + 1024) + (h * 16 + quad * 4) * 65 + l15;
  float ss[4] = {0.f, 0.f, 0.f, 0.f};
#pragma unroll
  for (int pt = 0; pt < 4; ++pt) {
    f32x4 aY = {0.f, 0.f, 0.f, 0.f}, aF = {0.f, 0.f, 0.f, 0.f}, aB = {0.f, 0.f, 0.f, 0.f};
#pragma unroll
    for (int s = 0; s < 4; ++s) {
      u32x2 lo = *(const u32x2*)(XST + (size_t)pt * 16 * 128 + (2 * s) * 16 + quad * 4);
      u32x2 hi = *(const u32x2*)(XST + (size_t)pt * 16 * 128 + (2 * s + 1) * 16 + quad * 4);
      u32x4 bv = {lo[0], lo[1], hi[0], hi[1]};
      aY = mfma16(__builtin_bit_cast(bf16x8, As[s]), __builtin_bit_cast(bf16x8, bv), aY);
    }
#pragma unroll
    for (int ns = 0; ns < 4; ++ns) {
      aF = mfma16(cmf[ns], ld_frag(HPf + (size_t)pt * 16 * 128 + ns * 32 + quad * 8), aF);
      aB = mfma16(cmf[ns], ld_frag(HPb + (size_t)pt * 16 * 128 + ns * 32 + quad * 8), aB);
    }
#pragma unroll
    for (int r = 0; r < 4; ++r) {
      const int qq = q0 + quad * 4 + r;
      float yv = aY[r] + __expf(CF[qq]) * aF[r] + __expf(CB[qq]) * aB[r];
      const float zv = proj[(row0 + qq) * IN_DIM + h * 64 + pt * 16 + l15];
      yv *= silu_f(zv);
      ybuf[r * 65 + pt * 16] = yv;
      ss[r] += yv * yv;
    }
  }
  const int lane2 = otid() & 63;
#pragma unroll
  for (int r = 0; r < 4; ++r) {
    float sv = ss[r];
#pragma unroll
    for (int o = 1; o < 16; o <<= 1) sv += shx(sv, o, lane2);
    ss[r] = sv;
  }
  if (l15 == 0) {
#pragma unroll
    for (int r = 0; r < 4; ++r) red[(quad * 4 + r) * 8 + h] = ss[r];
  }
  __syncthreads();
  u16* MIX = (u16*)(p.ws + OFF_MIXED);
  const float* ng = p.in[I_SSDNG] + l * 512 + h * 64;
#pragma unroll
  for (int r = 0; r < 4; ++r) {
    const int qq = q0 + quad * 4 + r;
    float tot = 0.f;
#pragma unroll
    for (int hh = 0; hh < 8; ++hh) tot += red[(quad * 4 + r) * 8 + hh];
    const float rinv = rsqrtf(tot * (1.f / 512.f) + 1e-6f);
#pragma unroll
    for (int pt = 0; pt < 4; ++pt) {
      const int pc = pt * 16 + l15;
      MIX[(row0 + qq) * 1024 + h * 64 + pc] = f2bf(ybuf[r * 65 + pt * 16] * rinv * ng[pc]);
    }
  }
  __syncthreads();
}

#define XB_TMO      128
#define XB_XCNT(j)  (256  + 64 * (j))
#define XB_XSUB(j)  (1280 + 64 * (j))
#define XB_XGEN(j)  (2304 + 64 * (j))
#define XB_TOP      3328
#define XB_TOPGEN   3392
#define XCD_BAR_WORDS 3456
#define XB_SPIN_CAP (1u << 18)
#define LAS __attribute__((address_space(3)))
__device__ __forceinline__ unsigned xb_ld(unsigned* p) { return __hip_atomic_load(p, __ATOMIC_RELAXED, __HIP_MEMORY_SCOPE_AGENT); }
__device__ __forceinline__ unsigned xb_add(unsigned* p, unsigned v) { return __hip_atomic_fetch_add(p, v, __ATOMIC_RELAXED, __HIP_MEMORY_SCOPE_AGENT); }
__device__ __forceinline__ unsigned xb_xcc_id() { return (unsigned)__builtin_amdgcn_s_getreg((3 << 11) | 20) & 0xFu; }
#define XB_SPIN(cond, bar) do { unsigned _sp = 0; while (cond) { __builtin_amdgcn_s_sleep(1); \
    if ((++_sp & 255u) == 0u) { if (xb_ld(&(bar)[XB_TMO])) break; if (_sp > XB_SPIN_CAP) { atomicAdd(&(bar)[XB_TMO], 1u); break; } } } } while (0)
struct XcdBarrier { unsigned* bar; unsigned x; volatile LAS unsigned* st; };
__device__ __forceinline__ XcdBarrier xcd_barrier_post(unsigned* bar, volatile LAS unsigned* st) {
  XcdBarrier b; b.bar = bar; b.x = xb_xcc_id(); b.st = st;
  if (threadIdx.x == 0) (void)xb_add(&bar[XB_XCNT(b.x)], 1u);
  return b;
}
__device__ __forceinline__ void xcd_barrier_complete(unsigned* bar, unsigned x, unsigned& nloc, unsigned& nx) {
  const unsigned G = gridDim.x * gridDim.y * gridDim.z;
  unsigned sum, cnt, mine, sp = 0u;
  for (;;) {
    sum = 0u; cnt = 0u; mine = 0u;
#pragma unroll
    for (unsigned j = 0; j < 16; ++j) { const unsigned c = xb_ld(&bar[XB_XCNT(j)]); sum += c; cnt += (c > 0u) ? 1u : 0u; mine = (j == x) ? c : mine; }
    if (sum == G) break;
    __builtin_amdgcn_s_sleep(1);
    if ((++sp & 255u) == 0u) { if (xb_ld(&bar[XB_TMO])) break; if (sp > XB_SPIN_CAP) { atomicAdd(&bar[XB_TMO], 1u); break; } }
  }
  nloc = mine > 0u ? mine : 1u; nx = cnt > 0u ? cnt : 1u;
}
__device__ __forceinline__ void xcd_barrier(const XcdBarrier& b) {
  asm volatile("s_waitcnt vmcnt(0)" ::: "memory");
  __syncthreads();
  if (threadIdx.x == 0) {
    unsigned* bar = b.bar;
    __builtin_amdgcn_s_waitcnt(0);
    unsigned nloc = b.st[0], nx = b.st[1];
    if (nloc == 0u) { xcd_barrier_complete(bar, b.x, nloc, nx); b.st[0] = nloc; b.st[1] = nx; }
    const unsigned old = xb_add(&bar[XB_XSUB(b.x)], 1u);
    const unsigned gen = old / nloc;
    if (old + 1u == (gen + 1u) * nloc) {
      __builtin_amdgcn_fence(__ATOMIC_RELEASE, "agent");
      asm volatile("s_waitcnt vmcnt(0)" ::: "memory");
      const unsigned og = xb_add(&bar[XB_TOP], 1u);
      const unsigned tg = og / nx;
      if (og + 1u == (tg + 1u) * nx) xb_add(&bar[XB_TOPGEN], 1u);
      else XB_SPIN(xb_ld(&bar[XB_TOPGEN]) == tg, bar);
      __builtin_amdgcn_fence(__ATOMIC_ACQUIRE, "agent");
      xb_add(&bar[XB_XGEN(b.x)], 1u);
      asm volatile("s_waitcnt vmcnt(0)" ::: "memory");
    } else {
      XB_SPIN(xb_ld(&bar[XB_XGEN(b.x)]) == gen, bar);
      __builtin_amdgcn_fence(__ATOMIC_ACQUIRE, "agent");
      asm volatile("s_waitcnt vmcnt(0)" ::: "memory");
    }
  }
  __syncthreads();
}

__device__ __forceinline__ int next_item(unsigned* ctr, int* slot) {
  __syncthreads();
  if (threadIdx.x == 0) *slot = (int)xb_add(ctr, 1u);
  __syncthreads();
  return *slot;
}

__device__ __forceinline__ void run_phase(const P& p, int ph, int rep, char* smem, int* qslot) {
  const int nb = gridDim.x, bid = obid();
  unsigned* qctr = (unsigned*)(p.ws + OFF_BAR) + 3520 + 16 * (ph * 2 + rep);
  if (ph == 0) {
    for (int it = bid; it < 96 + 16 + 1; it += nb) {
      if (it < 96) mod_item(p, it, smem);
      else if (it < 112) p0_sgu_item(p, it - 96);
      else s5_table_item(p);
    }
    p0_transposes(p, smem);
    return;
  }
  if (ph == 21) {
    norm_phase(p, 0, 2, (const float*)(p.ws + OFF_XB), (const float*)(p.ws + OFF_XB) + (size_t)4096 * 1024);
    return;
  }
  const int l = (ph - 1) / 10, sp = (ph - 1) % 10;
  const float* x0a = l == 0 ? p.in[I_XP] : (const float*)(p.ws + OFF_XB);
  const float* x0b = l == 0 ? p.in[I_XS] : (const float*)(p.ws + OFF_XB) + (size_t)4096 * 1024;
  const float* x1a = (const float*)(p.ws + OFF_XA);
  const float* x1b = x1a + (size_t)4096 * 1024;
  const float* mod = (const float*)(p.ws + OFF_MOD) + (size_t)l * 3 * 6144;
  Epi e{};
  switch (sp) {
    case 0: norm_phase(p, l, 0, x0a, x0b); break;
    case 1:
      e.outf = (float*)(p.ws + OFF_PROJ);
      gemm_phase<0, 1024>((const u16*)(p.ws + OFF_H), (const u16*)(p.ws + OFF_WIN_T) + (size_t)l * IN_PAD * 1024, 19, e, smem);
      break;
    case 2:
      for (int it = next_item(qctr, qslot); it < 48 * 18; it = next_item(qctr, qslot)) {
        if (it < 48) prep_v(p, l, it, smem);
        else if (it < 48 + 768) { int k = it - 48; prep_conv(p, l, k >> 4, k & 15, smem); }
        else prep_dt(p, l, it - 816, smem);
      }
      break;
    case 3: {
      constexpr int NA = 384 * ((DUP & 8) ? 2 : 1), NB = 768 * ((DUP & 16) ? 2 : 1);
      for (int it = next_item(qctr, qslot); it < NA + NB; it = next_item(qctr, qslot)) {
        if (it < NA) ssd_state_item(p, l, it % 384);
        else s5_local_item(p, l, (it - NA) % 768, smem);
      }
    } break;
    case 4: {
      constexpr int NA = 384 * ((DUP & 1) ? 2 : 1), NB = 768 * ((DUP & 2) ? 2 : 1), NC = 192 * ((DUP & 4) ? 2 : 1);
      for (int it = next_item(qctr, qslot); it < NA + NB + NC; it = next_item(qctr, qslot)) {
        if (it < NA) ssd_out_item(p, l, it % 384, smem);
        else if (it < NA + NB) s5_out_item(p, l, (it - NA) % 768, smem);
        else sgu_item(p, l, (it - NA - NB) % 192);
      }
    } break;
    case 5:
      e.outb = (u16*)(p.ws + OFF_MIXED);
      e.y1 = (const u16*)(p.ws + OFF_Y1B);
      e.bias = p.in[I_GLUB] + l * 256;
      gemm_phase<3, 256>((const u16*)(p.ws + OFF_Y1B), (const u16*)(p.ws + OFF_GLU_T) + (size_t)l * 256 * 256, 2, e, smem);
      break;
    case 6:
      e.outf = (float*)(p.ws + OFF_XA);
      e.xa = x0a; e.xb = x0b; e.gate = mod + 2048;
      gemm_phase<1, 1024>((const u16*)(p.ws + OFF_MIXED), (const u16*)(p.ws + OFF_WOUT_T) + (size_t)l * 1024 * 1024, 8, e, smem);
      break;
    case 7: norm_phase(p, l, 1, x1a, x1b); break;
    case 8:
      e.outb = (u16*)(p.ws + OFF_PROJ);
      gemm_phase<2, 1024>((const u16*)(p.ws + OFF_H), (const u16*)(p.ws + OFF_W1_T) + (size_t)l * 4096 * 1024, 32, e, smem);
      break;
    case 9:
      e.outf = (float*)(p.ws + OFF_XB);
      e.xa = x1a; e.xb = x1b; e.gate = mod + 5120;
      gemm_phase<1, 4096>((const u16*)(p.ws + OFF_PROJ), (const u16*)(p.ws + OFF_W2_T) + (size_t)l * 1024 * 4096, 8, e, smem);
      break;
  }
}

#ifndef REP_MASK
#define REP_MASK 0
#endif
__device__ __forceinline__ int phase_type(int ph) { return ph == 0 ? 10 : ph == 21 ? 11 : (ph - 1) % 10; }

__global__ void __launch_bounds__(512) mega(P p, int ph_lo, int ph_hi, int coop) {
  __shared__ __attribute__((aligned(16))) char smem[SMEM_BYTES];
  __shared__ __attribute__((aligned(16))) unsigned xb_words[4];
  XcdBarrier xb;
  if (coop) {
    if (threadIdx.x < 4) xb_words[threadIdx.x] = 0u;
    __syncthreads();
    xb = xcd_barrier_post((unsigned*)(p.ws + OFF_BAR), (volatile LAS unsigned*)xb_words);
  }
  for (int ph = ph_lo; ph < ph_hi; ++ph) {
    const int reps = ((REP_MASK >> phase_type(ph)) & 1) ? 2 : 1;
    for (int r = 0; r < reps; ++r) run_phase(p, ph, r, smem, (int*)&xb_words[2]);
    if (coop == 1 && ph + 1 < ph_hi) xcd_barrier(xb);
    if (coop == 2) cg::this_grid().sync();
  }
}

extern "C" void kernel_launch(void* const* d_in, const int* in_sizes, int n_in, void* d_out, int out_size, void* d_ws,
                              size_t ws_size, hipStream_t stream) {
  static int grid_blocks = 0;
  if (!grid_blocks) {
    int dev = 0, cus = 0, per_cu = 0;
    hipGetDevice(&dev);
    hipDeviceGetAttribute(&cus, hipDeviceAttributeMultiprocessorCount, dev);
    hipOccupancyMaxActiveBlocksPerMultiprocessor(&per_cu, mega, 512, 0);
    if (per_cu < 1) per_cu = 1;
    grid_blocks = cus * per_cu;
  }
  P p{};
  for (int i = 0; i < 35; ++i) p.in[i] = (const float*)d_in[i];
  p.out = (float*)d_out;
  p.ws = (char*)d_ws;
  if (ws_size < WS_TOTAL) { fprintf(stderr, "workspace too small: %zu < %zu\n", ws_size, (size_t)WS_TOTAL); return; }
#if COOP
  hipMemsetAsync((char*)d_ws + OFF_BAR, 0, 65536, stream);
  int lo = 0, hi = 22, coop = 1;
  void* args[] = {&p, &lo, &hi, &coop};
  hipError_t err = hipLaunchCooperativeKernel((void*)mega, dim3(grid_blocks), dim3(512), args, 0, stream);
  if (err != hipSuccess) fprintf(stderr, "cooperative launch failed: %s (grid %d)\n", hipGetErrorString(err), grid_blocks);
#else
  for (int ph = 0; ph < 22; ++ph) mega<<<dim3(grid_blocks), dim3(512), 0, stream>>>(p, ph, ph + 1, 0);
#endif
}
```

```cpp
#include <hip/hip_runtime.h>
#include <hip/hip_cooperative_groups.h>
#include <cstdio>
namespace cg = cooperative_groups;

#define DUP 0
#ifndef COOP
#define COOP 1
#endif

typedef unsigned short u16;
typedef __attribute__((ext_vector_type(8))) short bf16x8;
typedef __attribute__((ext_vector_type(4))) float f32x4;
typedef __attribute__((ext_vector_type(4))) unsigned int u32x4;
typedef __attribute__((ext_vector_type(2))) unsigned int u32x2;

constexpr int T_TOK = 6144;
constexpr int DM = 1024;
constexpr int IN_DIM = 2320;
constexpr int IN_PAD = 2432;
constexpr int DFF = 4096;
constexpr int SMEM_BYTES = 143360;

constexpr size_t OFF_WIN_T = 0;
constexpr size_t OFF_WOUT_T = OFF_WIN_T + (size_t)2 * IN_PAD * 1024 * 2;
constexpr size_t OFF_W1_T = OFF_WOUT_T + (size_t)2 * 1024 * 1024 * 2;
constexpr size_t OFF_W2_T = OFF_W1_T + (size_t)2 * 4096 * 1024 * 2;
constexpr size_t OFF_GLU_T = OFF_W2_T + (size_t)2 * 4096 * 1024 * 2;
constexpr size_t OFF_SGUW = OFF_GLU_T + (size_t)2 * 256 * 256 * 2;
constexpr size_t OFF_MOD = OFF_SGUW + (size_t)2 * 4 * 128 * 128 * 2;
constexpr size_t OFF_H = OFF_MOD + (size_t)2 * 3 * 6144 * 4;
constexpr size_t OFF_PROJ = OFF_H + (size_t)T_TOK * 1024 * 2;
constexpr size_t OFF_MIXED = OFF_PROJ + (size_t)T_TOK * IN_DIM * 4;
constexpr size_t OFF_XA = OFF_MIXED + (size_t)T_TOK * 1024 * 2;
constexpr size_t OFF_XB = OFF_XA + (size_t)T_TOK * 1024 * 4;
constexpr size_t OFF_HPREV = OFF_XB + (size_t)T_TOK * 1024 * 4;
constexpr size_t OFF_BM = OFF_HPREV + (size_t)48 * 2 * 8 * 64 * 128 * 2;
constexpr size_t OFF_CM = OFF_BM + (size_t)T_TOK * 256 * 2;
constexpr size_t OFF_BMT = OFF_CM + (size_t)T_TOK * 256 * 2;
constexpr size_t OFF_XST = OFF_BMT + (size_t)48 * 2 * 128 * 128 * 2;
constexpr size_t OFF_VT = OFF_XST + (size_t)48 * 8 * 64 * 128 * 2;
constexpr size_t OFF_DT = OFF_VT + (size_t)48 * 256 * 128 * 2;
constexpr size_t OFF_CUM = OFF_DT + (size_t)48 * 2 * 8 * 128 * 4;
constexpr size_t OFF_WDEC = OFF_CUM + (size_t)48 * 2 * 8 * 128 * 4;
constexpr size_t OFF_S5E = OFF_WDEC + (size_t)48 * 2 * 8 * 128 * 4;
constexpr size_t OFF_Y1B = OFF_S5E + (size_t)192 * 16 * 2 * 64 * 8;
constexpr size_t OFF_S5TAB = OFF_Y1B + (size_t)T_TOK * 256 * 2;
constexpr size_t OFF_S5BB = OFF_S5TAB + (size_t)4096 * 32;
constexpr size_t OFF_BAR = OFF_S5BB + (size_t)64 * 128 * 16 * 2;
constexpr size_t WS_TOTAL = OFF_BAR + 65536;

constexpr size_t OUT_SSD = (size_t)T_TOK * 1024;
constexpr size_t OUT_S5RE = OUT_SSD + (size_t)16 * 2 * 2 * 8 * 64 * 128;
constexpr size_t OUT_S5IM = OUT_S5RE + (size_t)16 * 2 * 2 * 16 * 64;

struct P {
  const float* in[35];
  float* out;
  char* ws;
};

enum { I_XP = 0, I_XS, I_SSSD, I_SS5R, I_SS5I, I_C, I_CCTX, I_ADAW, I_ADAB, I_N1G, I_N2G, I_WIN, I_CONVW, I_CONVB,
       I_DTB, I_ALOG, I_SSDD, I_SSDNG, I_SGUNG, I_SGUW, I_SGUB, I_LRE, I_LIM, I_LOGDT, I_BRE, I_BIM, I_CRE, I_CIM,
       I_S5D, I_GLUW, I_GLUB, I_WOUT, I_W1, I_W2, I_FNG };

__device__ __forceinline__ int otid() { int t = threadIdx.x; asm volatile("" : "+v"(t)); return t; }
__device__ __forceinline__ int obid() { int t = blockIdx.x; asm volatile("" : "+s"(t)); return t; }
__device__ __forceinline__ u16 f2bf(float f) {
  unsigned u = __float_as_uint(f);
  u += 0x7fffu + ((u >> 16) & 1u);
  return (u16)(u >> 16);
}
__device__ __forceinline__ float bf2f(u16 h) { return __uint_as_float(((unsigned)h) << 16); }
__device__ __forceinline__ unsigned pack2(float a, float b) { return (unsigned)f2bf(a) | ((unsigned)f2bf(b) << 16); }

__device__ __forceinline__ float gelu_t(float x) {
  float y = 0.7978845608028654f * (x + 0.044715f * x * x * x);
  float t = __expf(2.f * y);
  float th = 1.f - 2.f / (t + 1.f);
  return 0.5f * x * (1.f + th);
}
__device__ __forceinline__ float sigmoid_f(float x) { return 1.f / (1.f + __expf(-x)); }
__device__ __forceinline__ float silu_f(float x) { return x / (1.f + __expf(-x)); }
__device__ __forceinline__ float softplus_f(float x) { return x > 20.f ? x : log1pf(expf(x)); }

__device__ __forceinline__ f32x4 mfma16(bf16x8 a, bf16x8 b, f32x4 c) {
  return __builtin_amdgcn_mfma_f32_16x16x32_bf16(a, b, c, 0, 0, 0);
}
__device__ __forceinline__ bf16x8 ld_frag(const u16* ptr) {
  return __builtin_bit_cast(bf16x8, *(const u32x4*)ptr);
}

__device__ __forceinline__ void mod_item(const P& p, int it, char* smem) {
  float* red = (float*)smem;
  const int tid = otid();
  const int l = it / 48, jb = it % 48;
  const int j0 = jb * 128;
  const int jq = tid & 31, kg = tid >> 5;
  const float* aw = p.in[I_ADAW] + (size_t)l * 1024 * 6144;
  float acc[3][4];
#pragma unroll
  for (int m = 0; m < 3; ++m)
#pragma unroll
    for (int j = 0; j < 4; ++j) acc[m][j] = 0.f;
  for (int kk = 0; kk < 64; ++kk) {
    int k = kg * 64 + kk;
    f32x4 w = *(const f32x4*)(aw + (size_t)k * 6144 + j0 + jq * 4);
    float c0 = silu_f(p.in[I_CCTX][k]);
    float c1 = silu_f(p.in[I_C][k]);
    float c2 = silu_f(p.in[I_C][1024 + k]);
#pragma unroll
    for (int j = 0; j < 4; ++j) {
      acc[0][j] += c0 * w[j];
      acc[1][j] += c1 * w[j];
      acc[2][j] += c2 * w[j];
    }
  }
#pragma unroll
  for (int m = 0; m < 3; ++m)
#pragma unroll
    for (int j = 0; j < 4; ++j) red[(kg * 3 + m) * 128 + jq * 4 + j] = acc[m][j];
  __syncthreads();
  if (tid < 384) {
    int m = tid >> 7, j = tid & 127;
    float s = p.in[I_ADAB][l * 6144 + j0 + j];
    for (int g = 0; g < 16; ++g) s += red[(g * 3 + m) * 128 + j];
    float* mod = (float*)(p.ws + OFF_MOD);
    mod[(l * 3 + m) * 6144 + j0 + j] = s;
  }
  __syncthreads();
}

__device__ __forceinline__ void transpose_tile(const float* src, int K, int N, u16* dst, int k0, int n0, char* smem) {
  float* tile = (float*)smem;
  const int tid = otid();
#pragma unroll
  for (int i = 0; i < 4; ++i) {
    int k = (tid >> 4) + 32 * i, n4 = tid & 15;
    int n = n0 + n4 * 4;
    f32x4 v = {0.f, 0.f, 0.f, 0.f};
    if (n < N) v = *(const f32x4*)(src + (size_t)(k0 + k) * N + n);
    float* d = tile + k * 65 + n4 * 4;
    d[0] = v[0]; d[1] = v[1]; d[2] = v[2]; d[3] = v[3];
  }
  __syncthreads();
#pragma unroll
  for (int i = 0; i < 2; ++i) {
    int slot = tid + i * 512;
    int n = slot >> 4, kg = slot & 15;
    u32x4 o;
#pragma unroll
    for (int j = 0; j < 4; ++j)
      o[j] = pack2(tile[(kg * 8 + 2 * j) * 65 + n], tile[(kg * 8 + 2 * j + 1) * 65 + n]);
    *(u32x4*)(dst + (size_t)(n0 + n) * K + k0 + kg * 8) = o;
  }
  __syncthreads();
}

struct TrDesc { const float* src; u16* dst; int K, N, k0, n0; };
__device__ __forceinline__ TrDesc tr_decode(const P& p, int it) {
  TrDesc d;
  int l = it / 1464, r = it % 1464, nt;
  if (r < 304) { d.src = p.in[I_WIN] + (size_t)l * 1024 * IN_DIM; d.dst = (u16*)(p.ws + OFF_WIN_T) + (size_t)l * IN_PAD * 1024; d.K = 1024; d.N = IN_DIM; nt = 38; }
  else if (r < 432) { r -= 304; d.src = p.in[I_WOUT] + (size_t)l * 1024 * 1024; d.dst = (u16*)(p.ws + OFF_WOUT_T) + (size_t)l * 1024 * 1024; d.K = 1024; d.N = 1024; nt = 16; }
  else if (r < 944) { r -= 432; d.src = p.in[I_W1] + (size_t)l * 1024 * 4096; d.dst = (u16*)(p.ws + OFF_W1_T) + (size_t)l * 4096 * 1024; d.K = 1024; d.N = 4096; nt = 64; }
  else if (r < 1456) { r -= 944; d.src = p.in[I_W2] + (size_t)l * 4096 * 1024; d.dst = (u16*)(p.ws + OFF_W2_T) + (size_t)l * 1024 * 4096; d.K = 4096; d.N = 1024; nt = 16; }
  else { r -= 1456; d.src = p.in[I_GLUW] + (size_t)l * 256 * 256; d.dst = (u16*)(p.ws + OFF_GLU_T) + (size_t)l * 256 * 256; d.K = 256; d.N = 256; nt = 4; }
  d.k0 = (r / nt) * 128; d.n0 = (r % nt) * 64;
  return d;
}
__device__ __forceinline__ void tr_load(const TrDesc& d, int tid, f32x4 (&v)[4]) {
#pragma unroll
  for (int i = 0; i < 4; ++i) {
    const int k = (tid >> 4) + 32 * i, n = d.n0 + (tid & 15) * 4;
    v[i] = (f32x4){0.f, 0.f, 0.f, 0.f};
    if (n < d.N) v[i] = *(const f32x4*)(d.src + (size_t)(d.k0 + k) * d.N + n);
  }
}
__device__ __forceinline__ void p0_transposes(const P& p, char* smem) {
  float* tile = (float*)smem;
  const int tid = otid(), nb = gridDim.x;
  int cur = obid();
  if (cur >= 2928) return;
  f32x4 v[4];
  TrDesc d = tr_decode(p, cur);
  tr_load(d, tid, v);
  while (cur < 2928) {
    __syncthreads();
#pragma unroll
    for (int i = 0; i < 4; ++i) {
      float* q = tile + ((tid >> 4) + 32 * i) * 65 + (tid & 15) * 4;
      q[0] = v[i][0]; q[1] = v[i][1]; q[2] = v[i][2]; q[3] = v[i][3];
    }
    __syncthreads();
    const int nxt = cur + nb;
    TrDesc dn = d;
    if (nxt < 2928) { dn = tr_decode(p, nxt); tr_load(dn, tid, v); }
#pragma unroll
    for (int i = 0; i < 2; ++i) {
      const int slot = tid + i * 512;
      const int n = slot >> 4, kg = slot & 15;
      u32x4 o;
#pragma unroll
      for (int j = 0; j < 4; ++j) o[j] = pack2(tile[(kg * 8 + 2 * j) * 65 + n], tile[(kg * 8 + 2 * j + 1) * 65 + n]);
      *(u32x4*)(d.dst + (size_t)(d.n0 + n) * d.K + d.k0 + kg * 8) = o;
    }
    d = dn; cur = nxt;
  }
  __syncthreads();
}
__device__ __forceinline__ void p0_sgu_item(const P& p, int it) {
  const float* src = p.in[I_SGUW] + (size_t)it * 8192;
  u16* dst = (u16*)(p.ws + OFF_SGUW) + (size_t)it * 8192;
  const int tid = otid();
#pragma unroll
  for (int i = 0; i < 2; ++i) {
    int e = (tid + i * 512) * 8;
    f32x4 a = *(const f32x4*)(src + e), b = *(const f32x4*)(src + e + 4);
    u32x4 o = {pack2(a[0], a[1]), pack2(a[2], a[3]), pack2(b[0], b[1]), pack2(b[2], b[3])};
    *(u32x4*)(dst + e) = o;
  }
}

__device__ __forceinline__ float shx(float v, int o, int lane) {
  return __int_as_float(__builtin_amdgcn_ds_bpermute((lane ^ o) << 2, __float_as_int(v)));
}
__device__ __forceinline__ float wave_sum(float v, int lane) {
#pragma unroll
  for (int o = 32; o > 0; o >>= 1) v += shx(v, o, lane);
  return v;
}

__device__ __forceinline__ void norm_phase(const P& p, int l, int mode, const float* xa, const float* xb) {
  const int tid = otid(), w = tid >> 6, lane = tid & 63;
  const float* mod = (const float*)(p.ws + OFF_MOD);
  u16* H = (u16*)(p.ws + OFF_H);
  const float* g = mode == 0 ? p.in[I_N1G] + l * 1024 : mode == 1 ? p.in[I_N2G] + l * 1024 : p.in[I_FNG];
  for (int row = obid() * 8 + w; row < T_TOK; row += gridDim.x * 8) {
    const float* x = row < 4096 ? xa + (size_t)row * 1024 : xb + (size_t)(row - 4096) * 1024;
    f32x4 v[4];
    float ss = 0.f;
#pragma unroll
    for (int i = 0; i < 4; ++i) {
      v[i] = *(const f32x4*)(x + i * 256 + lane * 4);
#pragma unroll
      for (int j = 0; j < 4; ++j) ss += v[i][j] * v[i][j];
    }
    ss = wave_sum(ss, lane);
    float rinv = rsqrtf(ss * (1.f / 1024.f) + 1e-6f);
    int m = row < 4096 ? 0 : 1 + ((row - 4096) >> 10);
    const float* mb = mod + (size_t)(l * 3 + m) * 6144 + (mode == 1 ? 3072 : 0);
#pragma unroll
    for (int i = 0; i < 4; ++i) {
      int c = i * 256 + lane * 4;
      f32x4 gg = *(const f32x4*)(g + c);
      if (mode == 2) {
        f32x4 o;
#pragma unroll
        for (int j = 0; j < 4; ++j) o[j] = v[i][j] * rinv * gg[j];
        *(f32x4*)(p.out + (size_t)row * 1024 + c) = o;
      } else {
        f32x4 sh = *(const f32x4*)(mb + c);
        f32x4 sc = *(const f32x4*)(mb + 1024 + c);
        float o[4];
#pragma unroll
        for (int j = 0; j < 4; ++j) o[j] = v[i][j] * rinv * gg[j] * (1.f + sc[j]) + sh[j];
        u32x2 pk = {pack2(o[0], o[1]), pack2(o[2], o[3])};
        *(u32x2*)(H + (size_t)row * 1024 + c) = pk;
      }
    }
  }
}

struct Epi {
  float* outf;
  u16* outb;
  const float* xa;
  const float* xb;
  const float* gate;
  const u16* y1;
  const float* bias;
};

template <int EPI, int K>
__device__ __forceinline__ void gemm_phase(const u16* A, const u16* Bt, int ntn, const Epi& e, char* smem) {
  constexpr int LS = 72;
  constexpr int nk = K >> 6;
  u16* sA = (u16*)smem;
  u16* sB = sA + 2 * 192 * LS;
  const int tid = otid(), w = tid >> 6, lane = tid & 63, quad = lane >> 4, l15 = lane & 15;
  const int wm = w >> 1, wn = w & 1;
  const int lrow = tid >> 3, lkc = tid & 7;
  const int ntiles = 32 * ntn;
  const int bid = obid(), nb = gridDim.x;
  if (bid >= ntiles) return;
  const int total = ((ntiles - bid + nb - 1) / nb) * nk;
  u32x4 ra0[3], rb0[2], ra1[3], rb1[2];
  f32x4 acc[3][4];
#pragma unroll
  for (int i = 0; i < 3; ++i)
#pragma unroll
    for (int j = 0; j < 4; ++j) acc[i][j] = (f32x4){0.f, 0.f, 0.f, 0.f};
  auto issue = [&](u32x4 (&ra)[3], u32x4 (&rb)[2], int pos) {
    const int t = bid + (pos / nk) * nb, ks = pos % nk;
    const u16* ap = A + (size_t)((t & 31) * 192 + lrow) * K + lkc * 8 + ks * 64;
    const u16* bp = Bt + (size_t)((t >> 5) * 128 + lrow) * K + lkc * 8 + ks * 64;
#pragma unroll
    for (int i = 0; i < 3; ++i) ra[i] = *(const u32x4*)(ap + (size_t)i * 64 * K);
#pragma unroll
    for (int i = 0; i < 2; ++i) rb[i] = *(const u32x4*)(bp + (size_t)i * 64 * K);
  };
  auto stash = [&](u32x4 (&ra)[3], u32x4 (&rb)[2], int buf) {
#pragma unroll
    for (int i = 0; i < 3; ++i) *(u32x4*)(sA + buf * 192 * LS + (lrow + i * 64) * LS + lkc * 8) = ra[i];
#pragma unroll
    for (int i = 0; i < 2; ++i) *(u32x4*)(sB + buf * 128 * LS + (lrow + i * 64) * LS + lkc * 8) = rb[i];
  };
  auto body = [&](u32x4 (&ra)[3], u32x4 (&rb)[2], int pos) {
    if (pos + 1 < total) stash(ra, rb, (pos + 1) & 1);
    if (pos + 3 < total) issue(ra, rb, pos + 3);
    const int buf = pos & 1;
    const u16* cA = sA + buf * 192 * LS + (wm * 48 + l15) * LS + quad * 8;
    const u16* cB = sB + buf * 128 * LS + (wn * 64 + l15) * LS + quad * 8;
    {
      bf16x8 af[2][3], bq[2][4];
#pragma unroll
      for (int kk = 0; kk < 2; ++kk) {
#pragma unroll
        for (int i = 0; i < 3; ++i) af[kk][i] = ld_frag(cA + i * 16 * LS + kk * 32);
#pragma unroll
        for (int j = 0; j < 4; ++j) bq[kk][j] = ld_frag(cB + j * 16 * LS + kk * 32);
      }
      __builtin_amdgcn_s_setprio(1);
#pragma unroll
      for (int kk = 0; kk < 2; ++kk)
#pragma unroll
        for (int j = 0; j < 4; ++j)
#pragma unroll
          for (int i = 0; i < 3; ++i) acc[i][j] = mfma16(af[kk][i], bq[kk][j], acc[i][j]);
      __builtin_amdgcn_s_setprio(0);
    }
    if ((pos % nk) == nk - 1) {
      const int t = bid + (pos / nk) * nb;
      const int m0 = (t & 31) * 192, n0 = (t >> 5) * 128;
#pragma unroll
      for (int i = 0; i < 3; ++i)
#pragma unroll
        for (int j = 0; j < 4; ++j) {
#pragma unroll
          for (int r = 0; r < 4; ++r) {
            const int row = m0 + wm * 48 + i * 16 + quad * 4 + r;
            const int col = n0 + wn * 64 + j * 16 + l15;
            const float a = acc[i][j][r];
            if (EPI == 0) {
              if (col < IN_DIM) e.outf[(size_t)row * IN_DIM + col] = a;
            } else if (EPI == 1) {
              const float x = row < 4096 ? e.xa[(size_t)row * 1024 + col] : e.xb[(size_t)(row - 4096) * 1024 + col];
              const int m = row < 4096 ? 0 : 1 + ((row - 4096) >> 10);
              e.outf[(size_t)row * 1024 + col] = x + e.gate[m * 6144 + col] * a;
            } else if (EPI == 2) {
              const float rl = a > 0.f ? a : 0.f;
              e.outb[(size_t)row * DFF + col] = f2bf(rl * rl);
            } else {
              const float g = sigmoid_f(a + e.bias[col]);
              const float y = bf2f(e.y1[(size_t)row * 256 + col]);
              e.outb[(size_t)row * 1024 + 768 + col] = f2bf(y * g);
            }
          }
          acc[i][j] = (f32x4){0.f, 0.f, 0.f, 0.f};
        }
    }
    __syncthreads();
  };
  issue(ra0, rb0, 0);
  if (1 < total) issue(ra1, rb1, 1);
  stash(ra0, rb0, 0);
  if (2 < total) issue(ra0, rb0, 2);
  __syncthreads();
  for (int pos = 0; pos < total; pos += 2) {
    body(ra1, rb1, pos);
    if (pos + 1 < total) body(ra0, rb0, pos + 1);
  }
}

__device__ __forceinline__ void prep_conv(const P& p, int l, int ck, int s, char* smem) {
  float* tile = (float*)smem;
  const int tid = otid();
  const int row0 = ck * 128;
  int seq_lo, seq_hi;
  if (ck < 32) { seq_lo = (ck >> 1) * 256; seq_hi = seq_lo + 256; }
  else { seq_lo = 4096 + ((ck - 32) >> 3) * 1024; seq_hi = seq_lo + 1024; }
  const float* proj = (const float*)(p.ws + OFF_PROJ);
  const int c0 = s * 64;
  for (int id = tid; id < 132 * 16; id += 512) {
    int r = id >> 4, c4 = id & 15;
    int row = row0 - 2 + r;
    f32x4 v = {0.f, 0.f, 0.f, 0.f};
    if (row >= seq_lo && row < seq_hi) v = *(const f32x4*)(proj + (size_t)row * IN_DIM + 512 + c0 + c4 * 4);
    float* d = tile + r * 65 + c4 * 4;
    d[0] = v[0]; d[1] = v[1]; d[2] = v[2]; d[3] = v[3];
  }
  __syncthreads();
  const float* cw = p.in[I_CONVW] + (size_t)l * 5 * 1024;
  const float* cb = p.in[I_CONVB] + (size_t)l * 1024;
  if (s < 12) {
    u16* dstbase;
    if (s < 8) dstbase = (u16*)(p.ws + OFF_XST) + (size_t)(ck * 8 + s) * 64 * 128;
    else dstbase = (u16*)(p.ws + OFF_BMT) + ((size_t)(ck * 2 + ((s - 8) >> 1)) * 128 + ((s - 8) & 1) * 64) * 128;
#pragma unroll
    for (int it = 0; it < 2; ++it) {
      int slot = tid + it * 512;
      int pl = slot & 63, ig = slot >> 6;
      int c = c0 + pl;
      float w0 = cw[c], w1 = cw[1024 + c], w2 = cw[2048 + c], w3 = cw[3072 + c], w4 = cw[4096 + c], bb = cb[c];
      float o[8];
#pragma unroll
      for (int j = 0; j < 8; ++j) {
        int i = ig * 8 + j;
        float a = bb + tile[i * 65 + pl] * w0 + tile[(i + 1) * 65 + pl] * w1 + tile[(i + 2) * 65 + pl] * w2 +
                  tile[(i + 3) * 65 + pl] * w3 + tile[(i + 4) * 65 + pl] * w4;
        o[j] = silu_f(a);
      }
      u32x4 pk = {pack2(o[0], o[1]), pack2(o[2], o[3]), pack2(o[4], o[5]), pack2(o[6], o[7])};
      *(u32x4*)(dstbase + (size_t)pl * 128 + ig * 8) = pk;
    }
  }
  if (s >= 8) {
    u16* dstbase = s < 12 ? (u16*)(p.ws + OFF_BM) + (s - 8) * 64 : (u16*)(p.ws + OFF_CM) + (s - 12) * 64;
#pragma unroll
    for (int it = 0; it < 2; ++it) {
      int slot = tid + it * 512;
      int cg8 = slot & 7, i = slot >> 3;
      float o[8];
#pragma unroll
      for (int j = 0; j < 8; ++j) {
        int pl = cg8 * 8 + j;
        int c = c0 + pl;
        float a = cb[c] + tile[i * 65 + pl] * cw[c] + tile[(i + 1) * 65 + pl] * cw[1024 + c] +
                  tile[(i + 2) * 65 + pl] * cw[2048 + c] + tile[(i + 3) * 65 + pl] * cw[3072 + c] +
                  tile[(i + 4) * 65 + pl] * cw[4096 + c];
        o[j] = silu_f(a);
      }
      u32x4 pk = {pack2(o[0], o[1]), pack2(o[2], o[3]), pack2(o[4], o[5]), pack2(o[6], o[7])};
      *(u32x4*)(dstbase + (size_t)(row0 + i) * 256 + cg8 * 8) = pk;
    }
  }
  __syncthreads();
}

__device__ __forceinline__ void prep_dt(const P& p, int l, int ck, char* smem) {
  float* dts = (float*)smem;
  const int tid = otid();
  const float* proj = (const float*)(p.ws + OFF_PROJ);
  const int row0 = ck * 128;
#pragma unroll
  for (int it = 0; it < 4; ++it) {
    int i = (tid >> 4) + it * 32, col = tid & 15;
    float x = proj[(size_t)(row0 + i) * IN_DIM + 1536 + col] + p.in[I_DTB][l * 16 + col];
    dts[i * 16 + col] = softplus_f(x);
  }
  __syncthreads();
  if (tid < 16) {
    const int dir = tid >> 3, h = tid & 7;
    const float a = -expf(p.in[I_ALOG][l * 16 + tid]);
    float* DT = (float*)(p.ws + OFF_DT) + (size_t)((ck * 2 + dir) * 8 + h) * 128;
    float* CUM = (float*)(p.ws + OFF_CUM) + (size_t)((ck * 2 + dir) * 8 + h) * 128;
    float* WD = (float*)(p.ws + OFF_WDEC) + (size_t)((ck * 2 + dir) * 8 + h) * 128;
    float run = 0.f;
    if (dir == 0) {
      for (int i = 0; i < 128; ++i) { float d = dts[i * 16 + tid]; run += d * a; DT[i] = d; CUM[i] = run; dts[i * 16 + tid] = run; }
    } else {
      for (int i = 127; i >= 0; --i) { float d = dts[i * 16 + tid]; run += d * a; DT[i] = d; CUM[i] = run; dts[i * 16 + tid] = run; }
    }
    for (int i = 0; i < 128; ++i) WD[i] = DT[i] * __expf(run - dts[i * 16 + tid]);
  }
  __syncthreads();
}

__device__ __forceinline__ void prep_v(const P& p, int l, int ck, char* smem) {
  u16* tl = (u16*)smem;
  const int tid = otid(), w = tid >> 6, lane = tid & 63;
  const float* proj = (const float*)(p.ws + OFF_PROJ);
  const int row0 = ck * 128;
  const f32x4 g = *(const f32x4*)(p.in[I_SGUNG] + l * 256 + lane * 4);
  for (int rr = 0; rr < 16; ++rr) {
    int i = w * 16 + rr;
    f32x4 v = *(const f32x4*)(proj + (size_t)(row0 + i) * IN_DIM + 1552 + 256 + lane * 4);
    float ss = 0.f;
#pragma unroll
    for (int j = 0; j < 4; ++j) { v[j] = gelu_t(v[j]); ss += v[j] * v[j]; }
    ss = wave_sum(ss, lane);
    float rinv = rsqrtf(ss * (1.f / 256.f) + 1e-6f);
    u32x2 pk = {pack2(v[0] * rinv * g[0], v[1] * rinv * g[1]), pack2(v[2] * rinv * g[2], v[3] * rinv * g[3])};
    *(u32x2*)(tl + i * 264 + lane * 4) = pk;
  }
  __syncthreads();
  u16* VT = (u16*)(p.ws + OFF_VT) + (size_t)ck * 256 * 128;
#pragma unroll
  for (int it = 0; it < 8; ++it) {
    int c = tid & 255, ig = (tid >> 8) + 2 * it;
    u32x4 pk;
#pragma unroll
    for (int j = 0; j < 4; ++j)
      pk[j] = (unsigned)tl[(ig * 8 + 2 * j) * 264 + c] | ((unsigned)tl[(ig * 8 + 2 * j + 1) * 264 + c] << 16);
    *(u32x4*)(VT + (size_t)c * 128 + ig * 8) = pk;
  }
  __syncthreads();
}

template <int NT, bool PIPE>
__device__ __forceinline__ void ssd_state_chain(const P& p, int l, int sq, int h, int dir, int pt, int ntile0) {
  const int g = h >> 2;
  const bool lat = sq >= 16;
  const int nck = lat ? 8 : 2;
  const int ck0 = lat ? 32 + (sq - 16) * 8 : sq * 2;
  const int tid = otid(), w = tid >> 6, lane = tid & 63, quad = lane >> 4, l15 = lane & 15;
  const int lane_off = (pt * 16 + quad * 4) * 128 + ntile0 * 16 + l15;
  f32x4 acc[NT];
  if (lat) {
    const float* s0 = p.in[I_SSSD] + ((size_t)((((sq - 16) * 2 + l) * 2 + dir) * 8 + h) * 64) * 128;
#pragma unroll
    for (int nt = 0; nt < NT; ++nt)
#pragma unroll
      for (int r = 0; r < 4; ++r) acc[nt][r] = (s0 + lane_off)[r * 128 + nt * 16];
  } else {
#pragma unroll
    for (int nt = 0; nt < NT; ++nt) acc[nt] = (f32x4){0.f, 0.f, 0.f, 0.f};
  }
  const u16* XST = (const u16*)(p.ws + OFF_XST);
  const u16* BMT = (const u16*)(p.ws + OFF_BMT);
  u16* HPREV = (u16*)(p.ws + OFF_HPREV);
  u32x4 xr[4];
  f32x4 ww[4][2];
  bf16x8 bfr[4][NT];
  float cum_end = 0.f;
  auto issue = [&](int step) {
    const int ck = dir == 0 ? ck0 + step : ck0 + nck - 1 - step;
    const float* WD = (const float*)(p.ws + OFF_WDEC) + (size_t)((ck * 2 + dir) * 8 + h) * 128;
    const float* CUM = (const float*)(p.ws + OFF_CUM) + (size_t)((ck * 2 + dir) * 8 + h) * 128;
    cum_end = CUM[dir == 0 ? 127 : 0];
    const u16* xa = XST + ((size_t)(ck * 8 + h) * 64 + pt * 16 + l15) * 128;
    const u16* bb = BMT + ((size_t)(ck * 2 + g) * 128 + ntile0 * 16 + l15) * 128;
#pragma unroll
    for (int ks = 0; ks < 4; ++ks) {
      const int k0 = ks * 32 + quad * 8;
      xr[ks] = *(const u32x4*)(xa + k0);
      ww[ks][0] = *(const f32x4*)(WD + k0); ww[ks][1] = *(const f32x4*)(WD + k0 + 4);
#pragma unroll
      for (int nt = 0; nt < NT; ++nt) bfr[ks][nt] = ld_frag(bb + (size_t)nt * 16 * 128 + k0);
    }
  };
  if (PIPE) issue(0);
  for (int step = 0; step < nck; ++step) {
    const int ck = dir == 0 ? ck0 + step : ck0 + nck - 1 - step;
    u16* hp = HPREV + ((size_t)((ck * 2 + dir) * 8 + h) * 64) * 128;
    if (!PIPE) issue(step);
    const float decay = __expf(cum_end);
    bf16x8 af[4];
    bf16x8 bcur[4][NT];
#pragma unroll
    for (int ks = 0; ks < 4; ++ks) {
      u32x4 xs;
#pragma unroll
      for (int j = 0; j < 4; ++j) {
        float lo = __uint_as_float(xr[ks][j] << 16) * ww[ks][j >> 1][(j & 1) * 2];
        float hi = __uint_as_float(xr[ks][j] & 0xffff0000u) * ww[ks][j >> 1][(j & 1) * 2 + 1];
        xs[j] = pack2(lo, hi);
      }
      af[ks] = __builtin_bit_cast(bf16x8, xs);
#pragma unroll
      for (int nt = 0; nt < NT; ++nt) bcur[ks][nt] = bfr[ks][nt];
    }
    if (PIPE && step + 1 < nck) issue(step + 1);
#pragma unroll
    for (int nt = 0; nt < NT; ++nt)
#pragma unroll
      for (int r = 0; r < 4; ++r) (hp + lane_off)[r * 128 + nt * 16] = f2bf(acc[nt][r]);
#pragma unroll
    for (int nt = 0; nt < NT; ++nt)
#pragma unroll
      for (int r = 0; r < 4; ++r) acc[nt][r] *= decay;
#pragma unroll
    for (int ks = 0; ks < 4; ++ks)
#pragma unroll
      for (int nt = 0; nt < NT; ++nt) acc[nt] = mfma16(af[ks], bcur[ks][nt], acc[nt]);
  }
  if (!lat) {
    float* o = p.out + OUT_SSD + ((size_t)(((sq * 2 + l) * 2 + dir) * 8 + h) * 64) * 128;
#pragma unroll
    for (int nt = 0; nt < NT; ++nt)
#pragma unroll
      for (int r = 0; r < 4; ++r) (o + lane_off)[r * 128 + nt * 16] = acc[nt][r];
  }
}
__device__ __forceinline__ void ssd_state_item(const P& p, int l, int item) {
  const int w = otid() >> 6;
  if (item < 128) {
    const int idx = item >> 2, nq = item & 3;
    ssd_state_chain<1, false>(p, l, 16 + (idx >> 4), (idx & 15) >> 1, idx & 1, nq, w);
  } else {
    const int idx = item - 128;
    ssd_state_chain<4, false>(p, l, idx >> 4, (idx & 15) >> 1, idx & 1, w & 3, (w >> 2) * 4);
  }
}

__device__ __forceinline__ void s5_table_item(const P& p) {
  const int tid = otid();
  for (int e = tid; e < 4096; e += 512) {
    const float are = p.in[I_LRE][e], aim = p.in[I_LIM][e];
    const float step = expf(p.in[I_LOGDT][e >> 6]);
    const float er = expf(are * step), th = aim * step;
    const float lr = er * cosf(th), li = er * sinf(th);
    const float nr = lr - 1.f, ni = li;
    const float den = 1.f / (are * are + aim * aim);
    const float kr = (nr * are + ni * aim) * den, ki = (ni * are - nr * aim) * den;
    float pr = lr, pi = li;
#pragma unroll
    for (int k = 0; k < 5; ++k) { float a = pr * pr - pi * pi, b = 2.f * pr * pi; pr = a; pi = b; }
    f32x4* tab = (f32x4*)(p.ws + OFF_S5TAB) + (size_t)e * 2;
    tab[0] = (f32x4){lr, li, kr, ki};
    tab[1] = (f32x4){pr, pi, 0.f, 0.f};
    const int l = e >> 11, g = (e >> 6) & 15, n = e & 63;
    const float* Br = p.in[I_BRE] + ((size_t)(l * 16 + g) * 64 + n) * 16;
    const float* Bi = p.in[I_BIM] + ((size_t)(l * 16 + g) * 64 + n) * 16;
    u16* bb = (u16*)(p.ws + OFF_S5BB) + ((size_t)(e >> 6) * 128 + n * 2) * 16;
#pragma unroll
    for (int c4 = 0; c4 < 4; ++c4) {
      const f32x4 a = *(const f32x4*)(Br + c4 * 4), b = *(const f32x4*)(Bi + c4 * 4);
      u32x2 re = {pack2(kr * a[0] - ki * b[0], kr * a[1] - ki * b[1]), pack2(kr * a[2] - ki * b[2], kr * a[3] - ki * b[3])};
      u32x2 im = {pack2(kr * b[0] + ki * a[0], kr * b[1] + ki * a[1]), pack2(kr * b[2] + ki * a[2], kr * b[3] + ki * a[3])};
      *(u32x2*)(bb + c4 * 4) = re;
      *(u32x2*)(bb + 16 + c4 * 4) = im;
    }
  }
}
__device__ __forceinline__ void s5_sc_info(int sc, int& sq, int& j, int& nsc, int& sc0, int& row0) {
  if (sc < 128) { sq = sc >> 3; j = sc & 7; nsc = 8; sc0 = sq * 8; row0 = sq * 256; }
  else { int lb = (sc - 128) >> 5; sq = 16 + lb; j = (sc - 128) & 31; nsc = 32; sc0 = 128 + lb * 32; row0 = 4096 + lb * 1024; }
}
__device__ __forceinline__ int s5_row(bool lat, int row0, int s) { return lat ? row0 + (s & 15) * 64 + (s >> 4) : row0 + s; }

__device__ __forceinline__ void s5_load_u(const P& p, int sc, int gq, float* us) {
  int sq, j, nsc, sc0, row0;
  s5_sc_info(sc, sq, j, nsc, sc0, row0);
  const int tid = otid();
  const int gi = tid >> 7, i = (tid & 127) >> 2, c4 = tid & 3;
  const int row = s5_row(sq >= 16, row0, j * 32 + i);
  const float* proj = (const float*)(p.ws + OFF_PROJ);
  f32x4 v = *(const f32x4*)(proj + (size_t)row * IN_DIM + 2064 + (gq * 4 + gi) * 16 + c4 * 4);
  *(f32x4*)(us + (gi * 32 + i) * 16 + c4 * 4) = v;
}
__device__ __forceinline__ void s5_bu_mfma(const P& p, int l, int dir, int g, const float* us_g, float* hb, int lane) {
  const int quad = lane >> 4, l15 = lane & 15;
  bf16x8 af[2];
#pragma unroll
  for (int mt = 0; mt < 2; ++mt) {
    u32x4 pk = {0u, 0u, 0u, 0u};
    if (quad < 2) {
      const f32x4 a = *(const f32x4*)(us_g + (mt * 16 + l15) * 16 + quad * 8), b = *(const f32x4*)(us_g + (mt * 16 + l15) * 16 + quad * 8 + 4);
      pk = (u32x4){pack2(a[0], a[1]), pack2(a[2], a[3]), pack2(b[0], b[1]), pack2(b[2], b[3])};
    }
    af[mt] = __builtin_bit_cast(bf16x8, pk);
  }
  const u16* bb = (const u16*)(p.ws + OFF_S5BB) + ((size_t)((l * 2 + dir) * 16 + g) * 128 + l15) * 16 + (quad & 1) * 8;
#pragma unroll
  for (int nt = 0; nt < 8; ++nt) {
    u32x4 bv = *(const u32x4*)(bb + (size_t)nt * 16 * 16);
    if (quad >= 2) bv = (u32x4){0u, 0u, 0u, 0u};
    const bf16x8 bq = __builtin_bit_cast(bf16x8, bv);
#pragma unroll
    for (int mt = 0; mt < 2; ++mt) {
      f32x4 acc = {0.f, 0.f, 0.f, 0.f};
      acc = mfma16(af[mt], bq, acc);
#pragma unroll
      for (int r = 0; r < 4; ++r) hb[(mt * 16 + quad * 4 + r) * 132 + nt * 16 + l15] = acc[r];
    }
  }
}

__device__ __forceinline__ void s5_local_item(const P& p, int l, int item, char* smem) {
  float* us = (float*)smem;
  float* HB = (float*)(smem + 8192);
  const int sc = item >> 2, gq = item & 3;
  s5_load_u(p, sc, gq, us);
  __syncthreads();
  const int tid = otid(), w = tid >> 6, n = tid & 63;
  const int gi = w >> 1, dir = w & 1, g = gq * 4 + gi;
  float* hb = HB + (gi * 2 + dir) * 32 * 132;
  s5_bu_mfma(p, l, dir, g, us + gi * 32 * 16, hb, n);
  __syncthreads();
  const f32x4 t0 = *((const f32x4*)(p.ws + OFF_S5TAB) + (size_t)(((l * 2 + dir) * 16 + g) * 64 + n) * 2);
  const float lr = t0[0], li = t0[1];
  float hr = 0.f, hi = 0.f;
#pragma unroll 8
  for (int ii = 0; ii < 32; ++ii) {
    const int i = dir == 0 ? ii : 31 - ii;
    const float2 bu = *(const float2*)(hb + i * 132 + n * 2);
    const float a = lr * hr - li * hi + bu.x, b = lr * hi + li * hr + bu.y;
    hr = a; hi = b;
  }
  float* E = (float*)(p.ws + OFF_S5E);
  *(float2*)(E + ((size_t)((sc * 16 + g) * 2 + dir) * 64 + n) * 2) = make_float2(hr, hi);
  __syncthreads();
}

__device__ __forceinline__ void s5_out_item(const P& p, int l, int item, char* smem) {
  float* us = (float*)smem;
  float* HB = (float*)(smem + 8192);
  const int sc = item >> 2, gq = item & 3;
  int sq, j, nsc, sc0, row0;
  s5_sc_info(sc, sq, j, nsc, sc0, row0);
  const bool lat = sq >= 16;
  s5_load_u(p, sc, gq, us);
  __syncthreads();
  const int tid = otid(), w = tid >> 6, lane = tid & 63;
  {
    const int n = lane;
    const int gi = w >> 1, dir = w & 1, g = gq * 4 + gi;
    float* hb = HB + (gi * 2 + dir) * 32 * 132;
    s5_bu_mfma(p, l, dir, g, us + gi * 32 * 16, hb, lane);
    __syncthreads();
    const f32x4* tab = (const f32x4*)(p.ws + OFF_S5TAB) + (size_t)(((l * 2 + dir) * 16 + g) * 64 + n) * 2;
    const f32x4 t0 = tab[0], t1 = tab[1];
    const float lr = t0[0], li = t0[1], pr = t1[0], pi = t1[1];
    float hr = 0.f, hi = 0.f;
    if (lat) {
      const int si = ((((sq - 16) * 2 + l) * 2 + dir) * 16 + g) * 64 + n;
      hr = p.in[I_SS5R][si];
      hi = p.in[I_SS5I][si];
    }
    const float* E = (const float*)(p.ws + OFF_S5E);
    const int nprev = dir == 0 ? j : nsc - 1 - j;
    for (int jj0 = 0; jj0 < nprev; jj0 += 8) {
      float2 ev[8];
#pragma unroll
      for (int u = 0; u < 8; ++u) {
        const int jj = jj0 + u < nprev ? jj0 + u : nprev - 1;
        const int scp = dir == 0 ? sc0 + jj : sc0 + nsc - 1 - jj;
        ev[u] = *(const float2*)(E + ((size_t)((scp * 16 + g) * 2 + dir) * 64 + n) * 2);
      }
#pragma unroll
      for (int u = 0; u < 8; ++u) {
        if (jj0 + u < nprev) {
          const float a = pr * hr - pi * hi + ev[u].x, b = pr * hi + pi * hr + ev[u].y;
          hr = a; hi = b;
        }
      }
    }
#pragma unroll 8
    for (int ii = 0; ii < 32; ++ii) {
      const int i = dir == 0 ? ii : 31 - ii;
      float2* cell = (float2*)(hb + i * 132 + n * 2);
      const float2 bu = *cell;
      const float a = lr * hr - li * hi + bu.x, b = lr * hi + li * hr + bu.y;
      hr = a; hi = b;
      *cell = make_float2(hr, hi);
    }
    if (!lat && ((dir == 0 && j == nsc - 1) || (dir == 1 && j == 0))) {
      const int oi = (((sq * 2 + l) * 2 + dir) * 16 + g) * 64 + n;
      p.out[OUT_S5RE + oi] = hr;
      p.out[OUT_S5IM + oi] = hi;
    }
  }
  __syncthreads();
  {
    const int quad = lane >> 4, l15 = lane & 15;
    const int gi = w >> 1, mt = w & 1, g = gq * 4 + gi;
    const float* Cr = p.in[I_CRE] + ((size_t)(l * 16 + g) * 16 + l15) * 64;
    const float* Ci = p.in[I_CIM] + ((size_t)(l * 16 + g) * 16 + l15) * 64;
    bf16x8 bfr[4];
#pragma unroll
    for (int k4 = 0; k4 < 4; ++k4) {
      f32x4 cr = *(const f32x4*)(Cr + k4 * 16 + quad * 4), ci = *(const f32x4*)(Ci + k4 * 16 + quad * 4);
      u32x4 pk = {pack2(cr[0], -ci[0]), pack2(cr[1], -ci[1]), pack2(cr[2], -ci[2]), pack2(cr[3], -ci[3])};
      bfr[k4] = __builtin_bit_cast(bf16x8, pk);
    }
    f32x4 acc = {0.f, 0.f, 0.f, 0.f};
#pragma unroll
    for (int ks = 0; ks < 8; ++ks) {
      const float* ha = HB + ((gi * 2 + (ks >> 2)) * 32 + mt * 16 + l15) * 132 + (ks & 3) * 32 + quad * 8;
      const f32x4 h0 = *(const f32x4*)ha, h1 = *(const f32x4*)(ha + 4);
      u32x4 pk = {pack2(h0[0], h0[1]), pack2(h0[2], h0[3]), pack2(h1[0], h1[1]), pack2(h1[2], h1[3])};
      acc = mfma16(__builtin_bit_cast(bf16x8, pk), bfr[ks & 3], acc);
    }
    const float dsk = p.in[I_S5D][l * 256 + g * 16 + l15];
    u16* Y1B = (u16*)(p.ws + OFF_Y1B);
#pragma unroll
    for (int r = 0; r < 4; ++r) {
      const int i = mt * 16 + quad * 4 + r;
      const float y = acc[r] + dsk * us[(gi * 32 + i) * 16 + l15];
      const int row = s5_row(lat, row0, j * 32 + i);
      Y1B[(size_t)row * 256 + g * 16 + l15] = f2bf(gelu_t(y));
    }
  }
  __syncthreads();
}

__device__ __forceinline__ void sgu_item(const P& p, int l, int item) {
  const int ck = item >> 2, hd = item & 3;
  const int tid = otid(), w = tid >> 6, lane = tid & 63, quad = lane >> 4, l15 = lane & 15;
  const u16* W = (const u16*)(p.ws + OFF_SGUW) + ((size_t)(l * 4 + hd) * 128 + w * 16 + l15) * 128;
  const u16* VT = (const u16*)(p.ws + OFF_VT) + ((size_t)ck * 256 + hd * 64 + l15) * 128;
  f32x4 acc[4];
#pragma unroll
  for (int d = 0; d < 4; ++d) acc[d] = (f32x4){0.f, 0.f, 0.f, 0.f};
#pragma unroll
  for (int ks = 0; ks < 4; ++ks) {
    const int k0 = ks * 32 + quad * 8;
    bf16x8 af = ld_frag(W + k0);
#pragma unroll
    for (int d = 0; d < 4; ++d) acc[d] = mfma16(af, ld_frag(VT + (size_t)d * 16 * 128 + k0), acc[d]);
  }
  const float* proj = (const float*)(p.ws + OFF_PROJ);
  u16* MIX = (u16*)(p.ws + OFF_MIXED);
#pragma unroll
  for (int r = 0; r < 4; ++r) {
    const int q = w * 16 + quad * 4 + r;
    const float b = p.in[I_SGUB][(l * 4 + hd) * 128 + q];
    const size_t row = (size_t)ck * 128 + q;
#pragma unroll
    for (int d = 0; d < 4; ++d) {
      const int col = hd * 64 + d * 16 + l15;
      const float u = gelu_t(proj[row * IN_DIM + 1552 + col]);
      MIX[row * 1024 + 512 + col] = f2bf(u * (acc[d][r] + b));
    }
  }
}

__device__ __forceinline__ void ssd_out_item(const P& p, int l, int item, char* smem) {
  float* red = (float*)smem;
  const int ck = item >> 2, qb2 = item & 3;
  const int tid = otid(), h = tid >> 6, lane = tid & 63, quad = lane >> 4, l15 = lane & 15;
  const int g = h >> 2, q0 = qb2 * 32;
  const size_t row0 = (size_t)ck * 128;
  const u16* BM = (const u16*)(p.ws + OFF_BM);
  const u16* CM = (const u16*)(p.ws + OFF_CM);
  const float* DTf = (const float*)(p.ws + OFF_DT) + (size_t)((ck * 2 + 0) * 8 + h) * 128;
  const float* DTb = (const float*)(p.ws + OFF_DT) + (size_t)((ck * 2 + 1) * 8 + h) * 128;
  const float* CF = (const float*)(p.ws + OFF_CUM) + (size_t)((ck * 2 + 0) * 8 + h) * 128;
  const float* CB = (const float*)(p.ws + OFF_CUM) + (size_t)((ck * 2 + 1) * 8 + h) * 128;
  bf16x8 cmf[2][4];
#pragma unroll
  for (int t = 0; t < 2; ++t)
#pragma unroll
    for (int ns = 0; ns < 4; ++ns) cmf[t][ns] = ld_frag(CM + (row0 + q0 + t * 16 + l15) * 256 + g * 128 + ns * 32 + quad * 8);
  float cfq[2], cbq[2], dsum[2];
#pragma unroll
  for (int t = 0; t < 2; ++t) {
    const int q = q0 + t * 16 + l15;
    cfq[t] = CF[q]; cbq[t] = CB[q]; dsum[t] = DTf[q] + DTb[q];
  }
  const float Dh = p.in[I_SSDD][l * 8 + h];
  u32x4 As[2][4];
#pragma unroll
  for (int kt = 0; kt < 8; ++kt) {
    f32x4 aT[2] = {{0.f, 0.f, 0.f, 0.f}, {0.f, 0.f, 0.f, 0.f}};
#pragma unroll
    for (int ns = 0; ns < 4; ++ns) {
      const bf16x8 bmf = ld_frag(BM + (row0 + kt * 16 + l15) * 256 + g * 128 + ns * 32 + quad * 8);
      aT[0] = mfma16(bmf, cmf[0][ns], aT[0]);
      aT[1] = mfma16(bmf, cmf[1][ns], aT[1]);
    }
    const int kb = kt * 16 + quad * 4;
    f32x4 c = {0.f, 0.f, 0.f, 0.f}, d = c, c2 = c, d2 = c;
    if (kt <= qb2 * 2 + 1) { c = *(const f32x4*)(CF + kb); d = *(const f32x4*)(DTf + kb); }
    if (kt >= qb2 * 2) { c2 = *(const f32x4*)(CB + kb); d2 = *(const f32x4*)(DTb + kb); }
#pragma unroll
    for (int t = 0; t < 2; ++t) {
      const int qt = qb2 * 2 + t;
      const int q = q0 + t * 16 + l15;
      float m[4];
      if (kt < qt) {
#pragma unroll
        for (int r = 0; r < 4; ++r) m[r] = aT[t][r] * __expf(cfq[t] - c[r]) * d[r];
      } else if (kt > qt) {
#pragma unroll
        for (int r = 0; r < 4; ++r) m[r] = aT[t][r] * __expf(cbq[t] - c2[r]) * d2[r];
      } else {
#pragma unroll
        for (int r = 0; r < 4; ++r) {
          const int k = kb + r;
          float f;
          if (k < q) f = __expf(cfq[t] - c[r]) * d[r];
          else if (k > q) f = __expf(cbq[t] - c2[r]) * d2[r];
          else f = dsum[t];
          m[r] = aT[t][r] * f + (k == q ? Dh : 0.f);
        }
      }
      As[t][kt >> 1][(kt & 1) * 2 + 0] = pack2(m[0], m[1]);
      As[t][kt >> 1][(kt & 1) * 2 + 1] = pack2(m[2], m[3]);
    }
    if (kt & 1) asm volatile("" ::: "memory");
  }
  const u16* XST = (const u16*)(p.ws + OFF_XST) + ((size_t)(ck * 8 + h) * 64 + l15) * 128;
  const u16* HPf = (const u16*)(p.ws + OFF_HPREV) + ((size_t)((ck * 2 + 0) * 8 + h) * 64 + l15) * 128;
  const u16* HPb = (const u16*)(p.ws + OFF_HPREV) + ((size_t)((ck * 2 + 1) * 8 + h) * 64 + l15) * 128;
  const float* proj = (const float*)(p.ws + OFF_PROJ);
  float* ybuf = (float*)(smem + 1024) + (h * 32 + quad * 4) * 65 + l15;
  float ss[2][4] = {{0.f, 0.f, 0.f, 0.f}, {0.f, 0.f, 0.f, 0.f}};
#pragma unroll 1
  for (int pt = 0; pt < 4; ++pt) {
    f32x4 aY[2] = {{0.f, 0.f, 0.f, 0.f}, {0.f, 0.f, 0.f, 0.f}};
    f32x4 aF[2] = {{0.f, 0.f, 0.f, 0.f}, {0.f, 0.f, 0.f, 0.f}};
    f32x4 aB[2] = {{0.f, 0.f, 0.f, 0.f}, {0.f, 0.f, 0.f, 0.f}};
#pragma unroll
    for (int s2 = 0; s2 < 4; ++s2) {
      u32x2 lo = *(const u32x2*)(XST + (size_t)pt * 16 * 128 + (2 * s2) * 16 + quad * 4);
      u32x2 hi = *(const u32x2*)(XST + (size_t)pt * 16 * 128 + (2 * s2 + 1) * 16 + quad * 4);
      const bf16x8 bv = __builtin_bit_cast(bf16x8, (u32x4){lo[0], lo[1], hi[0], hi[1]});
      aY[0] = mfma16(__builtin_bit_cast(bf16x8, As[0][s2]), bv, aY[0]);
      aY[1] = mfma16(__builtin_bit_cast(bf16x8, As[1][s2]), bv, aY[1]);
    }
#pragma unroll
    for (int ns = 0; ns < 4; ++ns) {
      const bf16x8 hf = ld_frag(HPf + (size_t)pt * 16 * 128 + ns * 32 + quad * 8);
      const bf16x8 hb = ld_frag(HPb + (size_t)pt * 16 * 128 + ns * 32 + quad * 8);
      aF[0] = mfma16(cmf[0][ns], hf, aF[0]);
      aF[1] = mfma16(cmf[1][ns], hf, aF[1]);
      aB[0] = mfma16(cmf[0][ns], hb, aB[0]);
      aB[1] = mfma16(cmf[1][ns], hb, aB[1]);
    }
#pragma unroll
    for (int t = 0; t < 2; ++t)
#pragma unroll
      for (int r = 0; r < 4; ++r) {
        const int qq = q0 + t * 16 + quad * 4 + r;
        float yv = aY[t][r] + __expf(CF[qq]) * aF[t][r] + __expf(CB[qq]) * aB[t][r];
        const float zv = proj[(row0 + qq) * IN_DIM + h * 64 + pt * 16 + l15];
        yv *= silu_f(zv);
        ybuf[(t * 16 + r) * 65 + pt * 16] = yv;
        ss[t][r] += yv * yv;
      }
  }
  const int lane2 = otid() & 63;
#pragma unroll
  for (int t = 0; t < 2; ++t)
#pragma unroll
    for (int r = 0; r < 4; ++r) {
      float sv = ss[t][r];
#pragma unroll
      for (int o = 1; o < 16; o <<= 1) sv += shx(sv, o, lane2);
      ss[t][r] = sv;
    }
  if (l15 == 0) {
#pragma unroll
    for (int t = 0; t < 2; ++t)
#pragma unroll
      for (int r = 0; r < 4; ++r) red[(t * 16 + quad * 4 + r) * 8 + h] = ss[t][r];
  }
  __syncthreads();
  u16* MIX = (u16*)(p.ws + OFF_MIXED);
  const float* ng = p.in[I_SSDNG] + l * 512 + h * 64;
#pragma unroll
  for (int t = 0; t < 2; ++t)
#pragma unroll
    for (int r = 0; r < 4; ++r) {
      const int qq = q0 + t * 16 + quad * 4 + r;
      float tot = 0.f;
#pragma unroll
      for (int hh = 0; hh < 8; ++hh) tot += red[(t * 16 + quad * 4 + r) * 8 + hh];
      const float rinv = rsqrtf(tot * (1.f / 512.f) + 1e-6f);
#pragma unroll
      for (int pt = 0; pt < 4; ++pt) {
        const int pc = pt * 16 + l15;
        MIX[(row0 + qq) * 1024 + h * 64 + pc] = f2bf(ybuf[(t * 16 + r) * 65 + pt * 16] * rinv * ng[pc]);
      }
    }
  __syncthreads();
}

#define XB_TMO      128
#define XB_XCNT(j)  (256  + 64 * (j))
#define XB_XSUB(j)  (1280 + 64 * (j))
#define XB_XGEN(j)  (2304 + 64 * (j))
#define XB_TOP      3328
#define XB_TOPGEN   3392
#define XCD_BAR_WORDS 3456
#define XB_SPIN_CAP (1u << 18)
#define LAS __attribute__((address_space(3)))
__device__ __forceinline__ unsigned xb_ld(unsigned* p) { return __hip_atomic_load(p, __ATOMIC_RELAXED, __HIP_MEMORY_SCOPE_AGENT); }
__device__ __forceinline__ unsigned xb_add(unsigned* p, unsigned v) { return __hip_atomic_fetch_add(p, v, __ATOMIC_RELAXED, __HIP_MEMORY_SCOPE_AGENT); }
__device__ __forceinline__ unsigned xb_xcc_id() { return (unsigned)__builtin_amdgcn_s_getreg((3 << 11) | 20) & 0xFu; }
#define XB_SPIN(cond, bar) do { unsigned _sp = 0; while (cond) { __builtin_amdgcn_s_sleep(1); \
    if ((++_sp & 255u) == 0u) { if (xb_ld(&(bar)[XB_TMO])) break; if (_sp > XB_SPIN_CAP) { atomicAdd(&(bar)[XB_TMO], 1u); break; } } } } while (0)
struct XcdBarrier { unsigned* bar; unsigned x; volatile LAS unsigned* st; };
__device__ __forceinline__ XcdBarrier xcd_barrier_post(unsigned* bar, volatile LAS unsigned* st) {
  XcdBarrier b; b.bar = bar; b.x = xb_xcc_id(); b.st = st;
  if (threadIdx.x == 0) (void)xb_add(&bar[XB_XCNT(b.x)], 1u);
  return b;
}
__device__ __forceinline__ void xcd_barrier_complete(unsigned* bar, unsigned x, unsigned& nloc, unsigned& nx) {
  const unsigned G = gridDim.x * gridDim.y * gridDim.z;
  unsigned sum, cnt, mine, sp = 0u;
  for (;;) {
    sum = 0u; cnt = 0u; mine = 0u;
#pragma unroll
    for (unsigned j = 0; j < 16; ++j) { const unsigned c = xb_ld(&bar[XB_XCNT(j)]); sum += c; cnt += (c > 0u) ? 1u : 0u; mine = (j == x) ? c : mine; }
    if (sum == G) break;
    __builtin_amdgcn_s_sleep(1);
    if ((++sp & 255u) == 0u) { if (xb_ld(&bar[XB_TMO])) break; if (sp > XB_SPIN_CAP) { atomicAdd(&bar[XB_TMO], 1u); break; } }
  }
  nloc = mine > 0u ? mine : 1u; nx = cnt > 0u ? cnt : 1u;
}
__device__ __forceinline__ void xcd_barrier(const XcdBarrier& b) {
  asm volatile("s_waitcnt vmcnt(0)" ::: "memory");
  __syncthreads();
  if (threadIdx.x == 0) {
    unsigned* bar = b.bar;
    __builtin_amdgcn_s_waitcnt(0);
    unsigned nloc = b.st[0], nx = b.st[1];
    if (nloc == 0u) { xcd_barrier_complete(bar, b.x, nloc, nx); b.st[0] = nloc; b.st[1] = nx; }
    const unsigned old = xb_add(&bar[XB_XSUB(b.x)], 1u);
    const unsigned gen = old / nloc;
    if (old + 1u == (gen + 1u) * nloc) {
      __builtin_amdgcn_fence(__ATOMIC_RELEASE, "agent");
      asm volatile("s_waitcnt vmcnt(0)" ::: "memory");
      const unsigned og = xb_add(&bar[XB_TOP], 1u);
      const unsigned tg = og / nx;
      if (og + 1u == (tg + 1u) * nx) xb_add(&bar[XB_TOPGEN], 1u);
      else XB_SPIN(xb_ld(&bar[XB_TOPGEN]) == tg, bar);
      __builtin_amdgcn_fence(__ATOMIC_ACQUIRE, "agent");
      xb_add(&bar[XB_XGEN(b.x)], 1u);
      asm volatile("s_waitcnt vmcnt(0)" ::: "memory");
    } else {
      XB_SPIN(xb_ld(&bar[XB_XGEN(b.x)]) == gen, bar);
      __builtin_amdgcn_fence(__ATOMIC_ACQUIRE, "agent");
      asm volatile("s_waitcnt vmcnt(0)" ::: "memory");
    }
  }
  __syncthreads();
}

__device__ __forceinline__ int next_item(unsigned* ctr, int* slot) {
  __syncthreads();
  if (threadIdx.x == 0) *slot = (int)xb_add(ctr, 1u);
  __syncthreads();
  return *slot;
}

__device__ __forceinline__ void run_phase(const P& p, int ph, int rep, char* smem, int* qslot) {
  const int nb = gridDim.x, bid = obid();
  unsigned* qctr = (unsigned*)(p.ws + OFF_BAR) + 3520 + 16 * (ph * 2 + rep);
  if (ph == 0) {
    for (int it = bid; it < 96 + 16 + 1; it += nb) {
      if (it < 96) mod_item(p, it, smem);
      else if (it < 112) p0_sgu_item(p, it - 96);
      else s5_table_item(p);
    }
    p0_transposes(p, smem);
    return;
  }
  if (ph == 21) {
    norm_phase(p, 0, 2, (const float*)(p.ws + OFF_XB), (const float*)(p.ws + OFF_XB) + (size_t)4096 * 1024);
    return;
  }
  const int l = (ph - 1) / 10, sp = (ph - 1) % 10;
  const float* x0a = l == 0 ? p.in[I_XP] : (const float*)(p.ws + OFF_XB);
  const float* x0b = l == 0 ? p.in[I_XS] : (const float*)(p.ws + OFF_XB) + (size_t)4096 * 1024;
  const float* x1a = (const float*)(p.ws + OFF_XA);
  const float* x1b = x1a + (size_t)4096 * 1024;
  const float* mod = (const float*)(p.ws + OFF_MOD) + (size_t)l * 3 * 6144;
  Epi e{};
  switch (sp) {
    case 0: norm_phase(p, l, 0, x0a, x0b); break;
    case 1:
      e.outf = (float*)(p.ws + OFF_PROJ);
      gemm_phase<0, 1024>((const u16*)(p.ws + OFF_H), (const u16*)(p.ws + OFF_WIN_T) + (size_t)l * IN_PAD * 1024, 19, e, smem);
      break;
    case 2:
      for (int it = next_item(qctr, qslot); it < 48 * 18; it = next_item(qctr, qslot)) {
        if (it < 48) prep_v(p, l, it, smem);
        else if (it < 48 + 768) { int k = it - 48; prep_conv(p, l, k >> 4, k & 15, smem); }
        else prep_dt(p, l, it - 816, smem);
      }
      break;
    case 3: {
      constexpr int NA = 384 * ((DUP & 8) ? 2 : 1), NB = 768 * ((DUP & 16) ? 2 : 1);
      for (int it = next_item(qctr, qslot); it < NA + NB; it = next_item(qctr, qslot)) {
        if (it < NA) ssd_state_item(p, l, it % 384);
        else s5_local_item(p, l, (it - NA) % 768, smem);
      }
    } break;
    case 4: {
      constexpr int NA = 192 * ((DUP & 1) ? 2 : 1), NB = 768 * ((DUP & 2) ? 2 : 1), NC = 192 * ((DUP & 4) ? 2 : 1);
      for (int it = next_item(qctr, qslot); it < NA + NB + NC; it = next_item(qctr, qslot)) {
        if (it < NA) ssd_out_item(p, l, it % 192, smem);
        else if (it < NA + NB) s5_out_item(p, l, (it - NA) % 768, smem);
        else sgu_item(p, l, (it - NA - NB) % 192);
      }
    } break;
    case 5:
      e.outb = (u16*)(p.ws + OFF_MIXED);
      e.y1 = (const u16*)(p.ws + OFF_Y1B);
      e.bias = p.in[I_GLUB] + l * 256;
      gemm_phase<3, 256>((const u16*)(p.ws + OFF_Y1B), (const u16*)(p.ws + OFF_GLU_T) + (size_t)l * 256 * 256, 2, e, smem);
      break;
    case 6:
      e.outf = (float*)(p.ws + OFF_XA);
      e.xa = x0a; e.xb = x0b; e.gate = mod + 2048;
      gemm_phase<1, 1024>((const u16*)(p.ws + OFF_MIXED), (const u16*)(p.ws + OFF_WOUT_T) + (size_t)l * 1024 * 1024, 8, e, smem);
      break;
    case 7: norm_phase(p, l, 1, x1a, x1b); break;
    case 8:
      e.outb = (u16*)(p.ws + OFF_PROJ);
      gemm_phase<2, 1024>((const u16*)(p.ws + OFF_H), (const u16*)(p.ws + OFF_W1_T) + (size_t)l * 4096 * 1024, 32, e, smem);
      break;
    case 9:
      e.outf = (float*)(p.ws + OFF_XB);
      e.xa = x1a; e.xb = x1b; e.gate = mod + 5120;
      gemm_phase<1, 4096>((const u16*)(p.ws + OFF_PROJ), (const u16*)(p.ws + OFF_W2_T) + (size_t)l * 1024 * 4096, 8, e, smem);
      break;
  }
}

#ifndef REP_MASK
#define REP_MASK 0
#endif
__device__ __forceinline__ int phase_type(int ph) { return ph == 0 ? 10 : ph == 21 ? 11 : (ph - 1) % 10; }

__global__ void __launch_bounds__(512) mega(P p, int ph_lo, int ph_hi, int coop) {
  __shared__ __attribute__((aligned(16))) char smem[SMEM_BYTES];
  __shared__ __attribute__((aligned(16))) unsigned xb_words[4];
  XcdBarrier xb;
  if (coop) {
    if (threadIdx.x < 4) xb_words[threadIdx.x] = 0u;
    __syncthreads();
    xb = xcd_barrier_post((unsigned*)(p.ws + OFF_BAR), (volatile LAS unsigned*)xb_words);
  }
  for (int ph = ph_lo; ph < ph_hi; ++ph) {
    const int reps = ((REP_MASK >> phase_type(ph)) & 1) ? 2 : 1;
    for (int r = 0; r < reps; ++r) run_phase(p, ph, r, smem, (int*)&xb_words[2]);
    if (coop == 1 && ph + 1 < ph_hi) xcd_barrier(xb);
    if (coop == 2) cg::this_grid().sync();
  }
}

extern "C" void kernel_launch(void* const* d_in, const int* in_sizes, int n_in, void* d_out, int out_size, void* d_ws,
                              size_t ws_size, hipStream_t stream) {
  static int grid_blocks = 0;
  if (!grid_blocks) {
    int dev = 0, cus = 0, per_cu = 0;
    hipGetDevice(&dev);
    hipDeviceGetAttribute(&cus, hipDeviceAttributeMultiprocessorCount, dev);
    hipOccupancyMaxActiveBlocksPerMultiprocessor(&per_cu, mega, 512, 0);
    if (per_cu < 1) per_cu = 1;
    grid_blocks = cus * per_cu;
  }
  P p{};
  for (int i = 0; i < 35; ++i) p.in[i] = (const float*)d_in[i];
  p.out = (float*)d_out;
  p.ws = (char*)d_ws;
  if (ws_size < WS_TOTAL) { fprintf(stderr, "workspace too small: %zu < %zu\n", ws_size, (size_t)WS_TOTAL); return; }
#if COOP
  hipMemsetAsync((char*)d_ws + OFF_BAR, 0, 65536, stream);
  int lo = 0, hi = 22, coop = 1;
  void* args[] = {&p, &lo, &hi, &coop};
  hipError_t err = hipLaunchCooperativeKernel((void*)mega, dim3(grid_blocks), dim3(512), args, 0, stream);
  if (err != hipSuccess) fprintf(stderr, "cooperative launch failed: %s (grid %d)\n", hipGetErrorString(err), grid_blocks);
#else
  for (int ph = 0; ph < 22; ++ph) mega<<<dim3(grid_blocks), dim3(512), 0, stream>>>(p, ph, ph + 1, 0);
#endif
}
```

```cpp
#include <hip/hip_runtime.h>
#include <hip/hip_cooperative_groups.h>
#include <cstdio>
namespace cg = cooperative_groups;

#define DUP 0
#ifndef COOP
#define COOP 1
#endif

typedef unsigned short u16;
typedef __attribute__((ext_vector_type(8))) short bf16x8;
typedef __attribute__((ext_vector_type(4))) float f32x4;
typedef __attribute__((ext_vector_type(4))) unsigned int u32x4;
typedef __attribute__((ext_vector_type(2))) unsigned int u32x2;

constexpr int T_TOK = 6144;
constexpr int DM = 1024;
constexpr int IN_DIM = 2320;
constexpr int IN_PAD = 2432;
constexpr int DFF = 4096;
constexpr int SMEM_BYTES = 143360;

constexpr size_t OFF_WIN_T = 0;
constexpr size_t OFF_WOUT_T = OFF_WIN_T + (size_t)2 * IN_PAD * 1024 * 2;
constexpr size_t OFF_W1_T = OFF_WOUT_T + (size_t)2 * 1024 * 1024 * 2;
constexpr size_t OFF_W2_T = OFF_W1_T + (size_t)2 * 4096 * 1024 * 2;
constexpr size_t OFF_GLU_T = OFF_W2_T + (size_t)2 * 4096 * 1024 * 2;
constexpr size_t OFF_SGUW = OFF_GLU_T + (size_t)2 * 256 * 256 * 2;
constexpr size_t OFF_MOD = OFF_SGUW + (size_t)2 * 4 * 128 * 128 * 2;
constexpr size_t OFF_H = OFF_MOD + (size_t)2 * 3 * 6144 * 4;
constexpr size_t OFF_PROJ = OFF_H + (size_t)T_TOK * 1024 * 2;
constexpr size_t OFF_MIXED = OFF_PROJ + (size_t)T_TOK * IN_DIM * 4;
constexpr size_t OFF_XA = OFF_MIXED + (size_t)T_TOK * 1024 * 2;
constexpr size_t OFF_XB = OFF_XA + (size_t)T_TOK * 1024 * 4;
constexpr size_t OFF_HPREV = OFF_XB + (size_t)T_TOK * 1024 * 4;
constexpr size_t OFF_BM = OFF_HPREV + (size_t)48 * 2 * 8 * 64 * 128 * 2;
constexpr size_t OFF_CM = OFF_BM + (size_t)T_TOK * 256 * 2;
constexpr size_t OFF_BMT = OFF_CM + (size_t)T_TOK * 256 * 2;
constexpr size_t OFF_XST = OFF_BMT + (size_t)48 * 2 * 128 * 128 * 2;
constexpr size_t OFF_VT = OFF_XST + (size_t)48 * 8 * 64 * 128 * 2;
constexpr size_t OFF_DT = OFF_VT + (size_t)48 * 256 * 128 * 2;
constexpr size_t OFF_CUM = OFF_DT + (size_t)48 * 2 * 8 * 128 * 4;
constexpr size_t OFF_WDEC = OFF_CUM + (size_t)48 * 2 * 8 * 128 * 4;
constexpr size_t OFF_S5E = OFF_WDEC + (size_t)48 * 2 * 8 * 128 * 4;
constexpr size_t OFF_Y1B = OFF_S5E + (size_t)192 * 16 * 2 * 64 * 8;
constexpr size_t OFF_S5TAB = OFF_Y1B + (size_t)T_TOK * 256 * 2;
constexpr size_t OFF_S5BB = OFF_S5TAB + (size_t)4096 * 32;
constexpr size_t OFF_BAR = OFF_S5BB + (size_t)64 * 128 * 16 * 2;
constexpr size_t WS_TOTAL = OFF_BAR + 65536;

constexpr size_t OUT_SSD = (size_t)T_TOK * 1024;
constexpr size_t OUT_S5RE = OUT_SSD + (size_t)16 * 2 * 2 * 8 * 64 * 128;
constexpr size_t OUT_S5IM = OUT_S5RE + (size_t)16 * 2 * 2 * 16 * 64;

struct P {
  const float* in[35];
  float* out;
  char* ws;
};

enum { I_XP = 0, I_XS, I_SSSD, I_SS5R, I_SS5I, I_C, I_CCTX, I_ADAW, I_ADAB, I_N1G, I_N2G, I_WIN, I_CONVW, I_CONVB,
       I_DTB, I_ALOG, I_SSDD, I_SSDNG, I_SGUNG, I_SGUW, I_SGUB, I_LRE, I_LIM, I_LOGDT, I_BRE, I_BIM, I_CRE, I_CIM,
       I_S5D, I_GLUW, I_GLUB, I_WOUT, I_W1, I_W2, I_FNG };

__device__ __forceinline__ int otid() { int t = threadIdx.x; asm volatile("" : "+v"(t)); return t; }
__device__ __forceinline__ int obid() { int t = blockIdx.x; asm volatile("" : "+s"(t)); return t; }
__device__ __forceinline__ u16 f2bf(float f) {
  unsigned u = __float_as_uint(f);
  u += 0x7fffu + ((u >> 16) & 1u);
  return (u16)(u >> 16);
}
__device__ __forceinline__ float bf2f(u16 h) { return __uint_as_float(((unsigned)h) << 16); }
__device__ __forceinline__ unsigned pack2(float a, float b) { return (unsigned)f2bf(a) | ((unsigned)f2bf(b) << 16); }

__device__ __forceinline__ float gelu_t(float x) {
  float y = 0.7978845608028654f * (x + 0.044715f * x * x * x);
  float t = __expf(2.f * y);
  float th = 1.f - 2.f / (t + 1.f);
  return 0.5f * x * (1.f + th);
}
__device__ __forceinline__ float sigmoid_f(float x) { return 1.f / (1.f + __expf(-x)); }
__device__ __forceinline__ float silu_f(float x) { return x / (1.f + __expf(-x)); }
__device__ __forceinline__ float softplus_f(float x) { return x > 20.f ? x : log1pf(expf(x)); }

__device__ __forceinline__ f32x4 mfma16(bf16x8 a, bf16x8 b, f32x4 c) {
  return __builtin_amdgcn_mfma_f32_16x16x32_bf16(a, b, c, 0, 0, 0);
}
__device__ __forceinline__ bf16x8 ld_frag(const u16* ptr) {
  return __builtin_bit_cast(bf16x8, *(const u32x4*)ptr);
}

__device__ __forceinline__ void mod_item(const P& p, int it, char* smem) {
  float* red = (float*)smem;
  const int tid = otid();
  const int l = it / 48, jb = it % 48;
  const int j0 = jb * 128;
  const int jq = tid & 31, kg = tid >> 5;
  const float* aw = p.in[I_ADAW] + (size_t)l * 1024 * 6144;
  float acc[3][4];
#pragma unroll
  for (int m = 0; m < 3; ++m)
#pragma unroll
    for (int j = 0; j < 4; ++j) acc[m][j] = 0.f;
  for (int kk = 0; kk < 64; ++kk) {
    int k = kg * 64 + kk;
    f32x4 w = *(const f32x4*)(aw + (size_t)k * 6144 + j0 + jq * 4);
    float c0 = silu_f(p.in[I_CCTX][k]);
    float c1 = silu_f(p.in[I_C][k]);
    float c2 = silu_f(p.in[I_C][1024 + k]);
#pragma unroll
    for (int j = 0; j < 4; ++j) {
      acc[0][j] += c0 * w[j];
      acc[1][j] += c1 * w[j];
      acc[2][j] += c2 * w[j];
    }
  }
#pragma unroll
  for (int m = 0; m < 3; ++m)
#pragma unroll
    for (int j = 0; j < 4; ++j) red[(kg * 3 + m) * 128 + jq * 4 + j] = acc[m][j];
  __syncthreads();
  if (tid < 384) {
    int m = tid >> 7, j = tid & 127;
    float s = p.in[I_ADAB][l * 6144 + j0 + j];
    for (int g = 0; g < 16; ++g) s += red[(g * 3 + m) * 128 + j];
    float* mod = (float*)(p.ws + OFF_MOD);
    mod[(l * 3 + m) * 6144 + j0 + j] = s;
  }
  __syncthreads();
}

__device__ __forceinline__ void transpose_tile(const float* src, int K, int N, u16* dst, int k0, int n0, char* smem) {
  float* tile = (float*)smem;
  const int tid = otid();
#pragma unroll
  for (int i = 0; i < 4; ++i) {
    int k = (tid >> 4) + 32 * i, n4 = tid & 15;
    int n = n0 + n4 * 4;
    f32x4 v = {0.f, 0.f, 0.f, 0.f};
    if (n < N) v = *(const f32x4*)(src + (size_t)(k0 + k) * N + n);
    float* d = tile + k * 65 + n4 * 4;
    d[0] = v[0]; d[1] = v[1]; d[2] = v[2]; d[3] = v[3];
  }
  __syncthreads();
#pragma unroll
  for (int i = 0; i < 2; ++i) {
    int slot = tid + i * 512;
    int n = slot >> 4, kg = slot & 15;
    u32x4 o;
#pragma unroll
    for (int j = 0; j < 4; ++j)
      o[j] = pack2(tile[(kg * 8 + 2 * j) * 65 + n], tile[(kg * 8 + 2 * j + 1) * 65 + n]);
    *(u32x4*)(dst + (size_t)(n0 + n) * K + k0 + kg * 8) = o;
  }
  __syncthreads();
}

struct TrDesc { const float* src; u16* dst; int K, N, k0, n0; };
__device__ __forceinline__ TrDesc tr_decode(const P& p, int it) {
  TrDesc d;
  int l = it / 1464, r = it % 1464, nt;
  if (r < 304) { d.src = p.in[I_WIN] + (size_t)l * 1024 * IN_DIM; d.dst = (u16*)(p.ws + OFF_WIN_T) + (size_t)l * IN_PAD * 1024; d.K = 1024; d.N = IN_DIM; nt = 38; }
  else if (r < 432) { r -= 304; d.src = p.in[I_WOUT] + (size_t)l * 1024 * 1024; d.dst = (u16*)(p.ws + OFF_WOUT_T) + (size_t)l * 1024 * 1024; d.K = 1024; d.N = 1024; nt = 16; }
  else if (r < 944) { r -= 432; d.src = p.in[I_W1] + (size_t)l * 1024 * 4096; d.dst = (u16*)(p.ws + OFF_W1_T) + (size_t)l * 4096 * 1024; d.K = 1024; d.N = 4096; nt = 64; }
  else if (r < 1456) { r -= 944; d.src = p.in[I_W2] + (size_t)l * 4096 * 1024; d.dst = (u16*)(p.ws + OFF_W2_T) + (size_t)l * 1024 * 4096; d.K = 4096; d.N = 1024; nt = 16; }
  else { r -= 1456; d.src = p.in[I_GLUW] + (size_t)l * 256 * 256; d.dst = (u16*)(p.ws + OFF_GLU_T) + (size_t)l * 256 * 256; d.K = 256; d.N = 256; nt = 4; }
  d.k0 = (r / nt) * 128; d.n0 = (r % nt) * 64;
  return d;
}
__device__ __forceinline__ void tr_load(const TrDesc& d, int tid, f32x4 (&v)[4]) {
#pragma unroll
  for (int i = 0; i < 4; ++i) {
    const int k = (tid >> 4) + 32 * i, n = d.n0 + (tid & 15) * 4;
    v[i] = (f32x4){0.f, 0.f, 0.f, 0.f};
    if (n < d.N) v[i] = *(const f32x4*)(d.src + (size_t)(d.k0 + k) * d.N + n);
  }
}
__device__ __forceinline__ void p0_transposes(const P& p, char* smem) {
  float* tile = (float*)smem;
  const int tid = otid(), nb = gridDim.x;
  int cur = obid();
  if (cur >= 2928) return;
  f32x4 v[4];
  TrDesc d = tr_decode(p, cur);
  tr_load(d, tid, v);
  while (cur < 2928) {
    __syncthreads();
#pragma unroll
    for (int i = 0; i < 4; ++i) {
      float* q = tile + ((tid >> 4) + 32 * i) * 65 + (tid & 15) * 4;
      q[0] = v[i][0]; q[1] = v[i][1]; q[2] = v[i][2]; q[3] = v[i][3];
    }
    __syncthreads();
    const int nxt = cur + nb;
    TrDesc dn = d;
    if (nxt < 2928) { dn = tr_decode(p, nxt); tr_load(dn, tid, v); }
#pragma unroll
    for (int i = 0; i < 2; ++i) {
      const int slot = tid + i * 512;
      const int n = slot >> 4, kg = slot & 15;
      u32x4 o;
#pragma unroll
      for (int j = 0; j < 4; ++j) o[j] = pack2(tile[(kg * 8 + 2 * j) * 65 + n], tile[(kg * 8 + 2 * j + 1) * 65 + n]);
      *(u32x4*)(d.dst + (size_t)(d.n0 + n) * d.K + d.k0 + kg * 8) = o;
    }
    d = dn; cur = nxt;
  }
  __syncthreads();
}
__device__ __forceinline__ void p0_sgu_item(const P& p, int it) {
  const float* src = p.in[I_SGUW] + (size_t)it * 8192;
  u16* dst = (u16*)(p.ws + OFF_SGUW) + (size_t)it * 8192;
  const int tid = otid();
#pragma unroll
  for (int i = 0; i < 2; ++i) {
    int e = (tid + i * 512) * 8;
    f32x4 a = *(const f32x4*)(src + e), b = *(const f32x4*)(src + e + 4);
    u32x4 o = {pack2(a[0], a[1]), pack2(a[2], a[3]), pack2(b[0], b[1]), pack2(b[2], b[3])};
    *(u32x4*)(dst + e) = o;
  }
}

__device__ __forceinline__ float shx(float v, int o, int lane) {
  return __int_as_float(__builtin_amdgcn_ds_bpermute((lane ^ o) << 2, __float_as_int(v)));
}
__device__ __forceinline__ float wave_sum(float v, int lane) {
#pragma unroll
  for (int o = 32; o > 0; o >>= 1) v += shx(v, o, lane);
  return v;
}

__device__ __forceinline__ void norm_phase(const P& p, int l, int mode, const float* xa, const float* xb) {
  const int tid = otid(), w = tid >> 6, lane = tid & 63;
  const float* mod = (const float*)(p.ws + OFF_MOD);
  u16* H = (u16*)(p.ws + OFF_H);
  const float* g = mode == 0 ? p.in[I_N1G] + l * 1024 : mode == 1 ? p.in[I_N2G] + l * 1024 : p.in[I_FNG];
  for (int row = obid() * 8 + w; row < T_TOK; row += gridDim.x * 8) {
    const float* x = row < 4096 ? xa + (size_t)row * 1024 : xb + (size_t)(row - 4096) * 1024;
    f32x4 v[4];
    float ss = 0.f;
#pragma unroll
    for (int i = 0; i < 4; ++i) {
      v[i] = *(const f32x4*)(x + i * 256 + lane * 4);
#pragma unroll
      for (int j = 0; j < 4; ++j) ss += v[i][j] * v[i][j];
    }
    ss = wave_sum(ss, lane);
    float rinv = rsqrtf(ss * (1.f / 1024.f) + 1e-6f);
    int m = row < 4096 ? 0 : 1 + ((row - 4096) >> 10);
    const float* mb = mod + (size_t)(l * 3 + m) * 6144 + (mode == 1 ? 3072 : 0);
#pragma unroll
    for (int i = 0; i < 4; ++i) {
      int c = i * 256 + lane * 4;
      f32x4 gg = *(const f32x4*)(g + c);
      if (mode == 2) {
        f32x4 o;
#pragma unroll
        for (int j = 0; j < 4; ++j) o[j] = v[i][j] * rinv * gg[j];
        *(f32x4*)(p.out + (size_t)row * 1024 + c) = o;
      } else {
        f32x4 sh = *(const f32x4*)(mb + c);
        f32x4 sc = *(const f32x4*)(mb + 1024 + c);
        float o[4];
#pragma unroll
        for (int j = 0; j < 4; ++j) o[j] = v[i][j] * rinv * gg[j] * (1.f + sc[j]) + sh[j];
        u32x2 pk = {pack2(o[0], o[1]), pack2(o[2], o[3])};
        *(u32x2*)(H + (size_t)row * 1024 + c) = pk;
      }
    }
  }
}

struct Epi {
  float* outf;
  u16* outb;
  const float* xa;
  const float* xb;
  const float* gate;
  const u16* y1;
  const float* bias;
};

template <int EPI, int K>
__device__ __forceinline__ void gemm_phase(const u16* A, const u16* Bt, int ntn, const Epi& e, char* smem, int bid, int nb) {
  constexpr int LS = 72;
  constexpr int nk = K >> 6;
  u16* sA = (u16*)smem;
  u16* sB = sA + 2 * 192 * LS;
  const int tid = otid(), w = tid >> 6, lane = tid & 63, quad = lane >> 4, l15 = lane & 15;
  const int wm = w >> 1, wn = w & 1;
  const int lrow = tid >> 3, lkc = tid & 7;
  const int ntiles = 32 * ntn;
  if (bid >= ntiles) return;
  const int total = ((ntiles - bid + nb - 1) / nb) * nk;
  u32x4 ra0[3], rb0[2], ra1[3], rb1[2];
  f32x4 acc[3][4];
#pragma unroll
  for (int i = 0; i < 3; ++i)
#pragma unroll
    for (int j = 0; j < 4; ++j) acc[i][j] = (f32x4){0.f, 0.f, 0.f, 0.f};
  auto issue = [&](u32x4 (&ra)[3], u32x4 (&rb)[2], int pos) {
    const int t = bid + (pos / nk) * nb, ks = pos % nk;
    const u16* ap = A + (size_t)((t & 31) * 192 + lrow) * K + lkc * 8 + ks * 64;
    const u16* bp = Bt + (size_t)((t >> 5) * 128 + lrow) * K + lkc * 8 + ks * 64;
#pragma unroll
    for (int i = 0; i < 3; ++i) ra[i] = *(const u32x4*)(ap + (size_t)i * 64 * K);
#pragma unroll
    for (int i = 0; i < 2; ++i) rb[i] = *(const u32x4*)(bp + (size_t)i * 64 * K);
  };
  auto stash = [&](u32x4 (&ra)[3], u32x4 (&rb)[2], int buf) {
#pragma unroll
    for (int i = 0; i < 3; ++i) *(u32x4*)(sA + buf * 192 * LS + (lrow + i * 64) * LS + lkc * 8) = ra[i];
#pragma unroll
    for (int i = 0; i < 2; ++i) *(u32x4*)(sB + buf * 128 * LS + (lrow + i * 64) * LS + lkc * 8) = rb[i];
  };
  auto body = [&](u32x4 (&ra)[3], u32x4 (&rb)[2], int pos) {
    if (pos + 1 < total) stash(ra, rb, (pos + 1) & 1);
    if (pos + 3 < total) issue(ra, rb, pos + 3);
    const int buf = pos & 1;
    const u16* cA = sA + buf * 192 * LS + (wm * 48 + l15) * LS + quad * 8;
    const u16* cB = sB + buf * 128 * LS + (wn * 64 + l15) * LS + quad * 8;
    {
      bf16x8 af[2][3], bq[2][4];
#pragma unroll
      for (int kk = 0; kk < 2; ++kk) {
#pragma unroll
        for (int i = 0; i < 3; ++i) af[kk][i] = ld_frag(cA + i * 16 * LS + kk * 32);
#pragma unroll
        for (int j = 0; j < 4; ++j) bq[kk][j] = ld_frag(cB + j * 16 * LS + kk * 32);
      }
      __builtin_amdgcn_s_setprio(1);
#pragma unroll
      for (int kk = 0; kk < 2; ++kk)
#pragma unroll
        for (int j = 0; j < 4; ++j)
#pragma unroll
          for (int i = 0; i < 3; ++i) acc[i][j] = mfma16(af[kk][i], bq[kk][j], acc[i][j]);
      __builtin_amdgcn_s_setprio(0);
    }
    if ((pos % nk) == nk - 1) {
      const int t = bid + (pos / nk) * nb;
      const int m0 = (t & 31) * 192, n0 = (t >> 5) * 128;
#pragma unroll
      for (int i = 0; i < 3; ++i)
#pragma unroll
        for (int j = 0; j < 4; ++j) {
#pragma unroll
          for (int r = 0; r < 4; ++r) {
            const int row = m0 + wm * 48 + i * 16 + quad * 4 + r;
            const int col = n0 + wn * 64 + j * 16 + l15;
            const float a = acc[i][j][r];
            if (EPI == 0) {
              if (col < IN_DIM) e.outf[(size_t)row * IN_DIM + col] = a;
            } else if (EPI == 1) {
              const float x = row < 4096 ? e.xa[(size_t)row * 1024 + col] : e.xb[(size_t)(row - 4096) * 1024 + col];
              const int m = row < 4096 ? 0 : 1 + ((row - 4096) >> 10);
              e.outf[(size_t)row * 1024 + col] = x + e.gate[m * 6144 + col] * a;
            } else if (EPI == 2) {
              const float rl = a > 0.f ? a : 0.f;
              e.outb[(size_t)row * DFF + col] = f2bf(rl * rl);
            } else {
              const float g = sigmoid_f(a + e.bias[col]);
              const float y = bf2f(e.y1[(size_t)row * 256 + col]);
              e.outb[(size_t)row * 1024 + 768 + col] = f2bf(y * g);
            }
          }
          acc[i][j] = (f32x4){0.f, 0.f, 0.f, 0.f};
        }
    }
    __syncthreads();
  };
  issue(ra0, rb0, 0);
  if (1 < total) issue(ra1, rb1, 1);
  stash(ra0, rb0, 0);
  if (2 < total) issue(ra0, rb0, 2);
  __syncthreads();
  for (int pos = 0; pos < total; pos += 2) {
    body(ra1, rb1, pos);
    if (pos + 1 < total) body(ra0, rb0, pos + 1);
  }
}

__device__ __forceinline__ void prep_conv(const P& p, int l, int ck, int s, char* smem) {
  float* tile = (float*)smem;
  const int tid = otid();
  const int row0 = ck * 128;
  int seq_lo, seq_hi;
  if (ck < 32) { seq_lo = (ck >> 1) * 256; seq_hi = seq_lo + 256; }
  else { seq_lo = 4096 + ((ck - 32) >> 3) * 1024; seq_hi = seq_lo + 1024; }
  const float* proj = (const float*)(p.ws + OFF_PROJ);
  const int c0 = s * 64;
  for (int id = tid; id < 132 * 16; id += 512) {
    int r = id >> 4, c4 = id & 15;
    int row = row0 - 2 + r;
    f32x4 v = {0.f, 0.f, 0.f, 0.f};
    if (row >= seq_lo && row < seq_hi) v = *(const f32x4*)(proj + (size_t)row * IN_DIM + 512 + c0 + c4 * 4);
    float* d = tile + r * 65 + c4 * 4;
    d[0] = v[0]; d[1] = v[1]; d[2] = v[2]; d[3] = v[3];
  }
  __syncthreads();
  const float* cw = p.in[I_CONVW] + (size_t)l * 5 * 1024;
  const float* cb = p.in[I_CONVB] + (size_t)l * 1024;
  if (s < 12) {
    u16* dstbase;
    if (s < 8) dstbase = (u16*)(p.ws + OFF_XST) + (size_t)(ck * 8 + s) * 64 * 128;
    else dstbase = (u16*)(p.ws + OFF_BMT) + ((size_t)(ck * 2 + ((s - 8) >> 1)) * 128 + ((s - 8) & 1) * 64) * 128;
#pragma unroll
    for (int it = 0; it < 2; ++it) {
      int slot = tid + it * 512;
      int pl = slot & 63, ig = slot >> 6;
      int c = c0 + pl;
      float w0 = cw[c], w1 = cw[1024 + c], w2 = cw[2048 + c], w3 = cw[3072 + c], w4 = cw[4096 + c], bb = cb[c];
      float o[8];
#pragma unroll
      for (int j = 0; j < 8; ++j) {
        int i = ig * 8 + j;
        float a = bb + tile[i * 65 + pl] * w0 + tile[(i + 1) * 65 + pl] * w1 + tile[(i + 2) * 65 + pl] * w2 +
                  tile[(i + 3) * 65 + pl] * w3 + tile[(i + 4) * 65 + pl] * w4;
        o[j] = silu_f(a);
      }
      u32x4 pk = {pack2(o[0], o[1]), pack2(o[2], o[3]), pack2(o[4], o[5]), pack2(o[6], o[7])};
      *(u32x4*)(dstbase + (size_t)pl * 128 + ig * 8) = pk;
    }
  }
  if (s >= 8) {
    u16* dstbase = s < 12 ? (u16*)(p.ws + OFF_BM) + (s - 8) * 64 : (u16*)(p.ws + OFF_CM) + (s - 12) * 64;
#pragma unroll
    for (int it = 0; it < 2; ++it) {
      int slot = tid + it * 512;
      int cg8 = slot & 7, i = slot >> 3;
      float o[8];
#pragma unroll
      for (int j = 0; j < 8; ++j) {
        int pl = cg8 * 8 + j;
        int c = c0 + pl;
        float a = cb[c] + tile[i * 65 + pl] * cw[c] + tile[(i + 1) * 65 + pl] * cw[1024 + c] +
                  tile[(i + 2) * 65 + pl] * cw[2048 + c] + tile[(i + 3) * 65 + pl] * cw[3072 + c] +
                  tile[(i + 4) * 65 + pl] * cw[4096 + c];
        o[j] = silu_f(a);
      }
      u32x4 pk = {pack2(o[0], o[1]), pack2(o[2], o[3]), pack2(o[4], o[5]), pack2(o[6], o[7])};
      *(u32x4*)(dstbase + (size_t)(row0 + i) * 256 + cg8 * 8) = pk;
    }
  }
  __syncthreads();
}

__device__ __forceinline__ void prep_dt(const P& p, int l, int ck, char* smem) {
  float* dts = (float*)smem;
  const int tid = otid();
  const float* proj = (const float*)(p.ws + OFF_PROJ);
  const int row0 = ck * 128;
#pragma unroll
  for (int it = 0; it < 4; ++it) {
    int i = (tid >> 4) + it * 32, col = tid & 15;
    float x = proj[(size_t)(row0 + i) * IN_DIM + 1536 + col] + p.in[I_DTB][l * 16 + col];
    dts[i * 16 + col] = softplus_f(x);
  }
  __syncthreads();
  if (tid < 16) {
    const int dir = tid >> 3, h = tid & 7;
    const float a = -expf(p.in[I_ALOG][l * 16 + tid]);
    float* DT = (float*)(p.ws + OFF_DT) + (size_t)((ck * 2 + dir) * 8 + h) * 128;
    float* CUM = (float*)(p.ws + OFF_CUM) + (size_t)((ck * 2 + dir) * 8 + h) * 128;
    float* WD = (float*)(p.ws + OFF_WDEC) + (size_t)((ck * 2 + dir) * 8 + h) * 128;
    float run = 0.f;
    if (dir == 0) {
      for (int i = 0; i < 128; ++i) { float d = dts[i * 16 + tid]; run += d * a; DT[i] = d; CUM[i] = run; dts[i * 16 + tid] = run; }
    } else {
      for (int i = 127; i >= 0; --i) { float d = dts[i * 16 + tid]; run += d * a; DT[i] = d; CUM[i] = run; dts[i * 16 + tid] = run; }
    }
    for (int i = 0; i < 128; ++i) WD[i] = DT[i] * __expf(run - dts[i * 16 + tid]);
  }
  __syncthreads();
}

__device__ __forceinline__ void prep_v(const P& p, int l, int ck, char* smem) {
  u16* tl = (u16*)smem;
  const int tid = otid(), w = tid >> 6, lane = tid & 63;
  const float* proj = (const float*)(p.ws + OFF_PROJ);
  const int row0 = ck * 128;
  const f32x4 g = *(const f32x4*)(p.in[I_SGUNG] + l * 256 + lane * 4);
  for (int rr = 0; rr < 16; ++rr) {
    int i = w * 16 + rr;
    f32x4 v = *(const f32x4*)(proj + (size_t)(row0 + i) * IN_DIM + 1552 + 256 + lane * 4);
    float ss = 0.f;
#pragma unroll
    for (int j = 0; j < 4; ++j) { v[j] = gelu_t(v[j]); ss += v[j] * v[j]; }
    ss = wave_sum(ss, lane);
    float rinv = rsqrtf(ss * (1.f / 256.f) + 1e-6f);
    u32x2 pk = {pack2(v[0] * rinv * g[0], v[1] * rinv * g[1]), pack2(v[2] * rinv * g[2], v[3] * rinv * g[3])};
    *(u32x2*)(tl + i * 264 + lane * 4) = pk;
  }
  __syncthreads();
  u16* VT = (u16*)(p.ws + OFF_VT) + (size_t)ck * 256 * 128;
#pragma unroll
  for (int it = 0; it < 8; ++it) {
    int c = tid & 255, ig = (tid >> 8) + 2 * it;
    u32x4 pk;
#pragma unroll
    for (int j = 0; j < 4; ++j)
      pk[j] = (unsigned)tl[(ig * 8 + 2 * j) * 264 + c] | ((unsigned)tl[(ig * 8 + 2 * j + 1) * 264 + c] << 16);
    *(u32x4*)(VT + (size_t)c * 128 + ig * 8) = pk;
  }
  __syncthreads();
}

template <int NT, bool PIPE>
__device__ __forceinline__ void ssd_state_chain(const P& p, int l, int sq, int h, int dir, int pt, int ntile0) {
  const int g = h >> 2;
  const bool lat = sq >= 16;
  const int nck = lat ? 8 : 2;
  const int ck0 = lat ? 32 + (sq - 16) * 8 : sq * 2;
  const int tid = otid(), w = tid >> 6, lane = tid & 63, quad = lane >> 4, l15 = lane & 15;
  const int lane_off = (pt * 16 + quad * 4) * 128 + ntile0 * 16 + l15;
  f32x4 acc[NT];
  if (lat) {
    const float* s0 = p.in[I_SSSD] + ((size_t)((((sq - 16) * 2 + l) * 2 + dir) * 8 + h) * 64) * 128;
#pragma unroll
    for (int nt = 0; nt < NT; ++nt)
#pragma unroll
      for (int r = 0; r < 4; ++r) acc[nt][r] = (s0 + lane_off)[r * 128 + nt * 16];
  } else {
#pragma unroll
    for (int nt = 0; nt < NT; ++nt) acc[nt] = (f32x4){0.f, 0.f, 0.f, 0.f};
  }
  const u16* XST = (const u16*)(p.ws + OFF_XST);
  const u16* BMT = (const u16*)(p.ws + OFF_BMT);
  u16* HPREV = (u16*)(p.ws + OFF_HPREV);
  u32x4 xr[4];
  f32x4 ww[4][2];
  bf16x8 bfr[4][NT];
  float cum_end = 0.f;
  auto issue = [&](int step) {
    const int ck = dir == 0 ? ck0 + step : ck0 + nck - 1 - step;
    const float* WD = (const float*)(p.ws + OFF_WDEC) + (size_t)((ck * 2 + dir) * 8 + h) * 128;
    const float* CUM = (const float*)(p.ws + OFF_CUM) + (size_t)((ck * 2 + dir) * 8 + h) * 128;
    cum_end = CUM[dir == 0 ? 127 : 0];
    const u16* xa = XST + ((size_t)(ck * 8 + h) * 64 + pt * 16 + l15) * 128;
    const u16* bb = BMT + ((size_t)(ck * 2 + g) * 128 + ntile0 * 16 + l15) * 128;
#pragma unroll
    for (int ks = 0; ks < 4; ++ks) {
      const int k0 = ks * 32 + quad * 8;
      xr[ks] = *(const u32x4*)(xa + k0);
      ww[ks][0] = *(const f32x4*)(WD + k0); ww[ks][1] = *(const f32x4*)(WD + k0 + 4);
#pragma unroll
      for (int nt = 0; nt < NT; ++nt) bfr[ks][nt] = ld_frag(bb + (size_t)nt * 16 * 128 + k0);
    }
  };
  if (PIPE) issue(0);
  for (int step = 0; step < nck; ++step) {
    const int ck = dir == 0 ? ck0 + step : ck0 + nck - 1 - step;
    u16* hp = HPREV + ((size_t)((ck * 2 + dir) * 8 + h) * 64) * 128;
    if (!PIPE) issue(step);
    const float decay = __expf(cum_end);
    bf16x8 af[4];
    bf16x8 bcur[4][NT];
#pragma unroll
    for (int ks = 0; ks < 4; ++ks) {
      u32x4 xs;
#pragma unroll
      for (int j = 0; j < 4; ++j) {
        float lo = __uint_as_float(xr[ks][j] << 16) * ww[ks][j >> 1][(j & 1) * 2];
        float hi = __uint_as_float(xr[ks][j] & 0xffff0000u) * ww[ks][j >> 1][(j & 1) * 2 + 1];
        xs[j] = pack2(lo, hi);
      }
      af[ks] = __builtin_bit_cast(bf16x8, xs);
#pragma unroll
      for (int nt = 0; nt < NT; ++nt) bcur[ks][nt] = bfr[ks][nt];
    }
    if (PIPE && step + 1 < nck) issue(step + 1);
#pragma unroll
    for (int nt = 0; nt < NT; ++nt)
#pragma unroll
      for (int r = 0; r < 4; ++r) (hp + lane_off)[r * 128 + nt * 16] = f2bf(acc[nt][r]);
#pragma unroll
    for (int nt = 0; nt < NT; ++nt)
#pragma unroll
      for (int r = 0; r < 4; ++r) acc[nt][r] *= decay;
#pragma unroll
    for (int ks = 0; ks < 4; ++ks)
#pragma unroll
      for (int nt = 0; nt < NT; ++nt) acc[nt] = mfma16(af[ks], bcur[ks][nt], acc[nt]);
  }
  if (!lat) {
    float* o = p.out + OUT_SSD + ((size_t)(((sq * 2 + l) * 2 + dir) * 8 + h) * 64) * 128;
#pragma unroll
    for (int nt = 0; nt < NT; ++nt)
#pragma unroll
      for (int r = 0; r < 4; ++r) (o + lane_off)[r * 128 + nt * 16] = acc[nt][r];
  }
}
__device__ __forceinline__ void ssd_state_item(const P& p, int l, int item) {
  const int w = otid() >> 6;
  if (item < 128) {
    const int idx = item >> 2, nq = item & 3;
    ssd_state_chain<1, false>(p, l, 16 + (idx >> 4), (idx & 15) >> 1, idx & 1, nq, w);
  } else {
    const int idx = item - 128;
    ssd_state_chain<4, false>(p, l, idx >> 4, (idx & 15) >> 1, idx & 1, w & 3, (w >> 2) * 4);
  }
}

__device__ __forceinline__ void s5_table_item(const P& p) {
  const int tid = otid();
  for (int e = tid; e < 4096; e += 512) {
    const float are = p.in[I_LRE][e], aim = p.in[I_LIM][e];
    const float step = expf(p.in[I_LOGDT][e >> 6]);
    const float er = expf(are * step), th = aim * step;
    const float lr = er * cosf(th), li = er * sinf(th);
    const float nr = lr - 1.f, ni = li;
    const float den = 1.f / (are * are + aim * aim);
    const float kr = (nr * are + ni * aim) * den, ki = (ni * are - nr * aim) * den;
    float pr = lr, pi = li;
#pragma unroll
    for (int k = 0; k < 5; ++k) { float a = pr * pr - pi * pi, b = 2.f * pr * pi; pr = a; pi = b; }
    f32x4* tab = (f32x4*)(p.ws + OFF_S5TAB) + (size_t)e * 2;
    tab[0] = (f32x4){lr, li, kr, ki};
    tab[1] = (f32x4){pr, pi, 0.f, 0.f};
    const int l = e >> 11, g = (e >> 6) & 15, n = e & 63;
    const float* Br = p.in[I_BRE] + ((size_t)(l * 16 + g) * 64 + n) * 16;
    const float* Bi = p.in[I_BIM] + ((size_t)(l * 16 + g) * 64 + n) * 16;
    u16* bb = (u16*)(p.ws + OFF_S5BB) + ((size_t)(e >> 6) * 128 + n * 2) * 16;
#pragma unroll
    for (int c4 = 0; c4 < 4; ++c4) {
      const f32x4 a = *(const f32x4*)(Br + c4 * 4), b = *(const f32x4*)(Bi + c4 * 4);
      u32x2 re = {pack2(kr * a[0] - ki * b[0], kr * a[1] - ki * b[1]), pack2(kr * a[2] - ki * b[2], kr * a[3] - ki * b[3])};
      u32x2 im = {pack2(kr * b[0] + ki * a[0], kr * b[1] + ki * a[1]), pack2(kr * b[2] + ki * a[2], kr * b[3] + ki * a[3])};
      *(u32x2*)(bb + c4 * 4) = re;
      *(u32x2*)(bb + 16 + c4 * 4) = im;
    }
  }
}
__device__ __forceinline__ void s5_sc_info(int sc, int& sq, int& j, int& nsc, int& sc0, int& row0) {
  if (sc < 128) { sq = sc >> 3; j = sc & 7; nsc = 8; sc0 = sq * 8; row0 = sq * 256; }
  else { int lb = (sc - 128) >> 5; sq = 16 + lb; j = (sc - 128) & 31; nsc = 32; sc0 = 128 + lb * 32; row0 = 4096 + lb * 1024; }
}
__device__ __forceinline__ int s5_row(bool lat, int row0, int s) { return lat ? row0 + (s & 15) * 64 + (s >> 4) : row0 + s; }

__device__ __forceinline__ void s5_load_u(const P& p, int sc, int gq, float* us) {
  int sq, j, nsc, sc0, row0;
  s5_sc_info(sc, sq, j, nsc, sc0, row0);
  const int tid = otid();
  const int gi = tid >> 7, i = (tid & 127) >> 2, c4 = tid & 3;
  const int row = s5_row(sq >= 16, row0, j * 32 + i);
  const float* proj = (const float*)(p.ws + OFF_PROJ);
  f32x4 v = *(const f32x4*)(proj + (size_t)row * IN_DIM + 2064 + (gq * 4 + gi) * 16 + c4 * 4);
  *(f32x4*)(us + (gi * 32 + i) * 16 + c4 * 4) = v;
}
__device__ __forceinline__ void s5_bu_mfma(const P& p, int l, int dir, int g, const float* us_g, float* hb, int lane) {
  const int quad = lane >> 4, l15 = lane & 15;
  bf16x8 af[2];
#pragma unroll
  for (int mt = 0; mt < 2; ++mt) {
    u32x4 pk = {0u, 0u, 0u, 0u};
    if (quad < 2) {
      const f32x4 a = *(const f32x4*)(us_g + (mt * 16 + l15) * 16 + quad * 8), b = *(const f32x4*)(us_g + (mt * 16 + l15) * 16 + quad * 8 + 4);
      pk = (u32x4){pack2(a[0], a[1]), pack2(a[2], a[3]), pack2(b[0], b[1]), pack2(b[2], b[3])};
    }
    af[mt] = __builtin_bit_cast(bf16x8, pk);
  }
  const u16* bb = (const u16*)(p.ws + OFF_S5BB) + ((size_t)((l * 2 + dir) * 16 + g) * 128 + l15) * 16 + (quad & 1) * 8;
#pragma unroll
  for (int nt = 0; nt < 8; ++nt) {
    u32x4 bv = *(const u32x4*)(bb + (size_t)nt * 16 * 16);
    if (quad >= 2) bv = (u32x4){0u, 0u, 0u, 0u};
    const bf16x8 bq = __builtin_bit_cast(bf16x8, bv);
#pragma unroll
    for (int mt = 0; mt < 2; ++mt) {
      f32x4 acc = {0.f, 0.f, 0.f, 0.f};
      acc = mfma16(af[mt], bq, acc);
#pragma unroll
      for (int r = 0; r < 4; ++r) hb[(mt * 16 + quad * 4 + r) * 132 + nt * 16 + l15] = acc[r];
    }
  }
}

__device__ __forceinline__ void s5_local_item(const P& p, int l, int item, char* smem) {
  float* us = (float*)smem;
  float* HB = (float*)(smem + 8192);
  const int sc = item >> 2, gq = item & 3;
  s5_load_u(p, sc, gq, us);
  __syncthreads();
  const int tid = otid(), w = tid >> 6, n = tid & 63;
  const int gi = w >> 1, dir = w & 1, g = gq * 4 + gi;
  float* hb = HB + (gi * 2 + dir) * 32 * 132;
  s5_bu_mfma(p, l, dir, g, us + gi * 32 * 16, hb, n);
  __syncthreads();
  const f32x4 t0 = *((const f32x4*)(p.ws + OFF_S5TAB) + (size_t)(((l * 2 + dir) * 16 + g) * 64 + n) * 2);
  const float lr = t0[0], li = t0[1];
  float hr = 0.f, hi = 0.f;
#pragma unroll 8
  for (int ii = 0; ii < 32; ++ii) {
    const int i = dir == 0 ? ii : 31 - ii;
    const float2 bu = *(const float2*)(hb + i * 132 + n * 2);
    const float a = lr * hr - li * hi + bu.x, b = lr * hi + li * hr + bu.y;
    hr = a; hi = b;
  }
  float* E = (float*)(p.ws + OFF_S5E);
  *(float2*)(E + ((size_t)((sc * 16 + g) * 2 + dir) * 64 + n) * 2) = make_float2(hr, hi);
  __syncthreads();
}

__device__ __forceinline__ void s5_out_item(const P& p, int l, int item, char* smem) {
  float* us = (float*)smem;
  float* HB = (float*)(smem + 8192);
  const int sc = item >> 2, gq = item & 3;
  int sq, j, nsc, sc0, row0;
  s5_sc_info(sc, sq, j, nsc, sc0, row0);
  const bool lat = sq >= 16;
  s5_load_u(p, sc, gq, us);
  __syncthreads();
  const int tid = otid(), w = tid >> 6, lane = tid & 63;
  {
    const int n = lane;
    const int gi = w >> 1, dir = w & 1, g = gq * 4 + gi;
    float* hb = HB + (gi * 2 + dir) * 32 * 132;
    s5_bu_mfma(p, l, dir, g, us + gi * 32 * 16, hb, lane);
    __syncthreads();
    const f32x4* tab = (const f32x4*)(p.ws + OFF_S5TAB) + (size_t)(((l * 2 + dir) * 16 + g) * 64 + n) * 2;
    const f32x4 t0 = tab[0], t1 = tab[1];
    const float lr = t0[0], li = t0[1], pr = t1[0], pi = t1[1];
    float hr = 0.f, hi = 0.f;
    if (lat) {
      const int si = ((((sq - 16) * 2 + l) * 2 + dir) * 16 + g) * 64 + n;
      hr = p.in[I_SS5R][si];
      hi = p.in[I_SS5I][si];
    }
    const float* E = (const float*)(p.ws + OFF_S5E);
    const int nprev = dir == 0 ? j : nsc - 1 - j;
    for (int jj0 = 0; jj0 < nprev; jj0 += 8) {
      float2 ev[8];
#pragma unroll
      for (int u = 0; u < 8; ++u) {
        const int jj = jj0 + u < nprev ? jj0 + u : nprev - 1;
        const int scp = dir == 0 ? sc0 + jj : sc0 + nsc - 1 - jj;
        ev[u] = *(const float2*)(E + ((size_t)((scp * 16 + g) * 2 + dir) * 64 + n) * 2);
      }
#pragma unroll
      for (int u = 0; u < 8; ++u) {
        if (jj0 + u < nprev) {
          const float a = pr * hr - pi * hi + ev[u].x, b = pr * hi + pi * hr + ev[u].y;
          hr = a; hi = b;
        }
      }
    }
#pragma unroll 8
    for (int ii = 0; ii < 32; ++ii) {
      const int i = dir == 0 ? ii : 31 - ii;
      float2* cell = (float2*)(hb + i * 132 + n * 2);
      const float2 bu = *cell;
      const float a = lr * hr - li * hi + bu.x, b = lr * hi + li * hr + bu.y;
      hr = a; hi = b;
      *cell = make_float2(hr, hi);
    }
    if (!lat && ((dir == 0 && j == nsc - 1) || (dir == 1 && j == 0))) {
      const int oi = (((sq * 2 + l) * 2 + dir) * 16 + g) * 64 + n;
      p.out[OUT_S5RE + oi] = hr;
      p.out[OUT_S5IM + oi] = hi;
    }
  }
  __syncthreads();
  {
    const int quad = lane >> 4, l15 = lane & 15;
    const int gi = w >> 1, mt = w & 1, g = gq * 4 + gi;
    const float* Cr = p.in[I_CRE] + ((size_t)(l * 16 + g) * 16 + l15) * 64;
    const float* Ci = p.in[I_CIM] + ((size_t)(l * 16 + g) * 16 + l15) * 64;
    bf16x8 bfr[4];
#pragma unroll
    for (int k4 = 0; k4 < 4; ++k4) {
      f32x4 cr = *(const f32x4*)(Cr + k4 * 16 + quad * 4), ci = *(const f32x4*)(Ci + k4 * 16 + quad * 4);
      u32x4 pk = {pack2(cr[0], -ci[0]), pack2(cr[1], -ci[1]), pack2(cr[2], -ci[2]), pack2(cr[3], -ci[3])};
      bfr[k4] = __builtin_bit_cast(bf16x8, pk);
    }
    f32x4 acc = {0.f, 0.f, 0.f, 0.f};
#pragma unroll
    for (int ks = 0; ks < 8; ++ks) {
      const float* ha = HB + ((gi * 2 + (ks >> 2)) * 32 + mt * 16 + l15) * 132 + (ks & 3) * 32 + quad * 8;
      const f32x4 h0 = *(const f32x4*)ha, h1 = *(const f32x4*)(ha + 4);
      u32x4 pk = {pack2(h0[0], h0[1]), pack2(h0[2], h0[3]), pack2(h1[0], h1[1]), pack2(h1[2], h1[3])};
      acc = mfma16(__builtin_bit_cast(bf16x8, pk), bfr[ks & 3], acc);
    }
    const float dsk = p.in[I_S5D][l * 256 + g * 16 + l15];
    u16* Y1B = (u16*)(p.ws + OFF_Y1B);
#pragma unroll
    for (int r = 0; r < 4; ++r) {
      const int i = mt * 16 + quad * 4 + r;
      const float y = acc[r] + dsk * us[(gi * 32 + i) * 16 + l15];
      const int row = s5_row(lat, row0, j * 32 + i);
      Y1B[(size_t)row * 256 + g * 16 + l15] = f2bf(gelu_t(y));
    }
  }
  __syncthreads();
}

__device__ __forceinline__ void sgu_item(const P& p, int l, int item) {
  const int ck = item >> 2, hd = item & 3;
  const int tid = otid(), w = tid >> 6, lane = tid & 63, quad = lane >> 4, l15 = lane & 15;
  const u16* W = (const u16*)(p.ws + OFF_SGUW) + ((size_t)(l * 4 + hd) * 128 + w * 16 + l15) * 128;
  const u16* VT = (const u16*)(p.ws + OFF_VT) + ((size_t)ck * 256 + hd * 64 + l15) * 128;
  f32x4 acc[4];
#pragma unroll
  for (int d = 0; d < 4; ++d) acc[d] = (f32x4){0.f, 0.f, 0.f, 0.f};
#pragma unroll
  for (int ks = 0; ks < 4; ++ks) {
    const int k0 = ks * 32 + quad * 8;
    bf16x8 af = ld_frag(W + k0);
#pragma unroll
    for (int d = 0; d < 4; ++d) acc[d] = mfma16(af, ld_frag(VT + (size_t)d * 16 * 128 + k0), acc[d]);
  }
  const float* proj = (const float*)(p.ws + OFF_PROJ);
  u16* MIX = (u16*)(p.ws + OFF_MIXED);
#pragma unroll
  for (int r = 0; r < 4; ++r) {
    const int q = w * 16 + quad * 4 + r;
    const float b = p.in[I_SGUB][(l * 4 + hd) * 128 + q];
    const size_t row = (size_t)ck * 128 + q;
#pragma unroll
    for (int d = 0; d < 4; ++d) {
      const int col = hd * 64 + d * 16 + l15;
      const float u = gelu_t(proj[row * IN_DIM + 1552 + col]);
      MIX[row * 1024 + 512 + col] = f2bf(u * (acc[d][r] + b));
    }
  }
}

__device__ __forceinline__ void ssd_out_item(const P& p, int l, int item, char* smem) {
  float* red = (float*)smem;
  const int ck = item >> 2, qb2 = item & 3;
  const int tid = otid(), h = tid >> 6, lane = tid & 63, quad = lane >> 4, l15 = lane & 15;
  const int g = h >> 2, q0 = qb2 * 32;
  const size_t row0 = (size_t)ck * 128;
  const u16* BM = (const u16*)(p.ws + OFF_BM);
  const u16* CM = (const u16*)(p.ws + OFF_CM);
  const float* DTf = (const float*)(p.ws + OFF_DT) + (size_t)((ck * 2 + 0) * 8 + h) * 128;
  const float* DTb = (const float*)(p.ws + OFF_DT) + (size_t)((ck * 2 + 1) * 8 + h) * 128;
  const float* CF = (const float*)(p.ws + OFF_CUM) + (size_t)((ck * 2 + 0) * 8 + h) * 128;
  const float* CB = (const float*)(p.ws + OFF_CUM) + (size_t)((ck * 2 + 1) * 8 + h) * 128;
  bf16x8 cmf[2][4];
#pragma unroll
  for (int t = 0; t < 2; ++t)
#pragma unroll
    for (int ns = 0; ns < 4; ++ns) cmf[t][ns] = ld_frag(CM + (row0 + q0 + t * 16 + l15) * 256 + g * 128 + ns * 32 + quad * 8);
  float cfq[2], cbq[2], dsum[2];
#pragma unroll
  for (int t = 0; t < 2; ++t) {
    const int q = q0 + t * 16 + l15;
    cfq[t] = CF[q]; cbq[t] = CB[q]; dsum[t] = DTf[q] + DTb[q];
  }
  const float Dh = p.in[I_SSDD][l * 8 + h];
  u32x4 As[2][4];
#pragma unroll
  for (int kt = 0; kt < 8; ++kt) {
    f32x4 aT[2] = {{0.f, 0.f, 0.f, 0.f}, {0.f, 0.f, 0.f, 0.f}};
#pragma unroll
    for (int ns = 0; ns < 4; ++ns) {
      const bf16x8 bmf = ld_frag(BM + (row0 + kt * 16 + l15) * 256 + g * 128 + ns * 32 + quad * 8);
      aT[0] = mfma16(bmf, cmf[0][ns], aT[0]);
      aT[1] = mfma16(bmf, cmf[1][ns], aT[1]);
    }
    const int kb = kt * 16 + quad * 4;
    f32x4 c = {0.f, 0.f, 0.f, 0.f}, d = c, c2 = c, d2 = c;
    if (kt <= qb2 * 2 + 1) { c = *(const f32x4*)(CF + kb); d = *(const f32x4*)(DTf + kb); }
    if (kt >= qb2 * 2) { c2 = *(const f32x4*)(CB + kb); d2 = *(const f32x4*)(DTb + kb); }
#pragma unroll
    for (int t = 0; t < 2; ++t) {
      const int qt = qb2 * 2 + t;
      const int q = q0 + t * 16 + l15;
      float m[4];
      if (kt < qt) {
#pragma unroll
        for (int r = 0; r < 4; ++r) m[r] = aT[t][r] * __expf(cfq[t] - c[r]) * d[r];
      } else if (kt > qt) {
#pragma unroll
        for (int r = 0; r < 4; ++r) m[r] = aT[t][r] * __expf(cbq[t] - c2[r]) * d2[r];
      } else {
#pragma unroll
        for (int r = 0; r < 4; ++r) {
          const int k = kb + r;
          float f;
          if (k < q) f = __expf(cfq[t] - c[r]) * d[r];
          else if (k > q) f = __expf(cbq[t] - c2[r]) * d2[r];
          else f = dsum[t];
          m[r] = aT[t][r] * f + (k == q ? Dh : 0.f);
        }
      }
      As[t][kt >> 1][(kt & 1) * 2 + 0] = pack2(m[0], m[1]);
      As[t][kt >> 1][(kt & 1) * 2 + 1] = pack2(m[2], m[3]);
    }
    if (kt & 1) asm volatile("" ::: "memory");
  }
  const u16* XST = (const u16*)(p.ws + OFF_XST) + ((size_t)(ck * 8 + h) * 64 + l15) * 128;
  const u16* HPf = (const u16*)(p.ws + OFF_HPREV) + ((size_t)((ck * 2 + 0) * 8 + h) * 64 + l15) * 128;
  const u16* HPb = (const u16*)(p.ws + OFF_HPREV) + ((size_t)((ck * 2 + 1) * 8 + h) * 64 + l15) * 128;
  const float* proj = (const float*)(p.ws + OFF_PROJ);
  float* ybuf = (float*)(smem + 1024) + (h * 32 + quad * 4) * 65 + l15;
  float ss[2][4] = {{0.f, 0.f, 0.f, 0.f}, {0.f, 0.f, 0.f, 0.f}};
#pragma unroll 1
  for (int pt = 0; pt < 4; ++pt) {
    f32x4 aY[2] = {{0.f, 0.f, 0.f, 0.f}, {0.f, 0.f, 0.f, 0.f}};
    f32x4 aF[2] = {{0.f, 0.f, 0.f, 0.f}, {0.f, 0.f, 0.f, 0.f}};
    f32x4 aB[2] = {{0.f, 0.f, 0.f, 0.f}, {0.f, 0.f, 0.f, 0.f}};
#pragma unroll
    for (int s2 = 0; s2 < 4; ++s2) {
      u32x2 lo = *(const u32x2*)(XST + (size_t)pt * 16 * 128 + (2 * s2) * 16 + quad * 4);
      u32x2 hi = *(const u32x2*)(XST + (size_t)pt * 16 * 128 + (2 * s2 + 1) * 16 + quad * 4);
      const bf16x8 bv = __builtin_bit_cast(bf16x8, (u32x4){lo[0], lo[1], hi[0], hi[1]});
      aY[0] = mfma16(__builtin_bit_cast(bf16x8, As[0][s2]), bv, aY[0]);
      aY[1] = mfma16(__builtin_bit_cast(bf16x8, As[1][s2]), bv, aY[1]);
    }
#pragma unroll
    for (int ns = 0; ns < 4; ++ns) {
      const bf16x8 hf = ld_frag(HPf + (size_t)pt * 16 * 128 + ns * 32 + quad * 8);
      const bf16x8 hb = ld_frag(HPb + (size_t)pt * 16 * 128 + ns * 32 + quad * 8);
      aF[0] = mfma16(cmf[0][ns], hf, aF[0]);
      aF[1] = mfma16(cmf[1][ns], hf, aF[1]);
      aB[0] = mfma16(cmf[0][ns], hb, aB[0]);
      aB[1] = mfma16(cmf[1][ns], hb, aB[1]);
    }
#pragma unroll
    for (int t = 0; t < 2; ++t)
#pragma unroll
      for (int r = 0; r < 4; ++r) {
        const int qq = q0 + t * 16 + quad * 4 + r;
        float yv = aY[t][r] + __expf(CF[qq]) * aF[t][r] + __expf(CB[qq]) * aB[t][r];
        const float zv = proj[(row0 + qq) * IN_DIM + h * 64 + pt * 16 + l15];
        yv *= silu_f(zv);
        ybuf[(t * 16 + r) * 65 + pt * 16] = yv;
        ss[t][r] += yv * yv;
      }
  }
  const int lane2 = otid() & 63;
#pragma unroll
  for (int t = 0; t < 2; ++t)
#pragma unroll
    for (int r = 0; r < 4; ++r) {
      float sv = ss[t][r];
#pragma unroll
      for (int o = 1; o < 16; o <<= 1) sv += shx(sv, o, lane2);
      ss[t][r] = sv;
    }
  if (l15 == 0) {
#pragma unroll
    for (int t = 0; t < 2; ++t)
#pragma unroll
      for (int r = 0; r < 4; ++r) red[(t * 16 + quad * 4 + r) * 8 + h] = ss[t][r];
  }
  __syncthreads();
  u16* MIX = (u16*)(p.ws + OFF_MIXED);
  const float* ng = p.in[I_SSDNG] + l * 512 + h * 64;
#pragma unroll
  for (int t = 0; t < 2; ++t)
#pragma unroll
    for (int r = 0; r < 4; ++r) {
      const int qq = q0 + t * 16 + quad * 4 + r;
      float tot = 0.f;
#pragma unroll
      for (int hh = 0; hh < 8; ++hh) tot += red[(t * 16 + quad * 4 + r) * 8 + hh];
      const float rinv = rsqrtf(tot * (1.f / 512.f) + 1e-6f);
#pragma unroll
      for (int pt = 0; pt < 4; ++pt) {
        const int pc = pt * 16 + l15;
        MIX[(row0 + qq) * 1024 + h * 64 + pc] = f2bf(ybuf[(t * 16 + r) * 65 + pt * 16] * rinv * ng[pc]);
      }
    }
  __syncthreads();
}

#define XB_TMO      128
#define XB_XCNT(j)  (256  + 64 * (j))
#define XB_XSUB(j)  (1280 + 64 * (j))
#define XB_XGEN(j)  (2304 + 64 * (j))
#define XB_TOP      3328
#define XB_TOPGEN   3392
#define XCD_BAR_WORDS 3456
#define XB_SPIN_CAP (1u << 18)
#define LAS __attribute__((address_space(3)))
__device__ __forceinline__ unsigned xb_ld(unsigned* p) { return __hip_atomic_load(p, __ATOMIC_RELAXED, __HIP_MEMORY_SCOPE_AGENT); }
__device__ __forceinline__ unsigned xb_add(unsigned* p, unsigned v) { return __hip_atomic_fetch_add(p, v, __ATOMIC_RELAXED, __HIP_MEMORY_SCOPE_AGENT); }
__device__ __forceinline__ unsigned xb_xcc_id() { return (unsigned)__builtin_amdgcn_s_getreg((3 << 11) | 20) & 0xFu; }
#define XB_SPIN(cond, bar) do { unsigned _sp = 0; while (cond) { __builtin_amdgcn_s_sleep(1); \
    if ((++_sp & 255u) == 0u) { if (xb_ld(&(bar)[XB_TMO])) break; if (_sp > XB_SPIN_CAP) { atomicAdd(&(bar)[XB_TMO], 1u); break; } } } } while (0)
struct XcdBarrier { unsigned* bar; unsigned x; volatile LAS unsigned* st; };
__device__ __forceinline__ XcdBarrier xcd_barrier_post(unsigned* bar, volatile LAS unsigned* st) {
  XcdBarrier b; b.bar = bar; b.x = xb_xcc_id(); b.st = st;
  if (threadIdx.x == 0) (void)xb_add(&bar[XB_XCNT(b.x)], 1u);
  return b;
}
__device__ __forceinline__ void xcd_barrier_complete(unsigned* bar, unsigned x, unsigned& nloc, unsigned& nx) {
  const unsigned G = gridDim.x * gridDim.y * gridDim.z;
  unsigned sum, cnt, mine, sp = 0u;
  for (;;) {
    sum = 0u; cnt = 0u; mine = 0u;
#pragma unroll
    for (unsigned j = 0; j < 16; ++j) { const unsigned c = xb_ld(&bar[XB_XCNT(j)]); sum += c; cnt += (c > 0u) ? 1u : 0u; mine = (j == x) ? c : mine; }
    if (sum == G) break;
    __builtin_amdgcn_s_sleep(1);
    if ((++sp & 255u) == 0u) { if (xb_ld(&bar[XB_TMO])) break; if (sp > XB_SPIN_CAP) { atomicAdd(&bar[XB_TMO], 1u); break; } }
  }
  nloc = mine > 0u ? mine : 1u; nx = cnt > 0u ? cnt : 1u;
}
__device__ __forceinline__ void xcd_barrier(const XcdBarrier& b) {
  asm volatile("s_waitcnt vmcnt(0)" ::: "memory");
  __syncthreads();
  if (threadIdx.x == 0) {
    unsigned* bar = b.bar;
    __builtin_amdgcn_s_waitcnt(0);
    unsigned nloc = b.st[0], nx = b.st[1];
    if (nloc == 0u) { xcd_barrier_complete(bar, b.x, nloc, nx); b.st[0] = nloc; b.st[1] = nx; }
    const unsigned old = xb_add(&bar[XB_XSUB(b.x)], 1u);
    const unsigned gen = old / nloc;
    if (old + 1u == (gen + 1u) * nloc) {
      __builtin_amdgcn_fence(__ATOMIC_RELEASE, "agent");
      asm volatile("s_waitcnt vmcnt(0)" ::: "memory");
      const unsigned og = xb_add(&bar[XB_TOP], 1u);
      const unsigned tg = og / nx;
      if (og + 1u == (tg + 1u) * nx) xb_add(&bar[XB_TOPGEN], 1u);
      else XB_SPIN(xb_ld(&bar[XB_TOPGEN]) == tg, bar);
      __builtin_amdgcn_fence(__ATOMIC_ACQUIRE, "agent");
      xb_add(&bar[XB_XGEN(b.x)], 1u);
      asm volatile("s_waitcnt vmcnt(0)" ::: "memory");
    } else {
      XB_SPIN(xb_ld(&bar[XB_XGEN(b.x)]) == gen, bar);
      __builtin_amdgcn_fence(__ATOMIC_ACQUIRE, "agent");
      asm volatile("s_waitcnt vmcnt(0)" ::: "memory");
    }
  }
  __syncthreads();
}

__device__ __forceinline__ int next_item(unsigned* ctr, int* slot) {
  __syncthreads();
  if (threadIdx.x == 0) *slot = (int)xb_add(ctr, 1u);
  __syncthreads();
  return *slot;
}

__device__ __forceinline__ void run_phase(const P& p, int ph, int rep, char* smem, int* qslot) {
  const int nb = gridDim.x, bid = obid();
  unsigned* qctr = (unsigned*)(p.ws + OFF_BAR) + 3520 + 16 * (ph * 2 + rep);
  if (ph == 0) {
    for (int it = bid; it < 96 + 16 + 1; it += nb) {
      if (it < 96) mod_item(p, it, smem);
      else if (it < 112) p0_sgu_item(p, it - 96);
      else s5_table_item(p);
    }
    p0_transposes(p, smem);
    return;
  }
  if (ph == 21) {
    norm_phase(p, 0, 2, (const float*)(p.ws + OFF_XB), (const float*)(p.ws + OFF_XB) + (size_t)4096 * 1024);
    return;
  }
  const int l = (ph - 1) / 10, sp = (ph - 1) % 10;
  const float* x0a = l == 0 ? p.in[I_XP] : (const float*)(p.ws + OFF_XB);
  const float* x0b = l == 0 ? p.in[I_XS] : (const float*)(p.ws + OFF_XB) + (size_t)4096 * 1024;
  const float* x1a = (const float*)(p.ws + OFF_XA);
  const float* x1b = x1a + (size_t)4096 * 1024;
  const float* mod = (const float*)(p.ws + OFF_MOD) + (size_t)l * 3 * 6144;
  Epi e{};
  switch (sp) {
    case 0: norm_phase(p, l, 0, x0a, x0b); break;
    case 1:
      e.outf = (float*)(p.ws + OFF_PROJ);
      gemm_phase<0, 1024>((const u16*)(p.ws + OFF_H), (const u16*)(p.ws + OFF_WIN_T) + (size_t)l * IN_PAD * 1024, 19, e, smem, bid, nb);
      break;
    case 2: {
      constexpr int NB = 768 * ((DUP & 16) ? 2 : 1);
      for (int it = next_item(qctr, qslot); it < 864 + NB; it = next_item(qctr, qslot)) {
        if (it < 48) prep_v(p, l, it, smem);
        else if (it < 48 + NB) s5_local_item(p, l, (it - 48) % 768, smem);
        else if (it < 48 + NB + 768) { int k = it - 48 - NB; prep_conv(p, l, k >> 4, k & 15, smem); }
        else prep_dt(p, l, it - 816 - NB, smem);
      }
    } break;
    case 3: {
      constexpr int NA = 384 * ((DUP & 8) ? 2 : 1), NB = 768 * ((DUP & 2) ? 2 : 1), NC = 192 * ((DUP & 4) ? 2 : 1);
      for (int it = next_item(qctr, qslot); it < NA + NB + NC; it = next_item(qctr, qslot)) {
        if (it < NA) ssd_state_item(p, l, it % 384);
        else if (it < NA + NB) s5_out_item(p, l, (it - NA) % 768, smem);
        else sgu_item(p, l, (it - NA - NB) % 192);
      }
    } break;
    case 4: {
      constexpr int NA = 192 * ((DUP & 1) ? 2 : 1);
      Epi ge{};
      ge.outb = (u16*)(p.ws + OFF_MIXED);
      ge.y1 = (const u16*)(p.ws + OFF_Y1B);
      ge.bias = p.in[I_GLUB] + l * 256;
      {
        const int g0 = nb > 64 ? nb - 64 : 0;
        if (bid >= g0) gemm_phase<3, 256>((const u16*)(p.ws + OFF_Y1B), (const u16*)(p.ws + OFF_GLU_T) + (size_t)l * 256 * 256, 2, ge, smem, bid - g0, nb - g0);
      }
      for (int it = next_item(qctr, qslot); it < NA; it = next_item(qctr, qslot)) ssd_out_item(p, l, it % 192, smem);
    } break;
    case 5: break;
    case 6:
      e.outf = (float*)(p.ws + OFF_XA);
      e.xa = x0a; e.xb = x0b; e.gate = mod + 2048;
      gemm_phase<1, 1024>((const u16*)(p.ws + OFF_MIXED), (const u16*)(p.ws + OFF_WOUT_T) + (size_t)l * 1024 * 1024, 8, e, smem, bid, nb);
      break;
    case 7: norm_phase(p, l, 1, x1a, x1b); break;
    case 8:
      e.outb = (u16*)(p.ws + OFF_PROJ);
      gemm_phase<2, 1024>((const u16*)(p.ws + OFF_H), (const u16*)(p.ws + OFF_W1_T) + (size_t)l * 4096 * 1024, 32, e, smem, bid, nb);
      break;
    case 9:
      e.outf = (float*)(p.ws + OFF_XB);
      e.xa = x1a; e.xb = x1b; e.gate = mod + 5120;
      gemm_phase<1, 4096>((const u16*)(p.ws + OFF_PROJ), (const u16*)(p.ws + OFF_W2_T) + (size_t)l * 1024 * 4096, 8, e, smem, bid, nb);
      break;
  }
}

#ifndef REP_MASK
#define REP_MASK 0
#endif
__device__ __forceinline__ int phase_type(int ph) { return ph == 0 ? 10 : ph == 21 ? 11 : (ph - 1) % 10; }

__global__ void __launch_bounds__(512) mega(P p, int ph_lo, int ph_hi, int coop) {
  __shared__ __attribute__((aligned(16))) char smem[SMEM_BYTES];
  __shared__ __attribute__((aligned(16))) unsigned xb_words[4];
  XcdBarrier xb;
  if (coop) {
    if (threadIdx.x < 4) xb_words[threadIdx.x] = 0u;
    __syncthreads();
    xb = xcd_barrier_post((unsigned*)(p.ws + OFF_BAR), (volatile LAS unsigned*)xb_words);
  }
  for (int ph = ph_lo; ph < ph_hi; ++ph) {
    if (phase_type(ph) == 5) continue;
    const int reps = ((REP_MASK >> phase_type(ph)) & 1) ? 2 : 1;
    for (int r = 0; r < reps; ++r) run_phase(p, ph, r, smem, (int*)&xb_words[2]);
    if (coop == 1 && ph + 1 < ph_hi) xcd_barrier(xb);
    if (coop == 2) cg::this_grid().sync();
  }
}

extern "C" void kernel_launch(void* const* d_in, const int* in_sizes, int n_in, void* d_out, int out_size, void* d_ws,
                              size_t ws_size, hipStream_t stream) {
  static int grid_blocks = 0;
  if (!grid_blocks) {
    int dev = 0, cus = 0, per_cu = 0;
    hipGetDevice(&dev);
    hipDeviceGetAttribute(&cus, hipDeviceAttributeMultiprocessorCount, dev);
    hipOccupancyMaxActiveBlocksPerMultiprocessor(&per_cu, mega, 512, 0);
    if (per_cu < 1) per_cu = 1;
    grid_blocks = cus * per_cu;
  }
  P p{};
  for (int i = 0; i < 35; ++i) p.in[i] = (const float*)d_in[i];
  p.out = (float*)d_out;
  p.ws = (char*)d_ws;
  if (ws_size < WS_TOTAL) { fprintf(stderr, "workspace too small: %zu < %zu\n", ws_size, (size_t)WS_TOTAL); return; }
#if COOP
  hipMemsetAsync((char*)d_ws + OFF_BAR, 0, 65536, stream);
  int lo = 0, hi = 22, coop = 1;
  void* args[] = {&p, &lo, &hi, &coop};
  hipError_t err = hipLaunchCooperativeKernel((void*)mega, dim3(grid_blocks), dim3(512), args, 0, stream);
  if (err != hipSuccess) fprintf(stderr, "cooperative launch failed: %s (grid %d)\n", hipGetErrorString(err), grid_blocks);
#else
  for (int ph = 0; ph < 22; ++ph) mega<<<dim3(grid_blocks), dim3(512), 0, stream>>>(p, ph, ph + 1, 0);
#endif
}
```

```cpp
#include <hip/hip_runtime.h>
#include <hip/hip_cooperative_groups.h>
#include <cstdio>
namespace cg = cooperative_groups;

#define DUP 0
#ifndef COOP
#define COOP 1
#endif

typedef unsigned short u16;
typedef __attribute__((ext_vector_type(8))) short bf16x8;
typedef __attribute__((ext_vector_type(4))) float f32x4;
typedef __attribute__((ext_vector_type(4))) unsigned int u32x4;
typedef __attribute__((ext_vector_type(2))) unsigned int u32x2;

constexpr int T_TOK = 6144;
constexpr int DM = 1024;
constexpr int IN_DIM = 2320;
constexpr int IN_PAD = 2432;
constexpr int DFF = 4096;
constexpr int SMEM_BYTES = 143360;

constexpr size_t OFF_WIN_T = 0;
constexpr size_t OFF_WOUT_T = OFF_WIN_T + (size_t)2 * IN_PAD * 1024 * 2;
constexpr size_t OFF_W1_T = OFF_WOUT_T + (size_t)2 * 1024 * 1024 * 2;
constexpr size_t OFF_W2_T = OFF_W1_T + (size_t)2 * 4096 * 1024 * 2;
constexpr size_t OFF_GLU_T = OFF_W2_T + (size_t)2 * 4096 * 1024 * 2;
constexpr size_t OFF_SGUW = OFF_GLU_T + (size_t)2 * 256 * 256 * 2;
constexpr size_t OFF_MOD = OFF_SGUW + (size_t)2 * 4 * 128 * 128 * 2;
constexpr size_t OFF_H = OFF_MOD + (size_t)2 * 3 * 6144 * 4;
constexpr size_t OFF_PROJ = OFF_H + (size_t)T_TOK * 1024 * 2;
constexpr size_t OFF_MIXED = OFF_PROJ + (size_t)T_TOK * IN_DIM * 4;
constexpr size_t OFF_XA = OFF_MIXED + (size_t)T_TOK * 1024 * 2;
constexpr size_t OFF_XB = OFF_XA + (size_t)T_TOK * 1024 * 4;
constexpr size_t OFF_HPREV = OFF_XB + (size_t)T_TOK * 1024 * 4;
constexpr size_t OFF_BM = OFF_HPREV + (size_t)48 * 2 * 8 * 64 * 128 * 2;
constexpr size_t OFF_CM = OFF_BM + (size_t)T_TOK * 256 * 2;
constexpr size_t OFF_BMT = OFF_CM + (size_t)T_TOK * 256 * 2;
constexpr size_t OFF_XST = OFF_BMT + (size_t)48 * 2 * 128 * 128 * 2;
constexpr size_t OFF_VT = OFF_XST + (size_t)48 * 8 * 64 * 128 * 2;
constexpr size_t OFF_DT = OFF_VT + (size_t)48 * 256 * 128 * 2;
constexpr size_t OFF_CUM = OFF_DT + (size_t)48 * 2 * 8 * 128 * 4;
constexpr size_t OFF_WDEC = OFF_CUM + (size_t)48 * 2 * 8 * 128 * 4;
constexpr size_t OFF_S5E = OFF_WDEC + (size_t)48 * 2 * 8 * 128 * 4;
constexpr size_t OFF_Y1B = OFF_S5E + (size_t)192 * 16 * 2 * 64 * 8;
constexpr size_t OFF_S5TAB = OFF_Y1B + (size_t)T_TOK * 256 * 2;
constexpr size_t OFF_S5BB = OFF_S5TAB + (size_t)4096 * 32;
constexpr size_t OFF_BAR = OFF_S5BB + (size_t)64 * 128 * 16 * 2;
constexpr size_t WS_TOTAL = OFF_BAR + 65536;

constexpr size_t OUT_SSD = (size_t)T_TOK * 1024;
constexpr size_t OUT_S5RE = OUT_SSD + (size_t)16 * 2 * 2 * 8 * 64 * 128;
constexpr size_t OUT_S5IM = OUT_S5RE + (size_t)16 * 2 * 2 * 16 * 64;

struct P {
  const float* in[35];
  float* out;
  char* ws;
};

enum { I_XP = 0, I_XS, I_SSSD, I_SS5R, I_SS5I, I_C, I_CCTX, I_ADAW, I_ADAB, I_N1G, I_N2G, I_WIN, I_CONVW, I_CONVB,
       I_DTB, I_ALOG, I_SSDD, I_SSDNG, I_SGUNG, I_SGUW, I_SGUB, I_LRE, I_LIM, I_LOGDT, I_BRE, I_BIM, I_CRE, I_CIM,
       I_S5D, I_GLUW, I_GLUB, I_WOUT, I_W1, I_W2, I_FNG };

__device__ __forceinline__ int otid() { int t = threadIdx.x; asm volatile("" : "+v"(t)); return t; }
__device__ __forceinline__ int obid() { int t = blockIdx.x; asm volatile("" : "+s"(t)); return t; }
__device__ __forceinline__ u16 f2bf(float f) {
  unsigned u = __float_as_uint(f);
  u += 0x7fffu + ((u >> 16) & 1u);
  return (u16)(u >> 16);
}
__device__ __forceinline__ float bf2f(u16 h) { return __uint_as_float(((unsigned)h) << 16); }
__device__ __forceinline__ unsigned pack2(float a, float b) { return (unsigned)f2bf(a) | ((unsigned)f2bf(b) << 16); }

__device__ __forceinline__ float gelu_t(float x) {
  float y = 0.7978845608028654f * (x + 0.044715f * x * x * x);
  float t = __expf(2.f * y);
  float th = 1.f - 2.f / (t + 1.f);
  return 0.5f * x * (1.f + th);
}
__device__ __forceinline__ float sigmoid_f(float x) { return 1.f / (1.f + __expf(-x)); }
__device__ __forceinline__ float silu_f(float x) { return x / (1.f + __expf(-x)); }
__device__ __forceinline__ float softplus_f(float x) { return x > 20.f ? x : log1pf(expf(x)); }

__device__ __forceinline__ f32x4 mfma16(bf16x8 a, bf16x8 b, f32x4 c) {
  return __builtin_amdgcn_mfma_f32_16x16x32_bf16(a, b, c, 0, 0, 0);
}
__device__ __forceinline__ bf16x8 ld_frag(const u16* ptr) {
  return __builtin_bit_cast(bf16x8, *(const u32x4*)ptr);
}

__device__ __forceinline__ void mod_item(const P& p, int it, char* smem) {
  float* sc = (float*)smem;
  float* red = sc + 3072;
  const int tid = otid();
  const int l = it / 96, jb = it % 96;
  const int j0 = jb * 64;
  const int jq = tid & 15, kg = tid >> 4;
  for (int i = tid; i < 3072; i += 512) {
    const int m = i >> 10, k = i & 1023;
    sc[i] = silu_f(m == 0 ? p.in[I_CCTX][k] : p.in[I_C][(m - 1) * 1024 + k]);
  }
  __syncthreads();
  const float* aw = p.in[I_ADAW] + (size_t)l * 1024 * 6144 + (size_t)(kg * 32) * 6144 + j0 + jq * 4;
  float acc[3][4];
#pragma unroll
  for (int m = 0; m < 3; ++m)
#pragma unroll
    for (int j = 0; j < 4; ++j) acc[m][j] = 0.f;
#pragma unroll 1
  for (int k8 = 0; k8 < 4; ++k8) {
    f32x4 wv[8];
#pragma unroll
    for (int u = 0; u < 8; ++u) wv[u] = *(const f32x4*)(aw + (size_t)(k8 * 8 + u) * 6144);
#pragma unroll
    for (int u = 0; u < 8; ++u) {
      const int k = kg * 32 + k8 * 8 + u;
      const float c0 = sc[k], c1 = sc[1024 + k], c2 = sc[2048 + k];
#pragma unroll
      for (int j = 0; j < 4; ++j) {
        acc[0][j] += c0 * wv[u][j];
        acc[1][j] += c1 * wv[u][j];
        acc[2][j] += c2 * wv[u][j];
      }
    }
  }
#pragma unroll
  for (int m = 0; m < 3; ++m)
#pragma unroll
    for (int j = 0; j < 4; ++j) red[(kg * 3 + m) * 64 + jq * 4 + j] = acc[m][j];
  __syncthreads();
  if (tid < 192) {
    const int m = tid >> 6, j = tid & 63;
    float sv = p.in[I_ADAB][l * 6144 + j0 + j];
    for (int gq = 0; gq < 32; ++gq) sv += red[(gq * 3 + m) * 64 + j];
    float* mod = (float*)(p.ws + OFF_MOD);
    mod[(l * 3 + m) * 6144 + j0 + j] = sv;
  }
  __syncthreads();
}

__device__ __forceinline__ void transpose_tile(const float* src, int K, int N, u16* dst, int k0, int n0, char* smem) {
  float* tile = (float*)smem;
  const int tid = otid();
#pragma unroll
  for (int i = 0; i < 4; ++i) {
    int k = (tid >> 4) + 32 * i, n4 = tid & 15;
    int n = n0 + n4 * 4;
    f32x4 v = {0.f, 0.f, 0.f, 0.f};
    if (n < N) v = *(const f32x4*)(src + (size_t)(k0 + k) * N + n);
    float* d = tile + k * 65 + n4 * 4;
    d[0] = v[0]; d[1] = v[1]; d[2] = v[2]; d[3] = v[3];
  }
  __syncthreads();
#pragma unroll
  for (int i = 0; i < 2; ++i) {
    int slot = tid + i * 512;
    int n = slot >> 4, kg = slot & 15;
    u32x4 o;
#pragma unroll
    for (int j = 0; j < 4; ++j)
      o[j] = pack2(tile[(kg * 8 + 2 * j) * 65 + n], tile[(kg * 8 + 2 * j + 1) * 65 + n]);
    *(u32x4*)(dst + (size_t)(n0 + n) * K + k0 + kg * 8) = o;
  }
  __syncthreads();
}

struct TrDesc { const float* src; u16* dst; int K, N, k0, n0; };
__device__ __forceinline__ TrDesc tr_decode(const P& p, int it) {
  TrDesc d;
  int l = it / 1464, r = it % 1464, nt;
  if (r < 304) { d.src = p.in[I_WIN] + (size_t)l * 1024 * IN_DIM; d.dst = (u16*)(p.ws + OFF_WIN_T) + (size_t)l * IN_PAD * 1024; d.K = 1024; d.N = IN_DIM; nt = 38; }
  else if (r < 432) { r -= 304; d.src = p.in[I_WOUT] + (size_t)l * 1024 * 1024; d.dst = (u16*)(p.ws + OFF_WOUT_T) + (size_t)l * 1024 * 1024; d.K = 1024; d.N = 1024; nt = 16; }
  else if (r < 944) { r -= 432; d.src = p.in[I_W1] + (size_t)l * 1024 * 4096; d.dst = (u16*)(p.ws + OFF_W1_T) + (size_t)l * 4096 * 1024; d.K = 1024; d.N = 4096; nt = 64; }
  else if (r < 1456) { r -= 944; d.src = p.in[I_W2] + (size_t)l * 4096 * 1024; d.dst = (u16*)(p.ws + OFF_W2_T) + (size_t)l * 1024 * 4096; d.K = 4096; d.N = 1024; nt = 16; }
  else { r -= 1456; d.src = p.in[I_GLUW] + (size_t)l * 256 * 256; d.dst = (u16*)(p.ws + OFF_GLU_T) + (size_t)l * 256 * 256; d.K = 256; d.N = 256; nt = 4; }
  d.k0 = (r / nt) * 128; d.n0 = (r % nt) * 64;
  return d;
}
__device__ __forceinline__ void tr_load(const TrDesc& d, int tid, f32x4 (&v)[4]) {
#pragma unroll
  for (int i = 0; i < 4; ++i) {
    const int k = (tid >> 4) + 32 * i, n = d.n0 + (tid & 15) * 4;
    v[i] = (f32x4){0.f, 0.f, 0.f, 0.f};
    if (n < d.N) v[i] = *(const f32x4*)(d.src + (size_t)(d.k0 + k) * d.N + n);
  }
}
__device__ __forceinline__ void p0_transposes(const P& p, char* smem) {
  float* tile = (float*)smem;
  const int tid = otid(), nb = gridDim.x;
  int cur = obid();
  if (cur >= 2928) return;
  f32x4 v[4];
  TrDesc d = tr_decode(p, cur);
  tr_load(d, tid, v);
  while (cur < 2928) {
    __syncthreads();
#pragma unroll
    for (int i = 0; i < 4; ++i) {
      float* q = tile + ((tid >> 4) + 32 * i) * 65 + (tid & 15) * 4;
      q[0] = v[i][0]; q[1] = v[i][1]; q[2] = v[i][2]; q[3] = v[i][3];
    }
    __syncthreads();
    const int nxt = cur + nb;
    TrDesc dn = d;
    if (nxt < 2928) { dn = tr_decode(p, nxt); tr_load(dn, tid, v); }
#pragma unroll
    for (int i = 0; i < 2; ++i) {
      const int slot = tid + i * 512;
      const int n = slot >> 4, kg = slot & 15;
      u32x4 o;
#pragma unroll
      for (int j = 0; j < 4; ++j) o[j] = pack2(tile[(kg * 8 + 2 * j) * 65 + n], tile[(kg * 8 + 2 * j + 1) * 65 + n]);
      *(u32x4*)(d.dst + (size_t)(d.n0 + n) * d.K + d.k0 + kg * 8) = o;
    }
    d = dn; cur = nxt;
  }
  __syncthreads();
}
__device__ __forceinline__ void p0_sgu_item(const P& p, int it) {
  const float* src = p.in[I_SGUW] + (size_t)it * 8192;
  u16* dst = (u16*)(p.ws + OFF_SGUW) + (size_t)it * 8192;
  const int tid = otid();
#pragma unroll
  for (int i = 0; i < 2; ++i) {
    int e = (tid + i * 512) * 8;
    f32x4 a = *(const f32x4*)(src + e), b = *(const f32x4*)(src + e + 4);
    u32x4 o = {pack2(a[0], a[1]), pack2(a[2], a[3]), pack2(b[0], b[1]), pack2(b[2], b[3])};
    *(u32x4*)(dst + e) = o;
  }
}

__device__ __forceinline__ float shx(float v, int o, int lane) {
  return __int_as_float(__builtin_amdgcn_ds_bpermute((lane ^ o) << 2, __float_as_int(v)));
}
__device__ __forceinline__ float wave_sum(float v, int lane) {
#pragma unroll
  for (int o = 32; o > 0; o >>= 1) v += shx(v, o, lane);
  return v;
}

__device__ __forceinline__ void norm_phase(const P& p, int l, int mode, const float* xa, const float* xb) {
  const int tid = otid(), w = tid >> 6, lane = tid & 63;
  const float* mod = (const float*)(p.ws + OFF_MOD);
  u16* H = (u16*)(p.ws + OFF_H);
  const float* g = mode == 0 ? p.in[I_N1G] + l * 1024 : mode == 1 ? p.in[I_N2G] + l * 1024 : p.in[I_FNG];
  for (int row = obid() * 8 + w; row < T_TOK; row += gridDim.x * 8) {
    const float* x = row < 4096 ? xa + (size_t)row * 1024 : xb + (size_t)(row - 4096) * 1024;
    f32x4 v[4];
    float ss = 0.f;
#pragma unroll
    for (int i = 0; i < 4; ++i) {
      v[i] = *(const f32x4*)(x + i * 256 + lane * 4);
#pragma unroll
      for (int j = 0; j < 4; ++j) ss += v[i][j] * v[i][j];
    }
    ss = wave_sum(ss, lane);
    float rinv = rsqrtf(ss * (1.f / 1024.f) + 1e-6f);
    int m = row < 4096 ? 0 : 1 + ((row - 4096) >> 10);
    const float* mb = mod + (size_t)(l * 3 + m) * 6144 + (mode == 1 ? 3072 : 0);
#pragma unroll
    for (int i = 0; i < 4; ++i) {
      int c = i * 256 + lane * 4;
      f32x4 gg = *(const f32x4*)(g + c);
      if (mode == 2) {
        f32x4 o;
#pragma unroll
        for (int j = 0; j < 4; ++j) o[j] = v[i][j] * rinv * gg[j];
        *(f32x4*)(p.out + (size_t)row * 1024 + c) = o;
      } else {
        f32x4 sh = *(const f32x4*)(mb + c);
        f32x4 sc = *(const f32x4*)(mb + 1024 + c);
        float o[4];
#pragma unroll
        for (int j = 0; j < 4; ++j) o[j] = v[i][j] * rinv * gg[j] * (1.f + sc[j]) + sh[j];
        u32x2 pk = {pack2(o[0], o[1]), pack2(o[2], o[3])};
        *(u32x2*)(H + (size_t)row * 1024 + c) = pk;
      }
    }
  }
}

struct Epi {
  float* outf;
  u16* outb;
  const float* xa;
  const float* xb;
  const float* gate;
  const u16* y1;
  const float* bias;
};

template <int EPI, int K>
__device__ __forceinline__ void gemm_phase(const u16* A, const u16* Bt, int ntn, const Epi& e, char* smem, int bid, int nb) {
  constexpr int LS = 72;
  constexpr int nk = K >> 6;
  u16* sA = (u16*)smem;
  u16* sB = sA + 2 * 192 * LS;
  const int tid = otid(), w = tid >> 6, lane = tid & 63, quad = lane >> 4, l15 = lane & 15;
  const int wm = w >> 1, wn = w & 1;
  const int lrow = tid >> 3, lkc = tid & 7;
  const int ntiles = 32 * ntn;
  if (bid >= ntiles) return;
  const int total = ((ntiles - bid + nb - 1) / nb) * nk;
  u32x4 ra0[3], rb0[2], ra1[3], rb1[2];
  f32x4 acc[3][4];
#pragma unroll
  for (int i = 0; i < 3; ++i)
#pragma unroll
    for (int j = 0; j < 4; ++j) acc[i][j] = (f32x4){0.f, 0.f, 0.f, 0.f};
  auto issue = [&](u32x4 (&ra)[3], u32x4 (&rb)[2], int pos) {
    const int t = bid + (pos / nk) * nb, ks = pos % nk;
    const u16* ap = A + (size_t)((t & 31) * 192 + lrow) * K + lkc * 8 + ks * 64;
    const u16* bp = Bt + (size_t)((t >> 5) * 128 + lrow) * K + lkc * 8 + ks * 64;
#pragma unroll
    for (int i = 0; i < 3; ++i) ra[i] = *(const u32x4*)(ap + (size_t)i * 64 * K);
#pragma unroll
    for (int i = 0; i < 2; ++i) rb[i] = *(const u32x4*)(bp + (size_t)i * 64 * K);
  };
  auto stash = [&](u32x4 (&ra)[3], u32x4 (&rb)[2], int buf) {
#pragma unroll
    for (int i = 0; i < 3; ++i) *(u32x4*)(sA + buf * 192 * LS + (lrow + i * 64) * LS + lkc * 8) = ra[i];
#pragma unroll
    for (int i = 0; i < 2; ++i) *(u32x4*)(sB + buf * 128 * LS + (lrow + i * 64) * LS + lkc * 8) = rb[i];
  };
  auto body = [&](u32x4 (&ra)[3], u32x4 (&rb)[2], int pos) {
    if (pos + 1 < total) stash(ra, rb, (pos + 1) & 1);
    if (pos + 3 < total) issue(ra, rb, pos + 3);
    const int buf = pos & 1;
    const u16* cA = sA + buf * 192 * LS + (wm * 48 + l15) * LS + quad * 8;
    const u16* cB = sB + buf * 128 * LS + (wn * 64 + l15) * LS + quad * 8;
    {
      bf16x8 af[2][3], bq[2][4];
#pragma unroll
      for (int kk = 0; kk < 2; ++kk) {
#pragma unroll
        for (int i = 0; i < 3; ++i) af[kk][i] = ld_frag(cA + i * 16 * LS + kk * 32);
#pragma unroll
        for (int j = 0; j < 4; ++j) bq[kk][j] = ld_frag(cB + j * 16 * LS + kk * 32);
      }
      __builtin_amdgcn_s_setprio(1);
#pragma unroll
      for (int kk = 0; kk < 2; ++kk)
#pragma unroll
        for (int j = 0; j < 4; ++j)
#pragma unroll
          for (int i = 0; i < 3; ++i) acc[i][j] = mfma16(af[kk][i], bq[kk][j], acc[i][j]);
      __builtin_amdgcn_s_setprio(0);
    }
    if ((pos % nk) == nk - 1) {
      const int t = bid + (pos / nk) * nb;
      const int m0 = (t & 31) * 192, n0 = (t >> 5) * 128;
#pragma unroll
      for (int i = 0; i < 3; ++i)
#pragma unroll
        for (int j = 0; j < 4; ++j) {
#pragma unroll
          for (int r = 0; r < 4; ++r) {
            const int row = m0 + wm * 48 + i * 16 + quad * 4 + r;
            const int col = n0 + wn * 64 + j * 16 + l15;
            const float a = acc[i][j][r];
            if (EPI == 0) {
              if (col < IN_DIM) e.outf[(size_t)row * IN_DIM + col] = a;
            } else if (EPI == 1) {
              const float x = row < 4096 ? e.xa[(size_t)row * 1024 + col] : e.xb[(size_t)(row - 4096) * 1024 + col];
              const int m = row < 4096 ? 0 : 1 + ((row - 4096) >> 10);
              e.outf[(size_t)row * 1024 + col] = x + e.gate[m * 6144 + col] * a;
            } else if (EPI == 2) {
              const float rl = a > 0.f ? a : 0.f;
              e.outb[(size_t)row * DFF + col] = f2bf(rl * rl);
            } else {
              const float g = sigmoid_f(a + e.bias[col]);
              const float y = bf2f(e.y1[(size_t)row * 256 + col]);
              e.outb[(size_t)row * 1024 + 768 + col] = f2bf(y * g);
            }
          }
          acc[i][j] = (f32x4){0.f, 0.f, 0.f, 0.f};
        }
    }
    __syncthreads();
  };
  issue(ra0, rb0, 0);
  if (1 < total) issue(ra1, rb1, 1);
  stash(ra0, rb0, 0);
  if (2 < total) issue(ra0, rb0, 2);
  __syncthreads();
  for (int pos = 0; pos < total; pos += 2) {
    body(ra1, rb1, pos);
    if (pos + 1 < total) body(ra0, rb0, pos + 1);
  }
}

__device__ __forceinline__ void prep_conv(const P& p, int l, int ck, int s, char* smem) {
  float* tile = (float*)smem;
  const int tid = otid();
  const int row0 = ck * 128;
  int seq_lo, seq_hi;
  if (ck < 32) { seq_lo = (ck >> 1) * 256; seq_hi = seq_lo + 256; }
  else { seq_lo = 4096 + ((ck - 32) >> 3) * 1024; seq_hi = seq_lo + 1024; }
  const float* proj = (const float*)(p.ws + OFF_PROJ);
  const int c0 = s * 64;
  for (int id = tid; id < 132 * 16; id += 512) {
    int r = id >> 4, c4 = id & 15;
    int row = row0 - 2 + r;
    f32x4 v = {0.f, 0.f, 0.f, 0.f};
    if (row >= seq_lo && row < seq_hi) v = *(const f32x4*)(proj + (size_t)row * IN_DIM + 512 + c0 + c4 * 4);
    float* d = tile + r * 65 + c4 * 4;
    d[0] = v[0]; d[1] = v[1]; d[2] = v[2]; d[3] = v[3];
  }
  __syncthreads();
  const float* cw = p.in[I_CONVW] + (size_t)l * 5 * 1024;
  const float* cb = p.in[I_CONVB] + (size_t)l * 1024;
  if (s < 12) {
    u16* dstbase;
    if (s < 8) dstbase = (u16*)(p.ws + OFF_XST) + (size_t)(ck * 8 + s) * 64 * 128;
    else dstbase = (u16*)(p.ws + OFF_BMT) + ((size_t)(ck * 2 + ((s - 8) >> 1)) * 128 + ((s - 8) & 1) * 64) * 128;
#pragma unroll
    for (int it = 0; it < 2; ++it) {
      int slot = tid + it * 512;
      int pl = slot & 63, ig = slot >> 6;
      int c = c0 + pl;
      float w0 = cw[c], w1 = cw[1024 + c], w2 = cw[2048 + c], w3 = cw[3072 + c], w4 = cw[4096 + c], bb = cb[c];
      float o[8];
#pragma unroll
      for (int j = 0; j < 8; ++j) {
        int i = ig * 8 + j;
        float a = bb + tile[i * 65 + pl] * w0 + tile[(i + 1) * 65 + pl] * w1 + tile[(i + 2) * 65 + pl] * w2 +
                  tile[(i + 3) * 65 + pl] * w3 + tile[(i + 4) * 65 + pl] * w4;
        o[j] = silu_f(a);
      }
      u32x4 pk = {pack2(o[0], o[1]), pack2(o[2], o[3]), pack2(o[4], o[5]), pack2(o[6], o[7])};
      *(u32x4*)(dstbase + (size_t)pl * 128 + ig * 8) = pk;
    }
  }
  if (s >= 8) {
    u16* dstbase = s < 12 ? (u16*)(p.ws + OFF_BM) + (s - 8) * 64 : (u16*)(p.ws + OFF_CM) + (s - 12) * 64;
#pragma unroll
    for (int it = 0; it < 2; ++it) {
      int slot = tid + it * 512;
      int cg8 = slot & 7, i = slot >> 3;
      float o[8];
#pragma unroll
      for (int j = 0; j < 8; ++j) {
        int pl = cg8 * 8 + j;
        int c = c0 + pl;
        float a = cb[c] + tile[i * 65 + pl] * cw[c] + tile[(i + 1) * 65 + pl] * cw[1024 + c] +
                  tile[(i + 2) * 65 + pl] * cw[2048 + c] + tile[(i + 3) * 65 + pl] * cw[3072 + c] +
                  tile[(i + 4) * 65 + pl] * cw[4096 + c];
        o[j] = silu_f(a);
      }
      u32x4 pk = {pack2(o[0], o[1]), pack2(o[2], o[3]), pack2(o[4], o[5]), pack2(o[6], o[7])};
      *(u32x4*)(dstbase + (size_t)(row0 + i) * 256 + cg8 * 8) = pk;
    }
  }
  __syncthreads();
}

__device__ __forceinline__ void prep_dt(const P& p, int l, int ck, char* smem) {
  float* dts = (float*)smem;
  const int tid = otid();
  const float* proj = (const float*)(p.ws + OFF_PROJ);
  const int row0 = ck * 128;
#pragma unroll
  for (int it = 0; it < 4; ++it) {
    int i = (tid >> 4) + it * 32, col = tid & 15;
    float x = proj[(size_t)(row0 + i) * IN_DIM + 1536 + col] + p.in[I_DTB][l * 16 + col];
    dts[i * 16 + col] = softplus_f(x);
  }
  __syncthreads();
  if (tid < 16) {
    const int dir = tid >> 3, h = tid & 7;
    const float a = -expf(p.in[I_ALOG][l * 16 + tid]);
    float* DT = (float*)(p.ws + OFF_DT) + (size_t)((ck * 2 + dir) * 8 + h) * 128;
    float* CUM = (float*)(p.ws + OFF_CUM) + (size_t)((ck * 2 + dir) * 8 + h) * 128;
    float* WD = (float*)(p.ws + OFF_WDEC) + (size_t)((ck * 2 + dir) * 8 + h) * 128;
    float run = 0.f;
    if (dir == 0) {
      for (int i = 0; i < 128; ++i) { float d = dts[i * 16 + tid]; run += d * a; DT[i] = d; CUM[i] = run; dts[i * 16 + tid] = run; }
    } else {
      for (int i = 127; i >= 0; --i) { float d = dts[i * 16 + tid]; run += d * a; DT[i] = d; CUM[i] = run; dts[i * 16 + tid] = run; }
    }
    for (int i = 0; i < 128; ++i) WD[i] = DT[i] * __expf(run - dts[i * 16 + tid]);
  }
  __syncthreads();
}

__device__ __forceinline__ void prep_v(const P& p, int l, int ck, char* smem) {
  u16* tl = (u16*)smem;
  const int tid = otid(), w = tid >> 6, lane = tid & 63;
  const float* proj = (const float*)(p.ws + OFF_PROJ);
  const int row0 = ck * 128;
  const f32x4 g = *(const f32x4*)(p.in[I_SGUNG] + l * 256 + lane * 4);
  for (int rr = 0; rr < 16; ++rr) {
    int i = w * 16 + rr;
    f32x4 v = *(const f32x4*)(proj + (size_t)(row0 + i) * IN_DIM + 1552 + 256 + lane * 4);
    float ss = 0.f;
#pragma unroll
    for (int j = 0; j < 4; ++j) { v[j] = gelu_t(v[j]); ss += v[j] * v[j]; }
    ss = wave_sum(ss, lane);
    float rinv = rsqrtf(ss * (1.f / 256.f) + 1e-6f);
    u32x2 pk = {pack2(v[0] * rinv * g[0], v[1] * rinv * g[1]), pack2(v[2] * rinv * g[2], v[3] * rinv * g[3])};
    *(u32x2*)(tl + i * 264 + lane * 4) = pk;
  }
  __syncthreads();
  u16* VT = (u16*)(p.ws + OFF_VT) + (size_t)ck * 256 * 128;
#pragma unroll
  for (int it = 0; it < 8; ++it) {
    int c = tid & 255, ig = (tid >> 8) + 2 * it;
    u32x4 pk;
#pragma unroll
    for (int j = 0; j < 4; ++j)
      pk[j] = (unsigned)tl[(ig * 8 + 2 * j) * 264 + c] | ((unsigned)tl[(ig * 8 + 2 * j + 1) * 264 + c] << 16);
    *(u32x4*)(VT + (size_t)c * 128 + ig * 8) = pk;
  }
  __syncthreads();
}

template <int NT, bool PIPE>
__device__ __forceinline__ void ssd_state_chain(const P& p, int l, int sq, int h, int dir, int pt, int ntile0) {
  const int g = h >> 2;
  const bool lat = sq >= 16;
  const int nck = lat ? 8 : 2;
  const int ck0 = lat ? 32 + (sq - 16) * 8 : sq * 2;
  const int tid = otid(), w = tid >> 6, lane = tid & 63, quad = lane >> 4, l15 = lane & 15;
  const int lane_off = (pt * 16 + quad * 4) * 128 + ntile0 * 16 + l15;
  f32x4 acc[NT];
  if (lat) {
    const float* s0 = p.in[I_SSSD] + ((size_t)((((sq - 16) * 2 + l) * 2 + dir) * 8 + h) * 64) * 128;
#pragma unroll
    for (int nt = 0; nt < NT; ++nt)
#pragma unroll
      for (int r = 0; r < 4; ++r) acc[nt][r] = (s0 + lane_off)[r * 128 + nt * 16];
  } else {
#pragma unroll
    for (int nt = 0; nt < NT; ++nt) acc[nt] = (f32x4){0.f, 0.f, 0.f, 0.f};
  }
  const u16* XST = (const u16*)(p.ws + OFF_XST);
  const u16* BMT = (const u16*)(p.ws + OFF_BMT);
  u16* HPREV = (u16*)(p.ws + OFF_HPREV);
  u32x4 xr[4];
  f32x4 ww[4][2];
  bf16x8 bfr[4][NT];
  float cum_end = 0.f;
  auto issue = [&](int step) {
    const int ck = dir == 0 ? ck0 + step : ck0 + nck - 1 - step;
    const float* WD = (const float*)(p.ws + OFF_WDEC) + (size_t)((ck * 2 + dir) * 8 + h) * 128;
    const float* CUM = (const float*)(p.ws + OFF_CUM) + (size_t)((ck * 2 + dir) * 8 + h) * 128;
    cum_end = CUM[dir == 0 ? 127 : 0];
    const u16* xa = XST + ((size_t)(ck * 8 + h) * 64 + pt * 16 + l15) * 128;
    const u16* bb = BMT + ((size_t)(ck * 2 + g) * 128 + ntile0 * 16 + l15) * 128;
#pragma unroll
    for (int ks = 0; ks < 4; ++ks) {
      const int k0 = ks * 32 + quad * 8;
      xr[ks] = *(const u32x4*)(xa + k0);
      ww[ks][0] = *(const f32x4*)(WD + k0); ww[ks][1] = *(const f32x4*)(WD + k0 + 4);
#pragma unroll
      for (int nt = 0; nt < NT; ++nt) bfr[ks][nt] = ld_frag(bb + (size_t)nt * 16 * 128 + k0);
    }
  };
  if (PIPE) issue(0);
  for (int step = 0; step < nck; ++step) {
    const int ck = dir == 0 ? ck0 + step : ck0 + nck - 1 - step;
    u16* hp = HPREV + ((size_t)((ck * 2 + dir) * 8 + h) * 64) * 128;
    if (!PIPE) issue(step);
    const float decay = __expf(cum_end);
    bf16x8 af[4];
    bf16x8 bcur[4][NT];
#pragma unroll
    for (int ks = 0; ks < 4; ++ks) {
      u32x4 xs;
#pragma unroll
      for (int j = 0; j < 4; ++j) {
        float lo = __uint_as_float(xr[ks][j] << 16) * ww[ks][j >> 1][(j & 1) * 2];
        float hi = __uint_as_float(xr[ks][j] & 0xffff0000u) * ww[ks][j >> 1][(j & 1) * 2 + 1];
        xs[j] = pack2(lo, hi);
      }
      af[ks] = __builtin_bit_cast(bf16x8, xs);
#pragma unroll
      for (int nt = 0; nt < NT; ++nt) bcur[ks][nt] = bfr[ks][nt];
    }
    if (PIPE && step + 1 < nck) issue(step + 1);
#pragma unroll
    for (int nt = 0; nt < NT; ++nt)
#pragma unroll
      for (int r = 0; r < 4; ++r) (hp + lane_off)[r * 128 + nt * 16] = f2bf(acc[nt][r]);
#pragma unroll
    for (int nt = 0; nt < NT; ++nt)
#pragma unroll
      for (int r = 0; r < 4; ++r) acc[nt][r] *= decay;
#pragma unroll
    for (int ks = 0; ks < 4; ++ks)
#pragma unroll
      for (int nt = 0; nt < NT; ++nt) acc[nt] = mfma16(af[ks], bcur[ks][nt], acc[nt]);
  }
  if (!lat) {
    float* o = p.out + OUT_SSD + ((size_t)(((sq * 2 + l) * 2 + dir) * 8 + h) * 64) * 128;
#pragma unroll
    for (int nt = 0; nt < NT; ++nt)
#pragma unroll
      for (int r = 0; r < 4; ++r) (o + lane_off)[r * 128 + nt * 16] = acc[nt][r];
  }
}
__device__ __forceinline__ void ssd_state_item(const P& p, int l, int item) {
  const int w = otid() >> 6;
  if (item < 128) {
    const int idx = item >> 2, nq = item & 3;
    ssd_state_chain<1, false>(p, l, 16 + (idx >> 4), (idx & 15) >> 1, idx & 1, nq, w);
  } else {
    const int idx = item - 128;
    ssd_state_chain<4, false>(p, l, idx >> 4, (idx & 15) >> 1, idx & 1, w & 3, (w >> 2) * 4);
  }
}

__device__ __forceinline__ void s5_table_item(const P& p) {
  const int tid = otid();
  for (int e = tid; e < 4096; e += 512) {
    const float are = p.in[I_LRE][e], aim = p.in[I_LIM][e];
    const float step = expf(p.in[I_LOGDT][e >> 6]);
    const float er = expf(are * step), th = aim * step;
    const float lr = er * cosf(th), li = er * sinf(th);
    const float nr = lr - 1.f, ni = li;
    const float den = 1.f / (are * are + aim * aim);
    const float kr = (nr * are + ni * aim) * den, ki = (ni * are - nr * aim) * den;
    float pr = lr, pi = li;
#pragma unroll
    for (int k = 0; k < 5; ++k) { float a = pr * pr - pi * pi, b = 2.f * pr * pi; pr = a; pi = b; }
    f32x4* tab = (f32x4*)(p.ws + OFF_S5TAB) + (size_t)e * 2;
    tab[0] = (f32x4){lr, li, kr, ki};
    tab[1] = (f32x4){pr, pi, 0.f, 0.f};
    const int l = e >> 11, g = (e >> 6) & 15, n = e & 63;
    const float* Br = p.in[I_BRE] + ((size_t)(l * 16 + g) * 64 + n) * 16;
    const float* Bi = p.in[I_BIM] + ((size_t)(l * 16 + g) * 64 + n) * 16;
    u16* bb = (u16*)(p.ws + OFF_S5BB) + ((size_t)(e >> 6) * 128 + n * 2) * 16;
#pragma unroll
    for (int c4 = 0; c4 < 4; ++c4) {
      const f32x4 a = *(const f32x4*)(Br + c4 * 4), b = *(const f32x4*)(Bi + c4 * 4);
      u32x2 re = {pack2(kr * a[0] - ki * b[0], kr * a[1] - ki * b[1]), pack2(kr * a[2] - ki * b[2], kr * a[3] - ki * b[3])};
      u32x2 im = {pack2(kr * b[0] + ki * a[0], kr * b[1] + ki * a[1]), pack2(kr * b[2] + ki * a[2], kr * b[3] + ki * a[3])};
      *(u32x2*)(bb + c4 * 4) = re;
      *(u32x2*)(bb + 16 + c4 * 4) = im;
    }
  }
}
__device__ __forceinline__ void s5_sc_info(int sc, int& sq, int& j, int& nsc, int& sc0, int& row0) {
  if (sc < 128) { sq = sc >> 3; j = sc & 7; nsc = 8; sc0 = sq * 8; row0 = sq * 256; }
  else { int lb = (sc - 128) >> 5; sq = 16 + lb; j = (sc - 128) & 31; nsc = 32; sc0 = 128 + lb * 32; row0 = 4096 + lb * 1024; }
}
__device__ __forceinline__ int s5_row(bool lat, int row0, int s) { return lat ? row0 + (s & 15) * 64 + (s >> 4) : row0 + s; }

__device__ __forceinline__ void s5_load_u(const P& p, int sc, int gq, float* us) {
  int sq, j, nsc, sc0, row0;
  s5_sc_info(sc, sq, j, nsc, sc0, row0);
  const int tid = otid();
  const int gi = tid >> 7, i = (tid & 127) >> 2, c4 = tid & 3;
  const int row = s5_row(sq >= 16, row0, j * 32 + i);
  const float* proj = (const float*)(p.ws + OFF_PROJ);
  f32x4 v = *(const f32x4*)(proj + (size_t)row * IN_DIM + 2064 + (gq * 4 + gi) * 16 + c4 * 4);
  *(f32x4*)(us + (gi * 32 + i) * 16 + c4 * 4) = v;
}
__device__ __forceinline__ void s5_bu_mfma(const P& p, int l, int dir, int g, const float* us_g, float* hb, int lane) {
  const int quad = lane >> 4, l15 = lane & 15;
  bf16x8 af[2];
#pragma unroll
  for (int mt = 0; mt < 2; ++mt) {
    u32x4 pk = {0u, 0u, 0u, 0u};
    if (quad < 2) {
      const f32x4 a = *(const f32x4*)(us_g + (mt * 16 + l15) * 16 + quad * 8), b = *(const f32x4*)(us_g + (mt * 16 + l15) * 16 + quad * 8 + 4);
      pk = (u32x4){pack2(a[0], a[1]), pack2(a[2], a[3]), pack2(b[0], b[1]), pack2(b[2], b[3])};
    }
    af[mt] = __builtin_bit_cast(bf16x8, pk);
  }
  const u16* bb = (const u16*)(p.ws + OFF_S5BB) + ((size_t)((l * 2 + dir) * 16 + g) * 128 + l15) * 16 + (quad & 1) * 8;
#pragma unroll
  for (int nt = 0; nt < 8; ++nt) {
    u32x4 bv = *(const u32x4*)(bb + (size_t)nt * 16 * 16);
    if (quad >= 2) bv = (u32x4){0u, 0u, 0u, 0u};
    const bf16x8 bq = __builtin_bit_cast(bf16x8, bv);
#pragma unroll
    for (int mt = 0; mt < 2; ++mt) {
      f32x4 acc = {0.f, 0.f, 0.f, 0.f};
      acc = mfma16(af[mt], bq, acc);
#pragma unroll
      for (int r = 0; r < 4; ++r) hb[(mt * 16 + quad * 4 + r) * 132 + nt * 16 + l15] = acc[r];
    }
  }
}

__device__ __forceinline__ void s5_local_item(const P& p, int l, int item, char* smem) {
  float* us = (float*)smem;
  float* HB = (float*)(smem + 8192);
  const int sc = item >> 2, gq = item & 3;
  s5_load_u(p, sc, gq, us);
  __syncthreads();
  const int tid = otid(), w = tid >> 6, n = tid & 63;
  const int gi = w >> 1, dir = w & 1, g = gq * 4 + gi;
  float* hb = HB + (gi * 2 + dir) * 32 * 132;
  s5_bu_mfma(p, l, dir, g, us + gi * 32 * 16, hb, n);
  __syncthreads();
  const f32x4 t0 = *((const f32x4*)(p.ws + OFF_S5TAB) + (size_t)(((l * 2 + dir) * 16 + g) * 64 + n) * 2);
  const float lr = t0[0], li = t0[1];
  float hr = 0.f, hi = 0.f;
#pragma unroll 8
  for (int ii = 0; ii < 32; ++ii) {
    const int i = dir == 0 ? ii : 31 - ii;
    const float2 bu = *(const float2*)(hb + i * 132 + n * 2);
    const float a = lr * hr - li * hi + bu.x, b = lr * hi + li * hr + bu.y;
    hr = a; hi = b;
  }
  float* E = (float*)(p.ws + OFF_S5E);
  *(float2*)(E + ((size_t)((sc * 16 + g) * 2 + dir) * 64 + n) * 2) = make_float2(hr, hi);
  __syncthreads();
}

__device__ __forceinline__ void s5_out_item(const P& p, int l, int item, char* smem) {
  float* us = (float*)smem;
  float* HB = (float*)(smem + 8192);
  const int sc = item >> 2, gq = item & 3;
  int sq, j, nsc, sc0, row0;
  s5_sc_info(sc, sq, j, nsc, sc0, row0);
  const bool lat = sq >= 16;
  s5_load_u(p, sc, gq, us);
  __syncthreads();
  const int tid = otid(), w = tid >> 6, lane = tid & 63;
  {
    const int n = lane;
    const int gi = w >> 1, dir = w & 1, g = gq * 4 + gi;
    float* hb = HB + (gi * 2 + dir) * 32 * 132;
    s5_bu_mfma(p, l, dir, g, us + gi * 32 * 16, hb, lane);
    __syncthreads();
    const f32x4* tab = (const f32x4*)(p.ws + OFF_S5TAB) + (size_t)(((l * 2 + dir) * 16 + g) * 64 + n) * 2;
    const f32x4 t0 = tab[0], t1 = tab[1];
    const float lr = t0[0], li = t0[1], pr = t1[0], pi = t1[1];
    float hr = 0.f, hi = 0.f;
    if (lat) {
      const int si = ((((sq - 16) * 2 + l) * 2 + dir) * 16 + g) * 64 + n;
      hr = p.in[I_SS5R][si];
      hi = p.in[I_SS5I][si];
    }
    const float* E = (const float*)(p.ws + OFF_S5E);
    const int nprev = dir == 0 ? j : nsc - 1 - j;
    for (int jj0 = 0; jj0 < nprev; jj0 += 8) {
      float2 ev[8];
#pragma unroll
      for (int u = 0; u < 8; ++u) {
        const int jj = jj0 + u < nprev ? jj0 + u : nprev - 1;
        const int scp = dir == 0 ? sc0 + jj : sc0 + nsc - 1 - jj;
        ev[u] = *(const float2*)(E + ((size_t)((scp * 16 + g) * 2 + dir) * 64 + n) * 2);
      }
#pragma unroll
      for (int u = 0; u < 8; ++u) {
        if (jj0 + u < nprev) {
          const float a = pr * hr - pi * hi + ev[u].x, b = pr * hi + pi * hr + ev[u].y;
          hr = a; hi = b;
        }
      }
    }
#pragma unroll 8
    for (int ii = 0; ii < 32; ++ii) {
      const int i = dir == 0 ? ii : 31 - ii;
      float2* cell = (float2*)(hb + i * 132 + n * 2);
      const float2 bu = *cell;
      const float a = lr * hr - li * hi + bu.x, b = lr * hi + li * hr + bu.y;
      hr = a; hi = b;
      *cell = make_float2(hr, hi);
    }
    if (!lat && ((dir == 0 && j == nsc - 1) || (dir == 1 && j == 0))) {
      const int oi = (((sq * 2 + l) * 2 + dir) * 16 + g) * 64 + n;
      p.out[OUT_S5RE + oi] = hr;
      p.out[OUT_S5IM + oi] = hi;
    }
  }
  __syncthreads();
  {
    const int quad = lane >> 4, l15 = lane & 15;
    const int gi = w >> 1, mt = w & 1, g = gq * 4 + gi;
    const float* Cr = p.in[I_CRE] + ((size_t)(l * 16 + g) * 16 + l15) * 64;
    const float* Ci = p.in[I_CIM] + ((size_t)(l * 16 + g) * 16 + l15) * 64;
    bf16x8 bfr[4];
#pragma unroll
    for (int k4 = 0; k4 < 4; ++k4) {
      f32x4 cr = *(const f32x4*)(Cr + k4 * 16 + quad * 4), ci = *(const f32x4*)(Ci + k4 * 16 + quad * 4);
      u32x4 pk = {pack2(cr[0], -ci[0]), pack2(cr[1], -ci[1]), pack2(cr[2], -ci[2]), pack2(cr[3], -ci[3])};
      bfr[k4] = __builtin_bit_cast(bf16x8, pk);
    }
    f32x4 acc = {0.f, 0.f, 0.f, 0.f};
#pragma unroll
    for (int ks = 0; ks < 8; ++ks) {
      const float* ha = HB + ((gi * 2 + (ks >> 2)) * 32 + mt * 16 + l15) * 132 + (ks & 3) * 32 + quad * 8;
      const f32x4 h0 = *(const f32x4*)ha, h1 = *(const f32x4*)(ha + 4);
      u32x4 pk = {pack2(h0[0], h0[1]), pack2(h0[2], h0[3]), pack2(h1[0], h1[1]), pack2(h1[2], h1[3])};
      acc = mfma16(__builtin_bit_cast(bf16x8, pk), bfr[ks & 3], acc);
    }
    const float dsk = p.in[I_S5D][l * 256 + g * 16 + l15];
    u16* Y1B = (u16*)(p.ws + OFF_Y1B);
#pragma unroll
    for (int r = 0; r < 4; ++r) {
      const int i = mt * 16 + quad * 4 + r;
      const float y = acc[r] + dsk * us[(gi * 32 + i) * 16 + l15];
      const int row = s5_row(lat, row0, j * 32 + i);
      Y1B[(size_t)row * 256 + g * 16 + l15] = f2bf(gelu_t(y));
    }
  }
  __syncthreads();
}

__device__ __forceinline__ void sgu_item(const P& p, int l, int item) {
  const int ck = item >> 2, hd = item & 3;
  const int tid = otid(), w = tid >> 6, lane = tid & 63, quad = lane >> 4, l15 = lane & 15;
  const u16* W = (const u16*)(p.ws + OFF_SGUW) + ((size_t)(l * 4 + hd) * 128 + w * 16 + l15) * 128;
  const u16* VT = (const u16*)(p.ws + OFF_VT) + ((size_t)ck * 256 + hd * 64 + l15) * 128;
  f32x4 acc[4];
#pragma unroll
  for (int d = 0; d < 4; ++d) acc[d] = (f32x4){0.f, 0.f, 0.f, 0.f};
#pragma unroll
  for (int ks = 0; ks < 4; ++ks) {
    const int k0 = ks * 32 + quad * 8;
    bf16x8 af = ld_frag(W + k0);
#pragma unroll
    for (int d = 0; d < 4; ++d) acc[d] = mfma16(af, ld_frag(VT + (size_t)d * 16 * 128 + k0), acc[d]);
  }
  const float* proj = (const float*)(p.ws + OFF_PROJ);
  u16* MIX = (u16*)(p.ws + OFF_MIXED);
#pragma unroll
  for (int r = 0; r < 4; ++r) {
    const int q = w * 16 + quad * 4 + r;
    const float b = p.in[I_SGUB][(l * 4 + hd) * 128 + q];
    const size_t row = (size_t)ck * 128 + q;
#pragma unroll
    for (int d = 0; d < 4; ++d) {
      const int col = hd * 64 + d * 16 + l15;
      const float u = gelu_t(proj[row * IN_DIM + 1552 + col]);
      MIX[row * 1024 + 512 + col] = f2bf(u * (acc[d][r] + b));
    }
  }
}

__device__ __forceinline__ void ssd_out_item(const P& p, int l, int item, char* smem) {
  float* red = (float*)smem;
  const int ck = item >> 2, qb2 = item & 3;
  const int tid = otid(), h = tid >> 6, lane = tid & 63, quad = lane >> 4, l15 = lane & 15;
  const int g = h >> 2, q0 = qb2 * 32;
  const size_t row0 = (size_t)ck * 128;
  const u16* BM = (const u16*)(p.ws + OFF_BM);
  const u16* CM = (const u16*)(p.ws + OFF_CM);
  const float* DTf = (const float*)(p.ws + OFF_DT) + (size_t)((ck * 2 + 0) * 8 + h) * 128;
  const float* DTb = (const float*)(p.ws + OFF_DT) + (size_t)((ck * 2 + 1) * 8 + h) * 128;
  const float* CF = (const float*)(p.ws + OFF_CUM) + (size_t)((ck * 2 + 0) * 8 + h) * 128;
  const float* CB = (const float*)(p.ws + OFF_CUM) + (size_t)((ck * 2 + 1) * 8 + h) * 128;
  bf16x8 cmf[2][4];
#pragma unroll
  for (int t = 0; t < 2; ++t)
#pragma unroll
    for (int ns = 0; ns < 4; ++ns) cmf[t][ns] = ld_frag(CM + (row0 + q0 + t * 16 + l15) * 256 + g * 128 + ns * 32 + quad * 8);
  float cfq[2], cbq[2], dsum[2];
#pragma unroll
  for (int t = 0; t < 2; ++t) {
    const int q = q0 + t * 16 + l15;
    cfq[t] = CF[q]; cbq[t] = CB[q]; dsum[t] = DTf[q] + DTb[q];
  }
  const float Dh = p.in[I_SSDD][l * 8 + h];
  u32x4 As[2][4];
#pragma unroll
  for (int kt = 0; kt < 8; ++kt) {
    f32x4 aT[2] = {{0.f, 0.f, 0.f, 0.f}, {0.f, 0.f, 0.f, 0.f}};
#pragma unroll
    for (int ns = 0; ns < 4; ++ns) {
      const bf16x8 bmf = ld_frag(BM + (row0 + kt * 16 + l15) * 256 + g * 128 + ns * 32 + quad * 8);
      aT[0] = mfma16(bmf, cmf[0][ns], aT[0]);
      aT[1] = mfma16(bmf, cmf[1][ns], aT[1]);
    }
    const int kb = kt * 16 + quad * 4;
    f32x4 c = {0.f, 0.f, 0.f, 0.f}, d = c, c2 = c, d2 = c;
    if (kt <= qb2 * 2 + 1) { c = *(const f32x4*)(CF + kb); d = *(const f32x4*)(DTf + kb); }
    if (kt >= qb2 * 2) { c2 = *(const f32x4*)(CB + kb); d2 = *(const f32x4*)(DTb + kb); }
#pragma unroll
    for (int t = 0; t < 2; ++t) {
      const int qt = qb2 * 2 + t;
      const int q = q0 + t * 16 + l15;
      float m[4];
      if (kt < qt) {
#pragma unroll
        for (int r = 0; r < 4; ++r) m[r] = aT[t][r] * __expf(cfq[t] - c[r]) * d[r];
      } else if (kt > qt) {
#pragma unroll
        for (int r = 0; r < 4; ++r) m[r] = aT[t][r] * __expf(cbq[t] - c2[r]) * d2[r];
      } else {
#pragma unroll
        for (int r = 0; r < 4; ++r) {
          const int k = kb + r;
          float f;
          if (k < q) f = __expf(cfq[t] - c[r]) * d[r];
          else if (k > q) f = __expf(cbq[t] - c2[r]) * d2[r];
          else f = dsum[t];
          m[r] = aT[t][r] * f + (k == q ? Dh : 0.f);
        }
      }
      As[t][kt >> 1][(kt & 1) * 2 + 0] = pack2(m[0], m[1]);
      As[t][kt >> 1][(kt & 1) * 2 + 1] = pack2(m[2], m[3]);
    }
    if (kt & 1) asm volatile("" ::: "memory");
  }
  const u16* XST = (const u16*)(p.ws + OFF_XST) + ((size_t)(ck * 8 + h) * 64 + l15) * 128;
  const u16* HPf = (const u16*)(p.ws + OFF_HPREV) + ((size_t)((ck * 2 + 0) * 8 + h) * 64 + l15) * 128;
  const u16* HPb = (const u16*)(p.ws + OFF_HPREV) + ((size_t)((ck * 2 + 1) * 8 + h) * 64 + l15) * 128;
  const float* proj = (const float*)(p.ws + OFF_PROJ);
  float* ybuf = (float*)(smem + 1024) + (h * 32 + quad * 4) * 65 + l15;
  float ss[2][4] = {{0.f, 0.f, 0.f, 0.f}, {0.f, 0.f, 0.f, 0.f}};
#pragma unroll 1
  for (int pt = 0; pt < 4; ++pt) {
    f32x4 aY[2] = {{0.f, 0.f, 0.f, 0.f}, {0.f, 0.f, 0.f, 0.f}};
    f32x4 aF[2] = {{0.f, 0.f, 0.f, 0.f}, {0.f, 0.f, 0.f, 0.f}};
    f32x4 aB[2] = {{0.f, 0.f, 0.f, 0.f}, {0.f, 0.f, 0.f, 0.f}};
#pragma unroll
    for (int s2 = 0; s2 < 4; ++s2) {
      u32x2 lo = *(const u32x2*)(XST + (size_t)pt * 16 * 128 + (2 * s2) * 16 + quad * 4);
      u32x2 hi = *(const u32x2*)(XST + (size_t)pt * 16 * 128 + (2 * s2 + 1) * 16 + quad * 4);
      const bf16x8 bv = __builtin_bit_cast(bf16x8, (u32x4){lo[0], lo[1], hi[0], hi[1]});
      aY[0] = mfma16(__builtin_bit_cast(bf16x8, As[0][s2]), bv, aY[0]);
      aY[1] = mfma16(__builtin_bit_cast(bf16x8, As[1][s2]), bv, aY[1]);
    }
#pragma unroll
    for (int ns = 0; ns < 4; ++ns) {
      const bf16x8 hf = ld_frag(HPf + (size_t)pt * 16 * 128 + ns * 32 + quad * 8);
      const bf16x8 hb = ld_frag(HPb + (size_t)pt * 16 * 128 + ns * 32 + quad * 8);
      aF[0] = mfma16(cmf[0][ns], hf, aF[0]);
      aF[1] = mfma16(cmf[1][ns], hf, aF[1]);
      aB[0] = mfma16(cmf[0][ns], hb, aB[0]);
      aB[1] = mfma16(cmf[1][ns], hb, aB[1]);
    }
#pragma unroll
    for (int t = 0; t < 2; ++t)
#pragma unroll
      for (int r = 0; r < 4; ++r) {
        const int qq = q0 + t * 16 + quad * 4 + r;
        float yv = aY[t][r] + __expf(CF[qq]) * aF[t][r] + __expf(CB[qq]) * aB[t][r];
        const float zv = proj[(row0 + qq) * IN_DIM + h * 64 + pt * 16 + l15];
        yv *= silu_f(zv);
        ybuf[(t * 16 + r) * 65 + pt * 16] = yv;
        ss[t][r] += yv * yv;
      }
  }
  const int lane2 = otid() & 63;
#pragma unroll
  for (int t = 0; t < 2; ++t)
#pragma unroll
    for (int r = 0; r < 4; ++r) {
      float sv = ss[t][r];
#pragma unroll
      for (int o = 1; o < 16; o <<= 1) sv += shx(sv, o, lane2);
      ss[t][r] = sv;
    }
  if (l15 == 0) {
#pragma unroll
    for (int t = 0; t < 2; ++t)
#pragma unroll
      for (int r = 0; r < 4; ++r) red[(t * 16 + quad * 4 + r) * 8 + h] = ss[t][r];
  }
  __syncthreads();
  u16* MIX = (u16*)(p.ws + OFF_MIXED);
  const float* ng = p.in[I_SSDNG] + l * 512 + h * 64;
#pragma unroll
  for (int t = 0; t < 2; ++t)
#pragma unroll
    for (int r = 0; r < 4; ++r) {
      const int qq = q0 + t * 16 + quad * 4 + r;
      float tot = 0.f;
#pragma unroll
      for (int hh = 0; hh < 8; ++hh) tot += red[(t * 16 + quad * 4 + r) * 8 + hh];
      const float rinv = rsqrtf(tot * (1.f / 512.f) + 1e-6f);
#pragma unroll
      for (int pt = 0; pt < 4; ++pt) {
        const int pc = pt * 16 + l15;
        MIX[(row0 + qq) * 1024 + h * 64 + pc] = f2bf(ybuf[(t * 16 + r) * 65 + pt * 16] * rinv * ng[pc]);
      }
    }
  __syncthreads();
}

#define XB_TMO      128
#define XB_XCNT(j)  (256  + 64 * (j))
#define XB_XSUB(j)  (1280 + 64 * (j))
#define XB_XGEN(j)  (2304 + 64 * (j))
#define XB_TOP      3328
#define XB_TOPGEN   3392
#define XCD_BAR_WORDS 3456
#define XB_SPIN_CAP (1u << 18)
#define LAS __attribute__((address_space(3)))
__device__ __forceinline__ unsigned xb_ld(unsigned* p) { return __hip_atomic_load(p, __ATOMIC_RELAXED, __HIP_MEMORY_SCOPE_AGENT); }
__device__ __forceinline__ unsigned xb_add(unsigned* p, unsigned v) { return __hip_atomic_fetch_add(p, v, __ATOMIC_RELAXED, __HIP_MEMORY_SCOPE_AGENT); }
__device__ __forceinline__ unsigned xb_xcc_id() { return (unsigned)__builtin_amdgcn_s_getreg((3 << 11) | 20) & 0xFu; }
#define XB_SPIN(cond, bar) do { unsigned _sp = 0; while (cond) { __builtin_amdgcn_s_sleep(1); \
    if ((++_sp & 255u) == 0u) { if (xb_ld(&(bar)[XB_TMO])) break; if (_sp > XB_SPIN_CAP) { atomicAdd(&(bar)[XB_TMO], 1u); break; } } } } while (0)
struct XcdBarrier { unsigned* bar; unsigned x; volatile LAS unsigned* st; };
__device__ __forceinline__ XcdBarrier xcd_barrier_post(unsigned* bar, volatile LAS unsigned* st) {
  XcdBarrier b; b.bar = bar; b.x = xb_xcc_id(); b.st = st;
  if (threadIdx.x == 0) (void)xb_add(&bar[XB_XCNT(b.x)], 1u);
  return b;
}
__device__ __forceinline__ void xcd_barrier_complete(unsigned* bar, unsigned x, unsigned& nloc, unsigned& nx) {
  const unsigned G = gridDim.x * gridDim.y * gridDim.z;
  unsigned sum, cnt, mine, sp = 0u;
  for (;;) {
    sum = 0u; cnt = 0u; mine = 0u;
#pragma unroll
    for (unsigned j = 0; j < 16; ++j) { const unsigned c = xb_ld(&bar[XB_XCNT(j)]); sum += c; cnt += (c > 0u) ? 1u : 0u; mine = (j == x) ? c : mine; }
    if (sum == G) break;
    __builtin_amdgcn_s_sleep(1);
    if ((++sp & 255u) == 0u) { if (xb_ld(&bar[XB_TMO])) break; if (sp > XB_SPIN_CAP) { atomicAdd(&bar[XB_TMO], 1u); break; } }
  }
  nloc = mine > 0u ? mine : 1u; nx = cnt > 0u ? cnt : 1u;
}
__device__ __forceinline__ void xcd_barrier(const XcdBarrier& b) {
  asm volatile("s_waitcnt vmcnt(0)" ::: "memory");
  __syncthreads();
  if (threadIdx.x == 0) {
    unsigned* bar = b.bar;
    __builtin_amdgcn_s_waitcnt(0);
    unsigned nloc = b.st[0], nx = b.st[1];
    if (nloc == 0u) { xcd_barrier_complete(bar, b.x, nloc, nx); b.st[0] = nloc; b.st[1] = nx; }
    const unsigned old = xb_add(&bar[XB_XSUB(b.x)], 1u);
    const unsigned gen = old / nloc;
    if (old + 1u == (gen + 1u) * nloc) {
      __builtin_amdgcn_fence(__ATOMIC_RELEASE, "agent");
      asm volatile("s_waitcnt vmcnt(0)" ::: "memory");
      const unsigned og = xb_add(&bar[XB_TOP], 1u);
      const unsigned tg = og / nx;
      if (og + 1u == (tg + 1u) * nx) xb_add(&bar[XB_TOPGEN], 1u);
      else XB_SPIN(xb_ld(&bar[XB_TOPGEN]) == tg, bar);
      __builtin_amdgcn_fence(__ATOMIC_ACQUIRE, "agent");
      xb_add(&bar[XB_XGEN(b.x)], 1u);
      asm volatile("s_waitcnt vmcnt(0)" ::: "memory");
    } else {
      XB_SPIN(xb_ld(&bar[XB_XGEN(b.x)]) == gen, bar);
      __builtin_amdgcn_fence(__ATOMIC_ACQUIRE, "agent");
      asm volatile("s_waitcnt vmcnt(0)" ::: "memory");
    }
  }
  __syncthreads();
}

__device__ __forceinline__ int next_item(unsigned* ctr, int* slot) {
  __syncthreads();
  if (threadIdx.x == 0) *slot = (int)xb_add(ctr, 1u);
  __syncthreads();
  return *slot;
}

__device__ __forceinline__ void run_phase(const P& p, int ph, int rep, char* smem, int* qslot) {
  const int nb = gridDim.x, bid = obid();
  unsigned* qctr = (unsigned*)(p.ws + OFF_BAR) + 3520 + 16 * (ph * 2 + rep);
  if (ph == 0) {
    for (int it = bid; it < 192 + 16 + 1; it += nb) {
      if (it < 192) mod_item(p, it, smem);
      else if (it < 208) p0_sgu_item(p, it - 192);
      else s5_table_item(p);
    }
    p0_transposes(p, smem);
    return;
  }
  if (ph == 21) {
    norm_phase(p, 0, 2, (const float*)(p.ws + OFF_XB), (const float*)(p.ws + OFF_XB) + (size_t)4096 * 1024);
    return;
  }
  const int l = (ph - 1) / 10, sp = (ph - 1) % 10;
  const float* x0a = l == 0 ? p.in[I_XP] : (const float*)(p.ws + OFF_XB);
  const float* x0b = l == 0 ? p.in[I_XS] : (const float*)(p.ws + OFF_XB) + (size_t)4096 * 1024;
  const float* x1a = (const float*)(p.ws + OFF_XA);
  const float* x1b = x1a + (size_t)4096 * 1024;
  const float* mod = (const float*)(p.ws + OFF_MOD) + (size_t)l * 3 * 6144;
  Epi e{};
  switch (sp) {
    case 0: norm_phase(p, l, 0, x0a, x0b); break;
    case 1:
      e.outf = (float*)(p.ws + OFF_PROJ);
      gemm_phase<0, 1024>((const u16*)(p.ws + OFF_H), (const u16*)(p.ws + OFF_WIN_T) + (size_t)l * IN_PAD * 1024, 19, e, smem, bid, nb);
      break;
    case 2: {
      constexpr int NB = 768 * ((DUP & 16) ? 2 : 1);
      for (int it = next_item(qctr, qslot); it < 864 + NB; it = next_item(qctr, qslot)) {
        if (it < 48) prep_v(p, l, it, smem);
        else if (it < 48 + NB) s5_local_item(p, l, (it - 48) % 768, smem);
        else if (it < 48 + NB + 768) { int k = it - 48 - NB; prep_conv(p, l, k >> 4, k & 15, smem); }
        else prep_dt(p, l, it - 816 - NB, smem);
      }
    } break;
    case 3: {
      constexpr int NA = 384 * ((DUP & 8) ? 2 : 1), NB = 768 * ((DUP & 2) ? 2 : 1), NC = 192 * ((DUP & 4) ? 2 : 1);
      for (int it = next_item(qctr, qslot); it < NA + NB + NC; it = next_item(qctr, qslot)) {
        if (it < NA) ssd_state_item(p, l, it % 384);
        else if (it < NA + NB) s5_out_item(p, l, (it - NA) % 768, smem);
        else sgu_item(p, l, (it - NA - NB) % 192);
      }
    } break;
    case 4: {
      constexpr int NA = 192 * ((DUP & 1) ? 2 : 1);
      Epi ge{};
      ge.outb = (u16*)(p.ws + OFF_MIXED);
      ge.y1 = (const u16*)(p.ws + OFF_Y1B);
      ge.bias = p.in[I_GLUB] + l * 256;
      {
        const int g0 = nb > 64 ? nb - 64 : 0;
        if (bid >= g0) gemm_phase<3, 256>((const u16*)(p.ws + OFF_Y1B), (const u16*)(p.ws + OFF_GLU_T) + (size_t)l * 256 * 256, 2, ge, smem, bid - g0, nb - g0);
      }
      for (int it = next_item(qctr, qslot); it < NA; it = next_item(qctr, qslot)) ssd_out_item(p, l, it % 192, smem);
    } break;
    case 5: break;
    case 6:
      e.outf = (float*)(p.ws + OFF_XA);
      e.xa = x0a; e.xb = x0b; e.gate = mod + 2048;
      gemm_phase<1, 1024>((const u16*)(p.ws + OFF_MIXED), (const u16*)(p.ws + OFF_WOUT_T) + (size_t)l * 1024 * 1024, 8, e, smem, bid, nb);
      break;
    case 7: norm_phase(p, l, 1, x1a, x1b); break;
    case 8:
      e.outb = (u16*)(p.ws + OFF_PROJ);
      gemm_phase<2, 1024>((const u16*)(p.ws + OFF_H), (const u16*)(p.ws + OFF_W1_T) + (size_t)l * 4096 * 1024, 32, e, smem, bid, nb);
      break;
    case 9:
      e.outf = (float*)(p.ws + OFF_XB);
      e.xa = x1a; e.xb = x1b; e.gate = mod + 5120;
      gemm_phase<1, 4096>((const u16*)(p.ws + OFF_PROJ), (const u16*)(p.ws + OFF_W2_T) + (size_t)l * 1024 * 4096, 8, e, smem, bid, nb);
      break;
  }
}

#ifndef REP_MASK
#define REP_MASK 0
#endif
__device__ __forceinline__ int phase_type(int ph) { return ph == 0 ? 10 : ph == 21 ? 11 : (ph - 1) % 10; }

__global__ void __launch_bounds__(512) mega(P p, int ph_lo, int ph_hi, int coop) {
  __shared__ __attribute__((aligned(16))) char smem[SMEM_BYTES];
  __shared__ __attribute__((aligned(16))) unsigned xb_words[4];
  XcdBarrier xb;
  if (coop) {
    if (threadIdx.x < 4) xb_words[threadIdx.x] = 0u;
    __syncthreads();
    xb = xcd_barrier_post((unsigned*)(p.ws + OFF_BAR), (volatile LAS unsigned*)xb_words);
  }
  for (int ph = ph_lo; ph < ph_hi; ++ph) {
    if (phase_type(ph) == 5) continue;
    const int reps = ((REP_MASK >> phase_type(ph)) & 1) ? 2 : 1;
    for (int r = 0; r < reps; ++r) run_phase(p, ph, r, smem, (int*)&xb_words[2]);
    if (coop == 1 && ph + 1 < ph_hi) xcd_barrier(xb);
    if (coop == 2) cg::this_grid().sync();
  }
}

extern "C" void kernel_launch(void* const* d_in, const int* in_sizes, int n_in, void* d_out, int out_size, void* d_ws,
                              size_t ws_size, hipStream_t stream) {
  static int grid_blocks = 0;
  if (!grid_blocks) {
    int dev = 0, cus = 0, per_cu = 0;
    hipGetDevice(&dev);
    hipDeviceGetAttribute(&cus, hipDeviceAttributeMultiprocessorCount, dev);
    hipOccupancyMaxActiveBlocksPerMultiprocessor(&per_cu, mega, 512, 0);
    if (per_cu < 1) per_cu = 1;
    grid_blocks = cus * per_cu;
  }
  P p{};
  for (int i = 0; i < 35; ++i) p.in[i] = (const float*)d_in[i];
  p.out = (float*)d_out;
  p.ws = (char*)d_ws;
  if (ws_size < WS_TOTAL) { fprintf(stderr, "workspace too small: %zu < %zu\n", ws_size, (size_t)WS_TOTAL); return; }
#if COOP
  hipMemsetAsync((char*)d_ws + OFF_BAR, 0, 65536, stream);
  int lo = 0, hi = 22, coop = 1;
  void* args[] = {&p, &lo, &hi, &coop};
  hipError_t err = hipLaunchCooperativeKernel((void*)mega, dim3(grid_blocks), dim3(512), args, 0, stream);
  if (err != hipSuccess) fprintf(stderr, "cooperative launch failed: %s (grid %d)\n", hipGetErrorString(err), grid_blocks);
#else
  for (int ph = 0; ph < 22; ++ph) mega<<<dim3(grid_blocks), dim3(512), 0, stream>>>(p, ph, ph + 1, 0);
#endif
}
```

```cpp
#include <hip/hip_runtime.h>
#include <hip/hip_cooperative_groups.h>
#include <cstdio>
namespace cg = cooperative_groups;

#define DUP 0
#ifndef COOP
#define COOP 1
#endif

typedef unsigned short u16;
typedef __attribute__((ext_vector_type(8))) short bf16x8;
typedef __attribute__((ext_vector_type(4))) float f32x4;
typedef __attribute__((ext_vector_type(4))) unsigned int u32x4;
typedef __attribute__((ext_vector_type(2))) unsigned int u32x2;

constexpr int T_TOK = 6144;
constexpr int DM = 1024;
constexpr int IN_DIM = 2320;
constexpr int IN_PAD = 2432;
constexpr int DFF = 4096;
constexpr int SMEM_BYTES = 143360;

constexpr size_t OFF_WIN_T = 0;
constexpr size_t OFF_WOUT_T = OFF_WIN_T + (size_t)2 * IN_PAD * 1024 * 2;
constexpr size_t OFF_W1_T = OFF_WOUT_T + (size_t)2 * 1024 * 1024 * 2;
constexpr size_t OFF_W2_T = OFF_W1_T + (size_t)2 * 4096 * 1024 * 2;
constexpr size_t OFF_GLU_T = OFF_W2_T + (size_t)2 * 4096 * 1024 * 2;
constexpr size_t OFF_SGUW = OFF_GLU_T + (size_t)2 * 256 * 256 * 2;
constexpr size_t OFF_MOD = OFF_SGUW + (size_t)2 * 4 * 128 * 128 * 2;
constexpr size_t OFF_H = OFF_MOD + (size_t)2 * 3 * 6144 * 4;
constexpr size_t OFF_PROJ = OFF_H + (size_t)T_TOK * 1024 * 2;
constexpr size_t OFF_MIXED = OFF_PROJ + (size_t)T_TOK * IN_DIM * 4;
constexpr size_t OFF_XA = OFF_MIXED + (size_t)T_TOK * 1024 * 2;
constexpr size_t OFF_XB = OFF_XA + (size_t)T_TOK * 1024 * 4;
constexpr size_t OFF_HPREV = OFF_XB + (size_t)T_TOK * 1024 * 4;
constexpr size_t OFF_BM = OFF_HPREV + (size_t)48 * 2 * 8 * 64 * 128 * 2;
constexpr size_t OFF_CM = OFF_BM + (size_t)T_TOK * 256 * 2;
constexpr size_t OFF_BMT = OFF_CM + (size_t)T_TOK * 256 * 2;
constexpr size_t OFF_XST = OFF_BMT + (size_t)48 * 2 * 128 * 128 * 2;
constexpr size_t OFF_VT = OFF_XST + (size_t)48 * 8 * 64 * 128 * 2;
constexpr size_t OFF_DT = OFF_VT + (size_t)48 * 256 * 128 * 2;
constexpr size_t OFF_CUM = OFF_DT + (size_t)48 * 2 * 8 * 128 * 4;
constexpr size_t OFF_WDEC = OFF_CUM + (size_t)48 * 2 * 8 * 128 * 4;
constexpr size_t OFF_S5E = OFF_WDEC + (size_t)48 * 2 * 8 * 128 * 4;
constexpr size_t OFF_Y1B = OFF_S5E + (size_t)192 * 16 * 2 * 64 * 8;
constexpr size_t OFF_S5TAB = OFF_Y1B + (size_t)T_TOK * 256 * 2;
constexpr size_t OFF_S5BB = OFF_S5TAB + (size_t)4096 * 32;
constexpr size_t OFF_BAR = OFF_S5BB + (size_t)64 * 128 * 16 * 2;
constexpr size_t WS_TOTAL = OFF_BAR + 65536;

constexpr size_t OUT_SSD = (size_t)T_TOK * 1024;
constexpr size_t OUT_S5RE = OUT_SSD + (size_t)16 * 2 * 2 * 8 * 64 * 128;
constexpr size_t OUT_S5IM = OUT_S5RE + (size_t)16 * 2 * 2 * 16 * 64;

struct P {
  const float* in[35];
  float* out;
  char* ws;
};

enum { I_XP = 0, I_XS, I_SSSD, I_SS5R, I_SS5I, I_C, I_CCTX, I_ADAW, I_ADAB, I_N1G, I_N2G, I_WIN, I_CONVW, I_CONVB,
       I_DTB, I_ALOG, I_SSDD, I_SSDNG, I_SGUNG, I_SGUW, I_SGUB, I_LRE, I_LIM, I_LOGDT, I_BRE, I_BIM, I_CRE, I_CIM,
       I_S5D, I_GLUW, I_GLUB, I_WOUT, I_W1, I_W2, I_FNG };

__device__ __forceinline__ int otid() { int t = threadIdx.x; asm volatile("" : "+v"(t)); return t; }
__device__ __forceinline__ int obid() { int t = blockIdx.x; asm volatile("" : "+s"(t)); return t; }
__device__ __forceinline__ u16 f2bf(float f) {
  unsigned u = __float_as_uint(f);
  u += 0x7fffu + ((u >> 16) & 1u);
  return (u16)(u >> 16);
}
__device__ __forceinline__ float bf2f(u16 h) { return __uint_as_float(((unsigned)h) << 16); }
__device__ __forceinline__ unsigned pack2(float a, float b) { return (unsigned)f2bf(a) | ((unsigned)f2bf(b) << 16); }

__device__ __forceinline__ float gelu_t(float x) {
  float y = 0.7978845608028654f * (x + 0.044715f * x * x * x);
  float t = __expf(2.f * y);
  float th = 1.f - 2.f / (t + 1.f);
  return 0.5f * x * (1.f + th);
}
__device__ __forceinline__ float sigmoid_f(float x) { return 1.f / (1.f + __expf(-x)); }
__device__ __forceinline__ float silu_f(float x) { return x / (1.f + __expf(-x)); }
__device__ __forceinline__ float softplus_f(float x) { return x > 20.f ? x : log1pf(expf(x)); }

__device__ __forceinline__ f32x4 mfma16(bf16x8 a, bf16x8 b, f32x4 c) {
  return __builtin_amdgcn_mfma_f32_16x16x32_bf16(a, b, c, 0, 0, 0);
}
__device__ __forceinline__ bf16x8 ld_frag(const u16* ptr) {
  return __builtin_bit_cast(bf16x8, *(const u32x4*)ptr);
}

__device__ __forceinline__ void mod_item(const P& p, int it, char* smem) {
  float* sc = (float*)smem;
  float* red = sc + 3072;
  const int tid = otid();
  const int l = it / 96, jb = it % 96;
  const int j0 = jb * 64;
  const int jq = tid & 15, kg = tid >> 4;
  for (int i = tid; i < 3072; i += 512) {
    const int m = i >> 10, k = i & 1023;
    sc[i] = silu_f(m == 0 ? p.in[I_CCTX][k] : p.in[I_C][(m - 1) * 1024 + k]);
  }
  __syncthreads();
  const float* aw = p.in[I_ADAW] + (size_t)l * 1024 * 6144 + (size_t)(kg * 32) * 6144 + j0 + jq * 4;
  float acc[3][4];
#pragma unroll
  for (int m = 0; m < 3; ++m)
#pragma unroll
    for (int j = 0; j < 4; ++j) acc[m][j] = 0.f;
#pragma unroll 1
  for (int k8 = 0; k8 < 4; ++k8) {
    f32x4 wv[8];
#pragma unroll
    for (int u = 0; u < 8; ++u) wv[u] = *(const f32x4*)(aw + (size_t)(k8 * 8 + u) * 6144);
#pragma unroll
    for (int u = 0; u < 8; ++u) {
      const int k = kg * 32 + k8 * 8 + u;
      const float c0 = sc[k], c1 = sc[1024 + k], c2 = sc[2048 + k];
#pragma unroll
      for (int j = 0; j < 4; ++j) {
        acc[0][j] += c0 * wv[u][j];
        acc[1][j] += c1 * wv[u][j];
        acc[2][j] += c2 * wv[u][j];
      }
    }
  }
#pragma unroll
  for (int m = 0; m < 3; ++m)
#pragma unroll
    for (int j = 0; j < 4; ++j) red[(kg * 3 + m) * 64 + jq * 4 + j] = acc[m][j];
  __syncthreads();
  if (tid < 192) {
    const int m = tid >> 6, j = tid & 63;
    float sv = p.in[I_ADAB][l * 6144 + j0 + j];
    for (int gq = 0; gq < 32; ++gq) sv += red[(gq * 3 + m) * 64 + j];
    float* mod = (float*)(p.ws + OFF_MOD);
    mod[(l * 3 + m) * 6144 + j0 + j] = sv;
  }
  __syncthreads();
}

__device__ __forceinline__ void transpose_tile(const float* src, int K, int N, u16* dst, int k0, int n0, char* smem) {
  float* tile = (float*)smem;
  const int tid = otid();
#pragma unroll
  for (int i = 0; i < 4; ++i) {
    int k = (tid >> 4) + 32 * i, n4 = tid & 15;
    int n = n0 + n4 * 4;
    f32x4 v = {0.f, 0.f, 0.f, 0.f};
    if (n < N) v = *(const f32x4*)(src + (size_t)(k0 + k) * N + n);
    float* d = tile + k * 65 + n4 * 4;
    d[0] = v[0]; d[1] = v[1]; d[2] = v[2]; d[3] = v[3];
  }
  __syncthreads();
#pragma unroll
  for (int i = 0; i < 2; ++i) {
    int slot = tid + i * 512;
    int n = slot >> 4, kg = slot & 15;
    u32x4 o;
#pragma unroll
    for (int j = 0; j < 4; ++j)
      o[j] = pack2(tile[(kg * 8 + 2 * j) * 65 + n], tile[(kg * 8 + 2 * j + 1) * 65 + n]);
    *(u32x4*)(dst + (size_t)(n0 + n) * K + k0 + kg * 8) = o;
  }
  __syncthreads();
}

struct TrDesc { const float* src; u16* dst; int K, N, k0, n0; };
__device__ __forceinline__ TrDesc tr_decode(const P& p, int it) {
  TrDesc d;
  int l = it / 1464, r = it % 1464, nt;
  if (r < 304) { d.src = p.in[I_WIN] + (size_t)l * 1024 * IN_DIM; d.dst = (u16*)(p.ws + OFF_WIN_T) + (size_t)l * IN_PAD * 1024; d.K = 1024; d.N = IN_DIM; nt = 38; }
  else if (r < 432) { r -= 304; d.src = p.in[I_WOUT] + (size_t)l * 1024 * 1024; d.dst = (u16*)(p.ws + OFF_WOUT_T) + (size_t)l * 1024 * 1024; d.K = 1024; d.N = 1024; nt = 16; }
  else if (r < 944) { r -= 432; d.src = p.in[I_W1] + (size_t)l * 1024 * 4096; d.dst = (u16*)(p.ws + OFF_W1_T) + (size_t)l * 4096 * 1024; d.K = 1024; d.N = 4096; nt = 64; }
  else if (r < 1456) { r -= 944; d.src = p.in[I_W2] + (size_t)l * 4096 * 1024; d.dst = (u16*)(p.ws + OFF_W2_T) + (size_t)l * 1024 * 4096; d.K = 4096; d.N = 1024; nt = 16; }
  else { r -= 1456; d.src = p.in[I_GLUW] + (size_t)l * 256 * 256; d.dst = (u16*)(p.ws + OFF_GLU_T) + (size_t)l * 256 * 256; d.K = 256; d.N = 256; nt = 4; }
  d.k0 = (r / nt) * 128; d.n0 = (r % nt) * 64;
  return d;
}
__device__ __forceinline__ void tr_load(const TrDesc& d, int tid, f32x4 (&v)[4]) {
#pragma unroll
  for (int i = 0; i < 4; ++i) {
    const int k = (tid >> 4) + 32 * i, n = d.n0 + (tid & 15) * 4;
    v[i] = (f32x4){0.f, 0.f, 0.f, 0.f};
    if (n < d.N) v[i] = *(const f32x4*)(d.src + (size_t)(d.k0 + k) * d.N + n);
  }
}
__device__ __forceinline__ void p0_transposes(const P& p, char* smem) {
  float* tile = (float*)smem;
  const int tid = otid(), nb = gridDim.x;
  int cur = obid();
  if (cur >= 2928) return;
  f32x4 v[4];
  TrDesc d = tr_decode(p, cur);
  tr_load(d, tid, v);
  while (cur < 2928) {
    __syncthreads();
#pragma unroll
    for (int i = 0; i < 4; ++i) {
      float* q = tile + ((tid >> 4) + 32 * i) * 65 + (tid & 15) * 4;
      q[0] = v[i][0]; q[1] = v[i][1]; q[2] = v[i][2]; q[3] = v[i][3];
    }
    __syncthreads();
    const int nxt = cur + nb;
    TrDesc dn = d;
    if (nxt < 2928) { dn = tr_decode(p, nxt); tr_load(dn, tid, v); }
#pragma unroll
    for (int i = 0; i < 2; ++i) {
      const int slot = tid + i * 512;
      const int n = slot >> 4, kg = slot & 15;
      u32x4 o;
#pragma unroll
      for (int j = 0; j < 4; ++j) o[j] = pack2(tile[(kg * 8 + 2 * j) * 65 + n], tile[(kg * 8 + 2 * j + 1) * 65 + n]);
      *(u32x4*)(d.dst + (size_t)(d.n0 + n) * d.K + d.k0 + kg * 8) = o;
    }
    d = dn; cur = nxt;
  }
  __syncthreads();
}
__device__ __forceinline__ void p0_sgu_item(const P& p, int it) {
  const float* src = p.in[I_SGUW] + (size_t)it * 8192;
  u16* dst = (u16*)(p.ws + OFF_SGUW) + (size_t)it * 8192;
  const int tid = otid();
#pragma unroll
  for (int i = 0; i < 2; ++i) {
    int e = (tid + i * 512) * 8;
    f32x4 a = *(const f32x4*)(src + e), b = *(const f32x4*)(src + e + 4);
    u32x4 o = {pack2(a[0], a[1]), pack2(a[2], a[3]), pack2(b[0], b[1]), pack2(b[2], b[3])};
    *(u32x4*)(dst + e) = o;
  }
}

__device__ __forceinline__ float shx(float v, int o, int lane) {
  return __int_as_float(__builtin_amdgcn_ds_bpermute((lane ^ o) << 2, __float_as_int(v)));
}
__device__ __forceinline__ float wave_sum(float v, int lane) {
#pragma unroll
  for (int o = 32; o > 0; o >>= 1) v += shx(v, o, lane);
  return v;
}

__device__ __forceinline__ void norm_phase(const P& p, int l, int mode, const float* xa, const float* xb) {
  const int tid = otid(), w = tid >> 6, lane = tid & 63;
  const float* mod = (const float*)(p.ws + OFF_MOD);
  u16* H = (u16*)(p.ws + OFF_H);
  const float* g = mode == 0 ? p.in[I_N1G] + l * 1024 : mode == 1 ? p.in[I_N2G] + l * 1024 : p.in[I_FNG];
  for (int row = obid() * 8 + w; row < T_TOK; row += gridDim.x * 8) {
    const float* x = row < 4096 ? xa + (size_t)row * 1024 : xb + (size_t)(row - 4096) * 1024;
    f32x4 v[4];
    float ss = 0.f;
#pragma unroll
    for (int i = 0; i < 4; ++i) {
      v[i] = *(const f32x4*)(x + i * 256 + lane * 4);
#pragma unroll
      for (int j = 0; j < 4; ++j) ss += v[i][j] * v[i][j];
    }
    ss = wave_sum(ss, lane);
    float rinv = rsqrtf(ss * (1.f / 1024.f) + 1e-6f);
    int m = row < 4096 ? 0 : 1 + ((row - 4096) >> 10);
    const float* mb = mod + (size_t)(l * 3 + m) * 6144 + (mode == 1 ? 3072 : 0);
#pragma unroll
    for (int i = 0; i < 4; ++i) {
      int c = i * 256 + lane * 4;
      f32x4 gg = *(const f32x4*)(g + c);
      if (mode == 2) {
        f32x4 o;
#pragma unroll
        for (int j = 0; j < 4; ++j) o[j] = v[i][j] * rinv * gg[j];
        *(f32x4*)(p.out + (size_t)row * 1024 + c) = o;
      } else {
        f32x4 sh = *(const f32x4*)(mb + c);
        f32x4 sc = *(const f32x4*)(mb + 1024 + c);
        float o[4];
#pragma unroll
        for (int j = 0; j < 4; ++j) o[j] = v[i][j] * rinv * gg[j] * (1.f + sc[j]) + sh[j];
        u32x2 pk = {pack2(o[0], o[1]), pack2(o[2], o[3])};
        *(u32x2*)(H + (size_t)row * 1024 + c) = pk;
      }
    }
  }
}

struct Epi {
  float* outf;
  u16* outb;
  const float* xa;
  const float* xb;
  const float* gate;
  const u16* y1;
  const float* bias;
};

template <int EPI, int K>
__device__ __forceinline__ void gemm_phase(const u16* A, const u16* Bt, int ntn, const Epi& e, char* smem, int bid, int nb) {
  constexpr int LS = 72;
  constexpr int nk = K >> 6;
  u16* sA = (u16*)smem;
  u16* sB = sA + 2 * 192 * LS;
  const int tid = otid(), w = tid >> 6, lane = tid & 63, quad = lane >> 4, l15 = lane & 15;
  const int wm = w >> 1, wn = w & 1;
  const int lrow = tid >> 3, lkc = tid & 7;
  const int ntiles = 32 * ntn;
  if (bid >= ntiles) return;
  const int total = ((ntiles - bid + nb - 1) / nb) * nk;
  u32x4 ra0[3], rb0[2], ra1[3], rb1[2];
  f32x4 acc[3][4];
#pragma unroll
  for (int i = 0; i < 3; ++i)
#pragma unroll
    for (int j = 0; j < 4; ++j) acc[i][j] = (f32x4){0.f, 0.f, 0.f, 0.f};
  auto issue = [&](u32x4 (&ra)[3], u32x4 (&rb)[2], int pos) {
    const int t = bid + (pos / nk) * nb, ks = pos % nk;
    const u16* ap = A + (size_t)((t & 31) * 192 + lrow) * K + lkc * 8 + ks * 64;
    const u16* bp = Bt + (size_t)((t >> 5) * 128 + lrow) * K + lkc * 8 + ks * 64;
#pragma unroll
    for (int i = 0; i < 3; ++i) ra[i] = *(const u32x4*)(ap + (size_t)i * 64 * K);
#pragma unroll
    for (int i = 0; i < 2; ++i) rb[i] = *(const u32x4*)(bp + (size_t)i * 64 * K);
  };
  auto stash = [&](u32x4 (&ra)[3], u32x4 (&rb)[2], int buf) {
#pragma unroll
    for (int i = 0; i < 3; ++i) *(u32x4*)(sA + buf * 192 * LS + (lrow + i * 64) * LS + lkc * 8) = ra[i];
#pragma unroll
    for (int i = 0; i < 2; ++i) *(u32x4*)(sB + buf * 128 * LS + (lrow + i * 64) * LS + lkc * 8) = rb[i];
  };
  auto body = [&](u32x4 (&ra)[3], u32x4 (&rb)[2], int pos) {
    if (pos + 1 < total) stash(ra, rb, (pos + 1) & 1);
    if (pos + 3 < total) issue(ra, rb, pos + 3);
    const int buf = pos & 1;
    const u16* cA = sA + buf * 192 * LS + (wm * 48 + l15) * LS + quad * 8;
    const u16* cB = sB + buf * 128 * LS + (wn * 64 + l15) * LS + quad * 8;
    {
      bf16x8 af[2][3], bq[2][4];
#pragma unroll
      for (int kk = 0; kk < 2; ++kk) {
#pragma unroll
        for (int i = 0; i < 3; ++i) af[kk][i] = ld_frag(cA + i * 16 * LS + kk * 32);
#pragma unroll
        for (int j = 0; j < 4; ++j) bq[kk][j] = ld_frag(cB + j * 16 * LS + kk * 32);
      }
      __builtin_amdgcn_s_setprio(1);
#pragma unroll
      for (int kk = 0; kk < 2; ++kk)
#pragma unroll
        for (int j = 0; j < 4; ++j)
#pragma unroll
          for (int i = 0; i < 3; ++i) acc[i][j] = mfma16(af[kk][i], bq[kk][j], acc[i][j]);
      __builtin_amdgcn_s_setprio(0);
    }
    if ((pos % nk) == nk - 1) {
      const int t = bid + (pos / nk) * nb;
      const int m0 = (t & 31) * 192, n0 = (t >> 5) * 128;
#pragma unroll
      for (int i = 0; i < 3; ++i)
#pragma unroll
        for (int j = 0; j < 4; ++j) {
#pragma unroll
          for (int r = 0; r < 4; ++r) {
            const int row = m0 + wm * 48 + i * 16 + quad * 4 + r;
            const int col = n0 + wn * 64 + j * 16 + l15;
            const float a = acc[i][j][r];
            if (EPI == 0) {
              if (col < IN_DIM) e.outf[(size_t)row * IN_DIM + col] = a;
            } else if (EPI == 1) {
              const float x = row < 4096 ? e.xa[(size_t)row * 1024 + col] : e.xb[(size_t)(row - 4096) * 1024 + col];
              const int m = row < 4096 ? 0 : 1 + ((row - 4096) >> 10);
              e.outf[(size_t)row * 1024 + col] = x + e.gate[m * 6144 + col] * a;
            } else if (EPI == 2) {
              const float rl = a > 0.f ? a : 0.f;
              e.outb[(size_t)row * DFF + col] = f2bf(rl * rl);
            } else {
              const float g = sigmoid_f(a + e.bias[col]);
              const float y = bf2f(e.y1[(size_t)row * 256 + col]);
              e.outb[(size_t)row * 1024 + 768 + col] = f2bf(y * g);
            }
          }
          acc[i][j] = (f32x4){0.f, 0.f, 0.f, 0.f};
        }
    }
    __syncthreads();
  };
  issue(ra0, rb0, 0);
  if (1 < total) issue(ra1, rb1, 1);
  stash(ra0, rb0, 0);
  if (2 < total) issue(ra0, rb0, 2);
  __syncthreads();
  for (int pos = 0; pos < total; pos += 2) {
    body(ra1, rb1, pos);
    if (pos + 1 < total) body(ra0, rb0, pos + 1);
  }
}

__device__ __forceinline__ void prep_conv(const P& p, int l, int ck, int s, char* smem) {
  float* tile = (float*)smem;
  const int tid = otid();
  const int row0 = ck * 128;
  int seq_lo, seq_hi;
  if (ck < 32) { seq_lo = (ck >> 1) * 256; seq_hi = seq_lo + 256; }
  else { seq_lo = 4096 + ((ck - 32) >> 3) * 1024; seq_hi = seq_lo + 1024; }
  const float* proj = (const float*)(p.ws + OFF_PROJ);
  const int c0 = s * 64;
  for (int id = tid; id < 132 * 16; id += 512) {
    int r = id >> 4, c4 = id & 15;
    int row = row0 - 2 + r;
    f32x4 v = {0.f, 0.f, 0.f, 0.f};
    if (row >= seq_lo && row < seq_hi) v = *(const f32x4*)(proj + (size_t)row * IN_DIM + 512 + c0 + c4 * 4);
    float* d = tile + r * 65 + c4 * 4;
    d[0] = v[0]; d[1] = v[1]; d[2] = v[2]; d[3] = v[3];
  }
  __syncthreads();
  const float* cw = p.in[I_CONVW] + (size_t)l * 5 * 1024;
  const float* cb = p.in[I_CONVB] + (size_t)l * 1024;
  if (s < 12) {
    u16* dstbase;
    if (s < 8) dstbase = (u16*)(p.ws + OFF_XST) + (size_t)(ck * 8 + s) * 64 * 128;
    else dstbase = (u16*)(p.ws + OFF_BMT) + ((size_t)(ck * 2 + ((s - 8) >> 1)) * 128 + ((s - 8) & 1) * 64) * 128;
#pragma unroll
    for (int it = 0; it < 2; ++it) {
      int slot = tid + it * 512;
      int pl = slot & 63, ig = slot >> 6;
      int c = c0 + pl;
      float w0 = cw[c], w1 = cw[1024 + c], w2 = cw[2048 + c], w3 = cw[3072 + c], w4 = cw[4096 + c], bb = cb[c];
      float o[8];
#pragma unroll
      for (int j = 0; j < 8; ++j) {
        int i = ig * 8 + j;
        float a = bb + tile[i * 65 + pl] * w0 + tile[(i + 1) * 65 + pl] * w1 + tile[(i + 2) * 65 + pl] * w2 +
                  tile[(i + 3) * 65 + pl] * w3 + tile[(i + 4) * 65 + pl] * w4;
        o[j] = silu_f(a);
      }
      u32x4 pk = {pack2(o[0], o[1]), pack2(o[2], o[3]), pack2(o[4], o[5]), pack2(o[6], o[7])};
      *(u32x4*)(dstbase + (size_t)pl * 128 + ig * 8) = pk;
    }
  }
  if (s >= 8) {
    u16* dstbase = s < 12 ? (u16*)(p.ws + OFF_BM) + (s - 8) * 64 : (u16*)(p.ws + OFF_CM) + (s - 12) * 64;
#pragma unroll
    for (int it = 0; it < 2; ++it) {
      int slot = tid + it * 512;
      int cg8 = slot & 7, i = slot >> 3;
      float o[8];
#pragma unroll
      for (int j = 0; j < 8; ++j) {
        int pl = cg8 * 8 + j;
        int c = c0 + pl;
        float a = cb[c] + tile[i * 65 + pl] * cw[c] + tile[(i + 1) * 65 + pl] * cw[1024 + c] +
                  tile[(i + 2) * 65 + pl] * cw[2048 + c] + tile[(i + 3) * 65 + pl] * cw[3072 + c] +
                  tile[(i + 4) * 65 + pl] * cw[4096 + c];
        o[j] = silu_f(a);
      }
      u32x4 pk = {pack2(o[0], o[1]), pack2(o[2], o[3]), pack2(o[4], o[5]), pack2(o[6], o[7])};
      *(u32x4*)(dstbase + (size_t)(row0 + i) * 256 + cg8 * 8) = pk;
    }
  }
  __syncthreads();
}

__device__ __forceinline__ void prep_dt(const P& p, int l, int ck, char* smem) {
  float* dts = (float*)smem;
  const int tid = otid();
  const float* proj = (const float*)(p.ws + OFF_PROJ);
  const int row0 = ck * 128;
#pragma unroll
  for (int it = 0; it < 4; ++it) {
    int i = (tid >> 4) + it * 32, col = tid & 15;
    float x = proj[(size_t)(row0 + i) * IN_DIM + 1536 + col] + p.in[I_DTB][l * 16 + col];
    dts[i * 16 + col] = softplus_f(x);
  }
  __syncthreads();
  if (tid < 16) {
    const int dir = tid >> 3, h = tid & 7;
    const float a = -expf(p.in[I_ALOG][l * 16 + tid]);
    float* DT = (float*)(p.ws + OFF_DT) + (size_t)((ck * 2 + dir) * 8 + h) * 128;
    float* CUM = (float*)(p.ws + OFF_CUM) + (size_t)((ck * 2 + dir) * 8 + h) * 128;
    float* WD = (float*)(p.ws + OFF_WDEC) + (size_t)((ck * 2 + dir) * 8 + h) * 128;
    float run = 0.f;
    if (dir == 0) {
      for (int i = 0; i < 128; ++i) { float d = dts[i * 16 + tid]; run += d * a; DT[i] = d; CUM[i] = run; dts[i * 16 + tid] = run; }
    } else {
      for (int i = 127; i >= 0; --i) { float d = dts[i * 16 + tid]; run += d * a; DT[i] = d; CUM[i] = run; dts[i * 16 + tid] = run; }
    }
    for (int i = 0; i < 128; ++i) WD[i] = DT[i] * __expf(run - dts[i * 16 + tid]);
  }
  __syncthreads();
}

__device__ __forceinline__ void prep_v(const P& p, int l, int ck, char* smem) {
  u16* tl = (u16*)smem;
  const int tid = otid(), w = tid >> 6, lane = tid & 63;
  const float* proj = (const float*)(p.ws + OFF_PROJ);
  const int row0 = ck * 128;
  const f32x4 g = *(const f32x4*)(p.in[I_SGUNG] + l * 256 + lane * 4);
  for (int rr = 0; rr < 16; ++rr) {
    int i = w * 16 + rr;
    f32x4 v = *(const f32x4*)(proj + (size_t)(row0 + i) * IN_DIM + 1552 + 256 + lane * 4);
    float ss = 0.f;
#pragma unroll
    for (int j = 0; j < 4; ++j) { v[j] = gelu_t(v[j]); ss += v[j] * v[j]; }
    ss = wave_sum(ss, lane);
    float rinv = rsqrtf(ss * (1.f / 256.f) + 1e-6f);
    u32x2 pk = {pack2(v[0] * rinv * g[0], v[1] * rinv * g[1]), pack2(v[2] * rinv * g[2], v[3] * rinv * g[3])};
    *(u32x2*)(tl + i * 264 + lane * 4) = pk;
  }
  __syncthreads();
  u16* VT = (u16*)(p.ws + OFF_VT) + (size_t)ck * 256 * 128;
#pragma unroll
  for (int it = 0; it < 8; ++it) {
    int c = tid & 255, ig = (tid >> 8) + 2 * it;
    u32x4 pk;
#pragma unroll
    for (int j = 0; j < 4; ++j)
      pk[j] = (unsigned)tl[(ig * 8 + 2 * j) * 264 + c] | ((unsigned)tl[(ig * 8 + 2 * j + 1) * 264 + c] << 16);
    *(u32x4*)(VT + (size_t)c * 128 + ig * 8) = pk;
  }
  __syncthreads();
}

template <int NT, bool PIPE>
__device__ __forceinline__ void ssd_state_chain(const P& p, int l, int sq, int h, int dir, int pt, int ntile0) {
  const int g = h >> 2;
  const bool lat = sq >= 16;
  const int nck = lat ? 8 : 2;
  const int ck0 = lat ? 32 + (sq - 16) * 8 : sq * 2;
  const int tid = otid(), w = tid >> 6, lane = tid & 63, quad = lane >> 4, l15 = lane & 15;
  const int lane_off = (pt * 16 + quad * 4) * 128 + ntile0 * 16 + l15;
  f32x4 acc[NT];
  if (lat) {
    const float* s0 = p.in[I_SSSD] + ((size_t)((((sq - 16) * 2 + l) * 2 + dir) * 8 + h) * 64) * 128;
#pragma unroll
    for (int nt = 0; nt < NT; ++nt)
#pragma unroll
      for (int r = 0; r < 4; ++r) acc[nt][r] = (s0 + lane_off)[r * 128 + nt * 16];
  } else {
#pragma unroll
    for (int nt = 0; nt < NT; ++nt) acc[nt] = (f32x4){0.f, 0.f, 0.f, 0.f};
  }
  const u16* XST = (const u16*)(p.ws + OFF_XST);
  const u16* BMT = (const u16*)(p.ws + OFF_BMT);
  u16* HPREV = (u16*)(p.ws + OFF_HPREV);
  u32x4 xr[4];
  f32x4 ww[4][2];
  bf16x8 bfr[4][NT];
  float cum_end = 0.f;
  auto issue = [&](int step) {
    const int ck = dir == 0 ? ck0 + step : ck0 + nck - 1 - step;
    const float* WD = (const float*)(p.ws + OFF_WDEC) + (size_t)((ck * 2 + dir) * 8 + h) * 128;
    const float* CUM = (const float*)(p.ws + OFF_CUM) + (size_t)((ck * 2 + dir) * 8 + h) * 128;
    cum_end = CUM[dir == 0 ? 127 : 0];
    const u16* xa = XST + ((size_t)(ck * 8 + h) * 64 + pt * 16 + l15) * 128;
    const u16* bb = BMT + ((size_t)(ck * 2 + g) * 128 + ntile0 * 16 + l15) * 128;
#pragma unroll
    for (int ks = 0; ks < 4; ++ks) {
      const int k0 = ks * 32 + quad * 8;
      xr[ks] = *(const u32x4*)(xa + k0);
      ww[ks][0] = *(const f32x4*)(WD + k0); ww[ks][1] = *(const f32x4*)(WD + k0 + 4);
#pragma unroll
      for (int nt = 0; nt < NT; ++nt) bfr[ks][nt] = ld_frag(bb + (size_t)nt * 16 * 128 + k0);
    }
  };
  if (PIPE) issue(0);
  for (int step = 0; step < nck; ++step) {
    const int ck = dir == 0 ? ck0 + step : ck0 + nck - 1 - step;
    u16* hp = HPREV + ((size_t)((ck * 2 + dir) * 8 + h) * 64) * 128;
    if (!PIPE) issue(step);
    const float decay = __expf(cum_end);
    bf16x8 af[4];
    bf16x8 bcur[4][NT];
#pragma unroll
    for (int ks = 0; ks < 4; ++ks) {
      u32x4 xs;
#pragma unroll
      for (int j = 0; j < 4; ++j) {
        float lo = __uint_as_float(xr[ks][j] << 16) * ww[ks][j >> 1][(j & 1) * 2];
        float hi = __uint_as_float(xr[ks][j] & 0xffff0000u) * ww[ks][j >> 1][(j & 1) * 2 + 1];
        xs[j] = pack2(lo, hi);
      }
      af[ks] = __builtin_bit_cast(bf16x8, xs);
#pragma unroll
      for (int nt = 0; nt < NT; ++nt) bcur[ks][nt] = bfr[ks][nt];
    }
    if (PIPE && step + 1 < nck) issue(step + 1);
#pragma unroll
    for (int nt = 0; nt < NT; ++nt)
#pragma unroll
      for (int r = 0; r < 4; ++r) (hp + lane_off)[r * 128 + nt * 16] = f2bf(acc[nt][r]);
#pragma unroll
    for (int nt = 0; nt < NT; ++nt)
#pragma unroll
      for (int r = 0; r < 4; ++r) acc[nt][r] *= decay;
#pragma unroll
    for (int ks = 0; ks < 4; ++ks)
#pragma unroll
      for (int nt = 0; nt < NT; ++nt) acc[nt] = mfma16(af[ks], bcur[ks][nt], acc[nt]);
  }
  if (!lat) {
    float* o = p.out + OUT_SSD + ((size_t)(((sq * 2 + l) * 2 + dir) * 8 + h) * 64) * 128;
#pragma unroll
    for (int nt = 0; nt < NT; ++nt)
#pragma unroll
      for (int r = 0; r < 4; ++r) (o + lane_off)[r * 128 + nt * 16] = acc[nt][r];
  }
}
__device__ __forceinline__ void ssd_state_item(const P& p, int l, int item) {
  const int w = otid() >> 6;
  if (item < 128) {
    const int idx = item >> 2, nq = item & 3;
    ssd_state_chain<1, false>(p, l, 16 + (idx >> 4), (idx & 15) >> 1, idx & 1, nq, w);
  } else {
    const int idx = item - 128;
    ssd_state_chain<4, false>(p, l, idx >> 4, (idx & 15) >> 1, idx & 1, w & 3, (w >> 2) * 4);
  }
}

__device__ __forceinline__ void s5_table_item(const P& p, int part) {
  const int tid = otid();
  for (int e = part * 512 + tid; e < 4096; e += 4096) {
    const float are = p.in[I_LRE][e], aim = p.in[I_LIM][e];
    const float step = expf(p.in[I_LOGDT][e >> 6]);
    const float er = expf(are * step), th = aim * step;
    const float lr = er * cosf(th), li = er * sinf(th);
    const float nr = lr - 1.f, ni = li;
    const float den = 1.f / (are * are + aim * aim);
    const float kr = (nr * are + ni * aim) * den, ki = (ni * are - nr * aim) * den;
    float pr = lr, pi = li;
#pragma unroll
    for (int k = 0; k < 5; ++k) { float a = pr * pr - pi * pi, b = 2.f * pr * pi; pr = a; pi = b; }
    f32x4* tab = (f32x4*)(p.ws + OFF_S5TAB) + (size_t)e * 2;
    tab[0] = (f32x4){lr, li, kr, ki};
    tab[1] = (f32x4){pr, pi, 0.f, 0.f};
    const int l = e >> 11, g = (e >> 6) & 15, n = e & 63;
    const float* Br = p.in[I_BRE] + ((size_t)(l * 16 + g) * 64 + n) * 16;
    const float* Bi = p.in[I_BIM] + ((size_t)(l * 16 + g) * 64 + n) * 16;
    u16* bb = (u16*)(p.ws + OFF_S5BB) + ((size_t)(e >> 6) * 128 + n * 2) * 16;
#pragma unroll
    for (int c4 = 0; c4 < 4; ++c4) {
      const f32x4 a = *(const f32x4*)(Br + c4 * 4), b = *(const f32x4*)(Bi + c4 * 4);
      u32x2 re = {pack2(kr * a[0] - ki * b[0], kr * a[1] - ki * b[1]), pack2(kr * a[2] - ki * b[2], kr * a[3] - ki * b[3])};
      u32x2 im = {pack2(kr * b[0] + ki * a[0], kr * b[1] + ki * a[1]), pack2(kr * b[2] + ki * a[2], kr * b[3] + ki * a[3])};
      *(u32x2*)(bb + c4 * 4) = re;
      *(u32x2*)(bb + 16 + c4 * 4) = im;
    }
  }
}
__device__ __forceinline__ void s5_sc_info(int sc, int& sq, int& j, int& nsc, int& sc0, int& row0) {
  if (sc < 128) { sq = sc >> 3; j = sc & 7; nsc = 8; sc0 = sq * 8; row0 = sq * 256; }
  else { int lb = (sc - 128) >> 5; sq = 16 + lb; j = (sc - 128) & 31; nsc = 32; sc0 = 128 + lb * 32; row0 = 4096 + lb * 1024; }
}
__device__ __forceinline__ int s5_row(bool lat, int row0, int s) { return lat ? row0 + (s & 15) * 64 + (s >> 4) : row0 + s; }

__device__ __forceinline__ void s5_load_u(const P& p, int sc, int gq, float* us) {
  int sq, j, nsc, sc0, row0;
  s5_sc_info(sc, sq, j, nsc, sc0, row0);
  const int tid = otid();
  const int gi = tid >> 7, i = (tid & 127) >> 2, c4 = tid & 3;
  const int row = s5_row(sq >= 16, row0, j * 32 + i);
  const float* proj = (const float*)(p.ws + OFF_PROJ);
  f32x4 v = *(const f32x4*)(proj + (size_t)row * IN_DIM + 2064 + (gq * 4 + gi) * 16 + c4 * 4);
  *(f32x4*)(us + (gi * 32 + i) * 16 + c4 * 4) = v;
}
__device__ __forceinline__ void s5_bu_mfma(const P& p, int l, int dir, int g, const float* us_g, float* hb, int lane) {
  const int quad = lane >> 4, l15 = lane & 15;
  bf16x8 af[2];
#pragma unroll
  for (int mt = 0; mt < 2; ++mt) {
    u32x4 pk = {0u, 0u, 0u, 0u};
    if (quad < 2) {
      const f32x4 a = *(const f32x4*)(us_g + (mt * 16 + l15) * 16 + quad * 8), b = *(const f32x4*)(us_g + (mt * 16 + l15) * 16 + quad * 8 + 4);
      pk = (u32x4){pack2(a[0], a[1]), pack2(a[2], a[3]), pack2(b[0], b[1]), pack2(b[2], b[3])};
    }
    af[mt] = __builtin_bit_cast(bf16x8, pk);
  }
  const u16* bb = (const u16*)(p.ws + OFF_S5BB) + ((size_t)((l * 2 + dir) * 16 + g) * 128 + l15) * 16 + (quad & 1) * 8;
#pragma unroll
  for (int nt = 0; nt < 8; ++nt) {
    u32x4 bv = *(const u32x4*)(bb + (size_t)nt * 16 * 16);
    if (quad >= 2) bv = (u32x4){0u, 0u, 0u, 0u};
    const bf16x8 bq = __builtin_bit_cast(bf16x8, bv);
#pragma unroll
    for (int mt = 0; mt < 2; ++mt) {
      f32x4 acc = {0.f, 0.f, 0.f, 0.f};
      acc = mfma16(af[mt], bq, acc);
#pragma unroll
      for (int r = 0; r < 4; ++r) hb[(mt * 16 + quad * 4 + r) * 132 + nt * 16 + l15] = acc[r];
    }
  }
}

__device__ __forceinline__ void s5_local_item(const P& p, int l, int item, char* smem) {
  float* us = (float*)smem;
  float* HB = (float*)(smem + 8192);
  const int sc = item >> 2, gq = item & 3;
  s5_load_u(p, sc, gq, us);
  __syncthreads();
  const int tid = otid(), w = tid >> 6, n = tid & 63;
  const int gi = w >> 1, dir = w & 1, g = gq * 4 + gi;
  float* hb = HB + (gi * 2 + dir) * 32 * 132;
  s5_bu_mfma(p, l, dir, g, us + gi * 32 * 16, hb, n);
  __syncthreads();
  const f32x4 t0 = *((const f32x4*)(p.ws + OFF_S5TAB) + (size_t)(((l * 2 + dir) * 16 + g) * 64 + n) * 2);
  const float lr = t0[0], li = t0[1];
  float hr = 0.f, hi = 0.f;
#pragma unroll 8
  for (int ii = 0; ii < 32; ++ii) {
    const int i = dir == 0 ? ii : 31 - ii;
    const float2 bu = *(const float2*)(hb + i * 132 + n * 2);
    const float a = lr * hr - li * hi + bu.x, b = lr * hi + li * hr + bu.y;
    hr = a; hi = b;
  }
  float* E = (float*)(p.ws + OFF_S5E);
  *(float2*)(E + ((size_t)((sc * 16 + g) * 2 + dir) * 64 + n) * 2) = make_float2(hr, hi);
  __syncthreads();
}

__device__ __forceinline__ void s5_out_item(const P& p, int l, int item, char* smem) {
  float* us = (float*)smem;
  float* HB = (float*)(smem + 8192);
  const int sc = item >> 2, gq = item & 3;
  int sq, j, nsc, sc0, row0;
  s5_sc_info(sc, sq, j, nsc, sc0, row0);
  const bool lat = sq >= 16;
  s5_load_u(p, sc, gq, us);
  __syncthreads();
  const int tid = otid(), w = tid >> 6, lane = tid & 63;
  {
    const int n = lane;
    const int gi = w >> 1, dir = w & 1, g = gq * 4 + gi;
    float* hb = HB + (gi * 2 + dir) * 32 * 132;
    s5_bu_mfma(p, l, dir, g, us + gi * 32 * 16, hb, lane);
    __syncthreads();
    const f32x4* tab = (const f32x4*)(p.ws + OFF_S5TAB) + (size_t)(((l * 2 + dir) * 16 + g) * 64 + n) * 2;
    const f32x4 t0 = tab[0], t1 = tab[1];
    const float lr = t0[0], li = t0[1], pr = t1[0], pi = t1[1];
    float hr = 0.f, hi = 0.f;
    if (lat) {
      const int si = ((((sq - 16) * 2 + l) * 2 + dir) * 16 + g) * 64 + n;
      hr = p.in[I_SS5R][si];
      hi = p.in[I_SS5I][si];
    }
    const float* E = (const float*)(p.ws + OFF_S5E);
    const int nprev = dir == 0 ? j : nsc - 1 - j;
    for (int jj0 = 0; jj0 < nprev; jj0 += 8) {
      float2 ev[8];
#pragma unroll
      for (int u = 0; u < 8; ++u) {
        const int jj = jj0 + u < nprev ? jj0 + u : nprev - 1;
        const int scp = dir == 0 ? sc0 + jj : sc0 + nsc - 1 - jj;
        ev[u] = *(const float2*)(E + ((size_t)((scp * 16 + g) * 2 + dir) * 64 + n) * 2);
      }
#pragma unroll
      for (int u = 0; u < 8; ++u) {
        if (jj0 + u < nprev) {
          const float a = pr * hr - pi * hi + ev[u].x, b = pr * hi + pi * hr + ev[u].y;
          hr = a; hi = b;
        }
      }
    }
#pragma unroll 8
    for (int ii = 0; ii < 32; ++ii) {
      const int i = dir == 0 ? ii : 31 - ii;
      float2* cell = (float2*)(hb + i * 132 + n * 2);
      const float2 bu = *cell;
      const float a = lr * hr - li * hi + bu.x, b = lr * hi + li * hr + bu.y;
      hr = a; hi = b;
      *cell = make_float2(hr, hi);
    }
    if (!lat && ((dir == 0 && j == nsc - 1) || (dir == 1 && j == 0))) {
      const int oi = (((sq * 2 + l) * 2 + dir) * 16 + g) * 64 + n;
      p.out[OUT_S5RE + oi] = hr;
      p.out[OUT_S5IM + oi] = hi;
    }
  }
  __syncthreads();
  {
    const int quad = lane >> 4, l15 = lane & 15;
    const int gi = w >> 1, mt = w & 1, g = gq * 4 + gi;
    const float* Cr = p.in[I_CRE] + ((size_t)(l * 16 + g) * 16 + l15) * 64;
    const float* Ci = p.in[I_CIM] + ((size_t)(l * 16 + g) * 16 + l15) * 64;
    bf16x8 bfr[4];
#pragma unroll
    for (int k4 = 0; k4 < 4; ++k4) {
      f32x4 cr = *(const f32x4*)(Cr + k4 * 16 + quad * 4), ci = *(const f32x4*)(Ci + k4 * 16 + quad * 4);
      u32x4 pk = {pack2(cr[0], -ci[0]), pack2(cr[1], -ci[1]), pack2(cr[2], -ci[2]), pack2(cr[3], -ci[3])};
      bfr[k4] = __builtin_bit_cast(bf16x8, pk);
    }
    f32x4 acc = {0.f, 0.f, 0.f, 0.f};
#pragma unroll
    for (int ks = 0; ks < 8; ++ks) {
      const float* ha = HB + ((gi * 2 + (ks >> 2)) * 32 + mt * 16 + l15) * 132 + (ks & 3) * 32 + quad * 8;
      const f32x4 h0 = *(const f32x4*)ha, h1 = *(const f32x4*)(ha + 4);
      u32x4 pk = {pack2(h0[0], h0[1]), pack2(h0[2], h0[3]), pack2(h1[0], h1[1]), pack2(h1[2], h1[3])};
      acc = mfma16(__builtin_bit_cast(bf16x8, pk), bfr[ks & 3], acc);
    }
    const float dsk = p.in[I_S5D][l * 256 + g * 16 + l15];
    u16* Y1B = (u16*)(p.ws + OFF_Y1B);
#pragma unroll
    for (int r = 0; r < 4; ++r) {
      const int i = mt * 16 + quad * 4 + r;
      const float y = acc[r] + dsk * us[(gi * 32 + i) * 16 + l15];
      const int row = s5_row(lat, row0, j * 32 + i);
      Y1B[(size_t)row * 256 + g * 16 + l15] = f2bf(gelu_t(y));
    }
  }
  __syncthreads();
}

__device__ __forceinline__ void sgu_item(const P& p, int l, int item) {
  const int ck = item >> 2, hd = item & 3;
  const int tid = otid(), w = tid >> 6, lane = tid & 63, quad = lane >> 4, l15 = lane & 15;
  const u16* W = (const u16*)(p.ws + OFF_SGUW) + ((size_t)(l * 4 + hd) * 128 + w * 16 + l15) * 128;
  const u16* VT = (const u16*)(p.ws + OFF_VT) + ((size_t)ck * 256 + hd * 64 + l15) * 128;
  f32x4 acc[4];
#pragma unroll
  for (int d = 0; d < 4; ++d) acc[d] = (f32x4){0.f, 0.f, 0.f, 0.f};
#pragma unroll
  for (int ks = 0; ks < 4; ++ks) {
    const int k0 = ks * 32 + quad * 8;
    bf16x8 af = ld_frag(W + k0);
#pragma unroll
    for (int d = 0; d < 4; ++d) acc[d] = mfma16(af, ld_frag(VT + (size_t)d * 16 * 128 + k0), acc[d]);
  }
  const float* proj = (const float*)(p.ws + OFF_PROJ);
  u16* MIX = (u16*)(p.ws + OFF_MIXED);
#pragma unroll
  for (int r = 0; r < 4; ++r) {
    const int q = w * 16 + quad * 4 + r;
    const float b = p.in[I_SGUB][(l * 4 + hd) * 128 + q];
    const size_t row = (size_t)ck * 128 + q;
#pragma unroll
    for (int d = 0; d < 4; ++d) {
      const int col = hd * 64 + d * 16 + l15;
      const float u = gelu_t(proj[row * IN_DIM + 1552 + col]);
      MIX[row * 1024 + 512 + col] = f2bf(u * (acc[d][r] + b));
    }
  }
}

__device__ __forceinline__ void ssd_out_item(const P& p, int l, int item, char* smem) {
  float* red = (float*)smem;
  const int ck = item >> 2, qb2 = item & 3;
  const int tid = otid(), h = tid >> 6, lane = tid & 63, quad = lane >> 4, l15 = lane & 15;
  const int g = h >> 2, q0 = qb2 * 32;
  const size_t row0 = (size_t)ck * 128;
  const u16* BM = (const u16*)(p.ws + OFF_BM);
  const u16* CM = (const u16*)(p.ws + OFF_CM);
  const float* DTf = (const float*)(p.ws + OFF_DT) + (size_t)((ck * 2 + 0) * 8 + h) * 128;
  const float* DTb = (const float*)(p.ws + OFF_DT) + (size_t)((ck * 2 + 1) * 8 + h) * 128;
  const float* CF = (const float*)(p.ws + OFF_CUM) + (size_t)((ck * 2 + 0) * 8 + h) * 128;
  const float* CB = (const float*)(p.ws + OFF_CUM) + (size_t)((ck * 2 + 1) * 8 + h) * 128;
  bf16x8 cmf[2][4];
#pragma unroll
  for (int t = 0; t < 2; ++t)
#pragma unroll
    for (int ns = 0; ns < 4; ++ns) cmf[t][ns] = ld_frag(CM + (row0 + q0 + t * 16 + l15) * 256 + g * 128 + ns * 32 + quad * 8);
  float cfq[2], cbq[2], dsum[2];
#pragma unroll
  for (int t = 0; t < 2; ++t) {
    const int q = q0 + t * 16 + l15;
    cfq[t] = CF[q]; cbq[t] = CB[q]; dsum[t] = DTf[q] + DTb[q];
  }
  const float Dh = p.in[I_SSDD][l * 8 + h];
  u32x4 As[2][4];
#pragma unroll
  for (int kt = 0; kt < 8; ++kt) {
    f32x4 aT[2] = {{0.f, 0.f, 0.f, 0.f}, {0.f, 0.f, 0.f, 0.f}};
#pragma unroll
    for (int ns = 0; ns < 4; ++ns) {
      const bf16x8 bmf = ld_frag(BM + (row0 + kt * 16 + l15) * 256 + g * 128 + ns * 32 + quad * 8);
      aT[0] = mfma16(bmf, cmf[0][ns], aT[0]);
      aT[1] = mfma16(bmf, cmf[1][ns], aT[1]);
    }
    const int kb = kt * 16 + quad * 4;
    f32x4 c = {0.f, 0.f, 0.f, 0.f}, d = c, c2 = c, d2 = c;
    if (kt <= qb2 * 2 + 1) { c = *(const f32x4*)(CF + kb); d = *(const f32x4*)(DTf + kb); }
    if (kt >= qb2 * 2) { c2 = *(const f32x4*)(CB + kb); d2 = *(const f32x4*)(DTb + kb); }
#pragma unroll
    for (int t = 0; t < 2; ++t) {
      const int qt = qb2 * 2 + t;
      const int q = q0 + t * 16 + l15;
      float m[4];
      if (kt < qt) {
#pragma unroll
        for (int r = 0; r < 4; ++r) m[r] = aT[t][r] * __expf(cfq[t] - c[r]) * d[r];
      } else if (kt > qt) {
#pragma unroll
        for (int r = 0; r < 4; ++r) m[r] = aT[t][r] * __expf(cbq[t] - c2[r]) * d2[r];
      } else {
#pragma unroll
        for (int r = 0; r < 4; ++r) {
          const int k = kb + r;
          float f;
          if (k < q) f = __expf(cfq[t] - c[r]) * d[r];
          else if (k > q) f = __expf(cbq[t] - c2[r]) * d2[r];
          else f = dsum[t];
          m[r] = aT[t][r] * f + (k == q ? Dh : 0.f);
        }
      }
      As[t][kt >> 1][(kt & 1) * 2 + 0] = pack2(m[0], m[1]);
      As[t][kt >> 1][(kt & 1) * 2 + 1] = pack2(m[2], m[3]);
    }
    if (kt & 1) asm volatile("" ::: "memory");
  }
  const u16* XST = (const u16*)(p.ws + OFF_XST) + ((size_t)(ck * 8 + h) * 64 + l15) * 128;
  const u16* HPf = (const u16*)(p.ws + OFF_HPREV) + ((size_t)((ck * 2 + 0) * 8 + h) * 64 + l15) * 128;
  const u16* HPb = (const u16*)(p.ws + OFF_HPREV) + ((size_t)((ck * 2 + 1) * 8 + h) * 64 + l15) * 128;
  const float* proj = (const float*)(p.ws + OFF_PROJ);
  float* ybuf = (float*)(smem + 1024) + (h * 32 + quad * 4) * 65 + l15;
  float ss[2][4] = {{0.f, 0.f, 0.f, 0.f}, {0.f, 0.f, 0.f, 0.f}};
#pragma unroll 1
  for (int pt = 0; pt < 4; ++pt) {
    f32x4 aY[2] = {{0.f, 0.f, 0.f, 0.f}, {0.f, 0.f, 0.f, 0.f}};
    f32x4 aF[2] = {{0.f, 0.f, 0.f, 0.f}, {0.f, 0.f, 0.f, 0.f}};
    f32x4 aB[2] = {{0.f, 0.f, 0.f, 0.f}, {0.f, 0.f, 0.f, 0.f}};
#pragma unroll
    for (int s2 = 0; s2 < 4; ++s2) {
      u32x2 lo = *(const u32x2*)(XST + (size_t)pt * 16 * 128 + (2 * s2) * 16 + quad * 4);
      u32x2 hi = *(const u32x2*)(XST + (size_t)pt * 16 * 128 + (2 * s2 + 1) * 16 + quad * 4);
      const bf16x8 bv = __builtin_bit_cast(bf16x8, (u32x4){lo[0], lo[1], hi[0], hi[1]});
      aY[0] = mfma16(__builtin_bit_cast(bf16x8, As[0][s2]), bv, aY[0]);
      aY[1] = mfma16(__builtin_bit_cast(bf16x8, As[1][s2]), bv, aY[1]);
    }
#pragma unroll
    for (int ns = 0; ns < 4; ++ns) {
      const bf16x8 hf = ld_frag(HPf + (size_t)pt * 16 * 128 + ns * 32 + quad * 8);
      const bf16x8 hb = ld_frag(HPb + (size_t)pt * 16 * 128 + ns * 32 + quad * 8);
      aF[0] = mfma16(cmf[0][ns], hf, aF[0]);
      aF[1] = mfma16(cmf[1][ns], hf, aF[1]);
      aB[0] = mfma16(cmf[0][ns], hb, aB[0]);
      aB[1] = mfma16(cmf[1][ns], hb, aB[1]);
    }
#pragma unroll
    for (int t = 0; t < 2; ++t)
#pragma unroll
      for (int r = 0; r < 4; ++r) {
        const int qq = q0 + t * 16 + quad * 4 + r;
        float yv = aY[t][r] + __expf(CF[qq]) * aF[t][r] + __expf(CB[qq]) * aB[t][r];
        const float zv = proj[(row0 + qq) * IN_DIM + h * 64 + pt * 16 + l15];
        yv *= silu_f(zv);
        ybuf[(t * 16 + r) * 65 + pt * 16] = yv;
        ss[t][r] += yv * yv;
      }
  }
  const int lane2 = otid() & 63;
#pragma unroll
  for (int t = 0; t < 2; ++t)
#pragma unroll
    for (int r = 0; r < 4; ++r) {
      float sv = ss[t][r];
#pragma unroll
      for (int o = 1; o < 16; o <<= 1) sv += shx(sv, o, lane2);
      ss[t][r] = sv;
    }
  if (l15 == 0) {
#pragma unroll
    for (int t = 0; t < 2; ++t)
#pragma unroll
      for (int r = 0; r < 4; ++r) red[(t * 16 + quad * 4 + r) * 8 + h] = ss[t][r];
  }
  __syncthreads();
  u16* MIX = (u16*)(p.ws + OFF_MIXED);
  const float* ng = p.in[I_SSDNG] + l * 512 + h * 64;
#pragma unroll
  for (int t = 0; t < 2; ++t)
#pragma unroll
    for (int r = 0; r < 4; ++r) {
      const int qq = q0 + t * 16 + quad * 4 + r;
      float tot = 0.f;
#pragma unroll
      for (int hh = 0; hh < 8; ++hh) tot += red[(t * 16 + quad * 4 + r) * 8 + hh];
      const float rinv = rsqrtf(tot * (1.f / 512.f) + 1e-6f);
#pragma unroll
      for (int pt = 0; pt < 4; ++pt) {
        const int pc = pt * 16 + l15;
        MIX[(row0 + qq) * 1024 + h * 64 + pc] = f2bf(ybuf[(t * 16 + r) * 65 + pt * 16] * rinv * ng[pc]);
      }
    }
  __syncthreads();
}

#define XB_TMO      128
#define XB_XCNT(j)  (256  + 64 * (j))
#define XB_XSUB(j)  (1280 + 64 * (j))
#define XB_XGEN(j)  (2304 + 64 * (j))
#define XB_TOP      3328
#define XB_TOPGEN   3392
#define XCD_BAR_WORDS 3456
#define XB_SPIN_CAP (1u << 18)
#define LAS __attribute__((address_space(3)))
__device__ __forceinline__ unsigned xb_ld(unsigned* p) { return __hip_atomic_load(p, __ATOMIC_RELAXED, __HIP_MEMORY_SCOPE_AGENT); }
__device__ __forceinline__ unsigned xb_add(unsigned* p, unsigned v) { return __hip_atomic_fetch_add(p, v, __ATOMIC_RELAXED, __HIP_MEMORY_SCOPE_AGENT); }
__device__ __forceinline__ unsigned xb_xcc_id() { return (unsigned)__builtin_amdgcn_s_getreg((3 << 11) | 20) & 0xFu; }
#define XB_SPIN(cond, bar) do { unsigned _sp = 0; while (cond) { __builtin_amdgcn_s_sleep(1); \
    if ((++_sp & 255u) == 0u) { if (xb_ld(&(bar)[XB_TMO])) break; if (_sp > XB_SPIN_CAP) { atomicAdd(&(bar)[XB_TMO], 1u); break; } } } } while (0)
struct XcdBarrier { unsigned* bar; unsigned x; volatile LAS unsigned* st; };
__device__ __forceinline__ XcdBarrier xcd_barrier_post(unsigned* bar, volatile LAS unsigned* st) {
  XcdBarrier b; b.bar = bar; b.x = xb_xcc_id(); b.st = st;
  if (threadIdx.x == 0) (void)xb_add(&bar[XB_XCNT(b.x)], 1u);
  return b;
}
__device__ __forceinline__ void xcd_barrier_complete(unsigned* bar, unsigned x, unsigned& nloc, unsigned& nx) {
  const unsigned G = gridDim.x * gridDim.y * gridDim.z;
  unsigned sum, cnt, mine, sp = 0u;
  for (;;) {
    sum = 0u; cnt = 0u; mine = 0u;
#pragma unroll
    for (unsigned j = 0; j < 16; ++j) { const unsigned c = xb_ld(&bar[XB_XCNT(j)]); sum += c; cnt += (c > 0u) ? 1u : 0u; mine = (j == x) ? c : mine; }
    if (sum == G) break;
    __builtin_amdgcn_s_sleep(1);
    if ((++sp & 255u) == 0u) { if (xb_ld(&bar[XB_TMO])) break; if (sp > XB_SPIN_CAP) { atomicAdd(&bar[XB_TMO], 1u); break; } }
  }
  nloc = mine > 0u ? mine : 1u; nx = cnt > 0u ? cnt : 1u;
}
__device__ __forceinline__ void xcd_barrier(const XcdBarrier& b) {
  asm volatile("s_waitcnt vmcnt(0)" ::: "memory");
  __syncthreads();
  if (threadIdx.x == 0) {
    unsigned* bar = b.bar;
    __builtin_amdgcn_s_waitcnt(0);
    unsigned nloc = b.st[0], nx = b.st[1];
    if (nloc == 0u) { xcd_barrier_complete(bar, b.x, nloc, nx); b.st[0] = nloc; b.st[1] = nx; }
    const unsigned old = xb_add(&bar[XB_XSUB(b.x)], 1u);
    const unsigned gen = old / nloc;
    if (old + 1u == (gen + 1u) * nloc) {
      __builtin_amdgcn_fence(__ATOMIC_RELEASE, "agent");
      asm volatile("s_waitcnt vmcnt(0)" ::: "memory");
      const unsigned og = xb_add(&bar[XB_TOP], 1u);
      const unsigned tg = og / nx;
      if (og + 1u == (tg + 1u) * nx) xb_add(&bar[XB_TOPGEN], 1u);
      else XB_SPIN(xb_ld(&bar[XB_TOPGEN]) == tg, bar);
      __builtin_amdgcn_fence(__ATOMIC_ACQUIRE, "agent");
      xb_add(&bar[XB_XGEN(b.x)], 1u);
      asm volatile("s_waitcnt vmcnt(0)" ::: "memory");
    } else {
      XB_SPIN(xb_ld(&bar[XB_XGEN(b.x)]) == gen, bar);
      __builtin_amdgcn_fence(__ATOMIC_ACQUIRE, "agent");
      asm volatile("s_waitcnt vmcnt(0)" ::: "memory");
    }
  }
  __syncthreads();
}

__device__ __forceinline__ int next_item(unsigned* ctr, int* slot) {
  __syncthreads();
  if (threadIdx.x == 0) *slot = (int)xb_add(ctr, 1u);
  __syncthreads();
  return *slot;
}

__device__ __forceinline__ void run_phase(const P& p, int ph, int rep, char* smem, int* qslot) {
  const int nb = gridDim.x, bid = obid();
  unsigned* qctr = (unsigned*)(p.ws + OFF_BAR) + 3520 + 16 * (ph * 2 + rep);
  if (ph == 0) {
    for (int it = bid; it < 192 + 16 + 8; it += nb) {
      if (it < 192) mod_item(p, it, smem);
      else if (it < 208) p0_sgu_item(p, it - 192);
      else s5_table_item(p, it - 208);
    }
    p0_transposes(p, smem);
    return;
  }
  if (ph == 21) {
    norm_phase(p, 0, 2, (const float*)(p.ws + OFF_XB), (const float*)(p.ws + OFF_XB) + (size_t)4096 * 1024);
    return;
  }
  const int l = (ph - 1) / 10, sp = (ph - 1) % 10;
  const float* x0a = l == 0 ? p.in[I_XP] : (const float*)(p.ws + OFF_XB);
  const float* x0b = l == 0 ? p.in[I_XS] : (const float*)(p.ws + OFF_XB) + (size_t)4096 * 1024;
  const float* x1a = (const float*)(p.ws + OFF_XA);
  const float* x1b = x1a + (size_t)4096 * 1024;
  const float* mod = (const float*)(p.ws + OFF_MOD) + (size_t)l * 3 * 6144;
  Epi e{};
  switch (sp) {
    case 0: norm_phase(p, l, 0, x0a, x0b); break;
    case 1:
      e.outf = (float*)(p.ws + OFF_PROJ);
      gemm_phase<0, 1024>((const u16*)(p.ws + OFF_H), (const u16*)(p.ws + OFF_WIN_T) + (size_t)l * IN_PAD * 1024, 19, e, smem, bid, nb);
      break;
    case 2: {
      constexpr int NB = 768 * ((DUP & 16) ? 2 : 1);
      for (int it = next_item(qctr, qslot); it < 864 + NB; it = next_item(qctr, qslot)) {
        if (it < 48) prep_v(p, l, it, smem);
        else if (it < 48 + NB) s5_local_item(p, l, (it - 48) % 768, smem);
        else if (it < 48 + NB + 768) { int k = it - 48 - NB; prep_conv(p, l, k >> 4, k & 15, smem); }
        else prep_dt(p, l, it - 816 - NB, smem);
      }
    } break;
    case 3: {
      constexpr int NA = 384 * ((DUP & 8) ? 2 : 1), NB = 768 * ((DUP & 2) ? 2 : 1), NC = 192 * ((DUP & 4) ? 2 : 1);
      for (int it = next_item(qctr, qslot); it < NA + NB + NC; it = next_item(qctr, qslot)) {
        if (it < NA) ssd_state_item(p, l, it % 384);
        else if (it < NA + NB) s5_out_item(p, l, (it - NA) % 768, smem);
        else sgu_item(p, l, (it - NA - NB) % 192);
      }
    } break;
    case 4: {
      constexpr int NA = 192 * ((DUP & 1) ? 2 : 1);
      Epi ge{};
      ge.outb = (u16*)(p.ws + OFF_MIXED);
      ge.y1 = (const u16*)(p.ws + OFF_Y1B);
      ge.bias = p.in[I_GLUB] + l * 256;
      {
        const int g0 = nb > 64 ? nb - 64 : 0;
        if (bid >= g0) gemm_phase<3, 256>((const u16*)(p.ws + OFF_Y1B), (const u16*)(p.ws + OFF_GLU_T) + (size_t)l * 256 * 256, 2, ge, smem, bid - g0, nb - g0);
      }
      for (int it = next_item(qctr, qslot); it < NA; it = next_item(qctr, qslot)) ssd_out_item(p, l, it % 192, smem);
    } break;
    case 5: break;
    case 6:
      e.outf = (float*)(p.ws + OFF_XA);
      e.xa = x0a; e.xb = x0b; e.gate = mod + 2048;
      gemm_phase<1, 1024>((const u16*)(p.ws + OFF_MIXED), (const u16*)(p.ws + OFF_WOUT_T) + (size_t)l * 1024 * 1024, 8, e, smem, bid, nb);
      break;
    case 7: norm_phase(p, l, 1, x1a, x1b); break;
    case 8:
      e.outb = (u16*)(p.ws + OFF_PROJ);
      gemm_phase<2, 1024>((const u16*)(p.ws + OFF_H), (const u16*)(p.ws + OFF_W1_T) + (size_t)l * 4096 * 1024, 32, e, smem, bid, nb);
      break;
    case 9:
      e.outf = (float*)(p.ws + OFF_XB);
      e.xa = x1a; e.xb = x1b; e.gate = mod + 5120;
      gemm_phase<1, 4096>((const u16*)(p.ws + OFF_PROJ), (const u16*)(p.ws + OFF_W2_T) + (size_t)l * 1024 * 4096, 8, e, smem, bid, nb);
      break;
  }
}

#ifndef REP_MASK
#define REP_MASK 0
#endif
__device__ __forceinline__ int phase_type(int ph) { return ph == 0 ? 10 : ph == 21 ? 11 : (ph - 1) % 10; }

__global__ void __launch_bounds__(512) mega(P p, int ph_lo, int ph_hi, int coop) {
  __shared__ __attribute__((aligned(16))) char smem[SMEM_BYTES];
  __shared__ __attribute__((aligned(16))) unsigned xb_words[4];
  XcdBarrier xb;
  if (coop) {
    if (threadIdx.x < 4) xb_words[threadIdx.x] = 0u;
    __syncthreads();
    xb = xcd_barrier_post((unsigned*)(p.ws + OFF_BAR), (volatile LAS unsigned*)xb_words);
  }
  for (int ph = ph_lo; ph < ph_hi; ++ph) {
    if (phase_type(ph) == 5) continue;
    const int reps = ((REP_MASK >> phase_type(ph)) & 1) ? 2 : 1;
    for (int r = 0; r < reps; ++r) run_phase(p, ph, r, smem, (int*)&xb_words[2]);
    if (coop == 1 && ph + 1 < ph_hi) xcd_barrier(xb);
    if (coop == 2) cg::this_grid().sync();
  }
}

extern "C" void kernel_launch(void* const* d_in, const int* in_sizes, int n_in, void* d_out, int out_size, void* d_ws,
                              size_t ws_size, hipStream_t stream) {
  static int grid_blocks = 0;
  if (!grid_blocks) {
    int dev = 0, cus = 0, per_cu = 0;
    hipGetDevice(&dev);
    hipDeviceGetAttribute(&cus, hipDeviceAttributeMultiprocessorCount, dev);
    hipOccupancyMaxActiveBlocksPerMultiprocessor(&per_cu, mega, 512, 0);
    if (per_cu < 1) per_cu = 1;
    grid_blocks = cus * per_cu;
  }
  P p{};
  for (int i = 0; i < 35; ++i) p.in[i] = (const float*)d_in[i];
  p.out = (float*)d_out;
  p.ws = (char*)d_ws;
  if (ws_size < WS_TOTAL) { fprintf(stderr, "workspace too small: %zu < %zu\n", ws_size, (size_t)WS_TOTAL); return; }
#if COOP
  hipMemsetAsync((char*)d_ws + OFF_BAR, 0, 65536, stream);
  int lo = 0, hi = 22, coop = 1;
  void* args[] = {&p, &lo, &hi, &coop};
  hipError_t err = hipLaunchCooperativeKernel((void*)mega, dim3(grid_blocks), dim3(512), args, 0, stream);
  if (err != hipSuccess) fprintf(stderr, "cooperative launch failed: %s (grid %d)\n", hipGetErrorString(err), grid_blocks);
#else
  for (int ph = 0; ph < 22; ++ph) mega<<<dim3(grid_blocks), dim3(512), 0, stream>>>(p, ph, ph + 1, 0);
#endif
}
```

```cpp
#include <hip/hip_runtime.h>
#include <hip/hip_cooperative_groups.h>
#include <cstdio>
namespace cg = cooperative_groups;

#define DUP 0
#ifndef COOP
#define COOP 1
#endif

typedef unsigned short u16;
typedef __attribute__((ext_vector_type(8))) short bf16x8;
typedef __attribute__((ext_vector_type(4))) float f32x4;
typedef __attribute__((ext_vector_type(4))) unsigned int u32x4;
typedef __attribute__((ext_vector_type(2))) unsigned int u32x2;

constexpr int T_TOK = 6144;
constexpr int DM = 1024;
constexpr int IN_DIM = 2320;
constexpr int IN_PAD = 2432;
constexpr int DFF = 4096;
constexpr int SMEM_BYTES = 143360;

constexpr size_t OFF_WIN_T = 0;
constexpr size_t OFF_WOUT_T = OFF_WIN_T + (size_t)2 * IN_PAD * 1024 * 2;
constexpr size_t OFF_W1_T = OFF_WOUT_T + (size_t)2 * 1024 * 1024 * 2;
constexpr size_t OFF_W2_T = OFF_W1_T + (size_t)2 * 4096 * 1024 * 2;
constexpr size_t OFF_GLU_T = OFF_W2_T + (size_t)2 * 4096 * 1024 * 2;
constexpr size_t OFF_SGUW = OFF_GLU_T + (size_t)2 * 256 * 256 * 2;
constexpr size_t OFF_MOD = OFF_SGUW + (size_t)2 * 4 * 128 * 128 * 2;
constexpr size_t OFF_H = OFF_MOD + (size_t)2 * 3 * 6144 * 4;
constexpr size_t OFF_PROJ = OFF_H + (size_t)T_TOK * 1024 * 2;
constexpr size_t OFF_MIXED = OFF_PROJ + (size_t)T_TOK * IN_DIM * 4;
constexpr size_t OFF_XA = OFF_MIXED + (size_t)T_TOK * 1024 * 2;
constexpr size_t OFF_XB = OFF_XA + (size_t)T_TOK * 1024 * 4;
constexpr size_t OFF_HPREV = OFF_XB + (size_t)T_TOK * 1024 * 4;
constexpr size_t OFF_BM = OFF_HPREV + (size_t)48 * 2 * 8 * 64 * 128 * 2;
constexpr size_t OFF_CM = OFF_BM + (size_t)T_TOK * 256 * 2;
constexpr size_t OFF_BMT = OFF_CM + (size_t)T_TOK * 256 * 2;
constexpr size_t OFF_XST = OFF_BMT + (size_t)48 * 2 * 128 * 128 * 2;
constexpr size_t OFF_VT = OFF_XST + (size_t)48 * 8 * 64 * 128 * 2;
constexpr size_t OFF_DT = OFF_VT + (size_t)48 * 256 * 128 * 2;
constexpr size_t OFF_CUM = OFF_DT + (size_t)48 * 2 * 8 * 128 * 4;
constexpr size_t OFF_WDEC = OFF_CUM + (size_t)48 * 2 * 8 * 128 * 4;
constexpr size_t OFF_S5E = OFF_WDEC + (size_t)48 * 2 * 8 * 128 * 4;
constexpr size_t OFF_Y1B = OFF_S5E + (size_t)192 * 16 * 2 * 64 * 8;
constexpr size_t OFF_S5TAB = OFF_Y1B + (size_t)T_TOK * 256 * 2;
constexpr size_t OFF_S5BB = OFF_S5TAB + (size_t)4096 * 32;
constexpr size_t OFF_BAR = OFF_S5BB + (size_t)64 * 128 * 16 * 2;
constexpr size_t WS_TOTAL = OFF_BAR + 65536;

constexpr size_t OUT_SSD = (size_t)T_TOK * 1024;
constexpr size_t OUT_S5RE = OUT_SSD + (size_t)16 * 2 * 2 * 8 * 64 * 128;
constexpr size_t OUT_S5IM = OUT_S5RE + (size_t)16 * 2 * 2 * 16 * 64;

struct P {
  const float* in[35];
  float* out;
  char* ws;
};

enum { I_XP = 0, I_XS, I_SSSD, I_SS5R, I_SS5I, I_C, I_CCTX, I_ADAW, I_ADAB, I_N1G, I_N2G, I_WIN, I_CONVW, I_CONVB,
       I_DTB, I_ALOG, I_SSDD, I_SSDNG, I_SGUNG, I_SGUW, I_SGUB, I_LRE, I_LIM, I_LOGDT, I_BRE, I_BIM, I_CRE, I_CIM,
       I_S5D, I_GLUW, I_GLUB, I_WOUT, I_W1, I_W2, I_FNG };

__device__ __forceinline__ int otid() { int t = threadIdx.x; asm volatile("" : "+v"(t)); return t; }
__device__ __forceinline__ int obid() { int t = blockIdx.x; asm volatile("" : "+s"(t)); return t; }
__device__ __forceinline__ u16 f2bf(float f) {
  unsigned u = __float_as_uint(f);
  u += 0x7fffu + ((u >> 16) & 1u);
  return (u16)(u >> 16);
}
__device__ __forceinline__ float bf2f(u16 h) { return __uint_as_float(((unsigned)h) << 16); }
__device__ __forceinline__ unsigned pack2(float a, float b) { return (unsigned)f2bf(a) | ((unsigned)f2bf(b) << 16); }

__device__ __forceinline__ float gelu_t(float x) {
  float y = 0.7978845608028654f * (x + 0.044715f * x * x * x);
  float t = __expf(2.f * y);
  float th = 1.f - 2.f / (t + 1.f);
  return 0.5f * x * (1.f + th);
}
__device__ __forceinline__ float sigmoid_f(float x) { return 1.f / (1.f + __expf(-x)); }
__device__ __forceinline__ float silu_f(float x) { return x / (1.f + __expf(-x)); }
__device__ __forceinline__ float softplus_f(float x) { return x > 20.f ? x : log1pf(expf(x)); }

__device__ __forceinline__ f32x4 mfma16(bf16x8 a, bf16x8 b, f32x4 c) {
  return __builtin_amdgcn_mfma_f32_16x16x32_bf16(a, b, c, 0, 0, 0);
}
__device__ __forceinline__ bf16x8 ld_frag(const u16* ptr) {
  return __builtin_bit_cast(bf16x8, *(const u32x4*)ptr);
}

__device__ __forceinline__ void mod_item(const P& p, int it, char* smem) {
  float* sc = (float*)smem;
  float* red = sc + 3072;
  const int tid = otid();
  const int l = it / 96, jb = it % 96;
  const int j0 = jb * 64;
  const int jq = tid & 15, kg = tid >> 4;
  for (int i = tid; i < 3072; i += 512) {
    const int m = i >> 10, k = i & 1023;
    sc[i] = silu_f(m == 0 ? p.in[I_CCTX][k] : p.in[I_C][(m - 1) * 1024 + k]);
  }
  __syncthreads();
  const float* aw = p.in[I_ADAW] + (size_t)l * 1024 * 6144 + (size_t)(kg * 32) * 6144 + j0 + jq * 4;
  float acc[3][4];
#pragma unroll
  for (int m = 0; m < 3; ++m)
#pragma unroll
    for (int j = 0; j < 4; ++j) acc[m][j] = 0.f;
#pragma unroll 1
  for (int k8 = 0; k8 < 4; ++k8) {
    f32x4 wv[8];
#pragma unroll
    for (int u = 0; u < 8; ++u) wv[u] = *(const f32x4*)(aw + (size_t)(k8 * 8 + u) * 6144);
#pragma unroll
    for (int u = 0; u < 8; ++u) {
      const int k = kg * 32 + k8 * 8 + u;
      const float c0 = sc[k], c1 = sc[1024 + k], c2 = sc[2048 + k];
#pragma unroll
      for (int j = 0; j < 4; ++j) {
        acc[0][j] += c0 * wv[u][j];
        acc[1][j] += c1 * wv[u][j];
        acc[2][j] += c2 * wv[u][j];
      }
    }
  }
#pragma unroll
  for (int m = 0; m < 3; ++m)
#pragma unroll
    for (int j = 0; j < 4; ++j) red[(kg * 3 + m) * 64 + jq * 4 + j] = acc[m][j];
  __syncthreads();
  if (tid < 192) {
    const int m = tid >> 6, j = tid & 63;
    float sv = p.in[I_ADAB][l * 6144 + j0 + j];
    for (int gq = 0; gq < 32; ++gq) sv += red[(gq * 3 + m) * 64 + j];
    float* mod = (float*)(p.ws + OFF_MOD);
    mod[(l * 3 + m) * 6144 + j0 + j] = sv;
  }
  __syncthreads();
}

__device__ __forceinline__ void transpose_tile(const float* src, int K, int N, u16* dst, int k0, int n0, char* smem) {
  float* tile = (float*)smem;
  const int tid = otid();
#pragma unroll
  for (int i = 0; i < 4; ++i) {
    int k = (tid >> 4) + 32 * i, n4 = tid & 15;
    int n = n0 + n4 * 4;
    f32x4 v = {0.f, 0.f, 0.f, 0.f};
    if (n < N) v = *(const f32x4*)(src + (size_t)(k0 + k) * N + n);
    float* d = tile + k * 65 + n4 * 4;
    d[0] = v[0]; d[1] = v[1]; d[2] = v[2]; d[3] = v[3];
  }
  __syncthreads();
#pragma unroll
  for (int i = 0; i < 2; ++i) {
    int slot = tid + i * 512;
    int n = slot >> 4, kg = slot & 15;
    u32x4 o;
#pragma unroll
    for (int j = 0; j < 4; ++j)
      o[j] = pack2(tile[(kg * 8 + 2 * j) * 65 + n], tile[(kg * 8 + 2 * j + 1) * 65 + n]);
    *(u32x4*)(dst + (size_t)(n0 + n) * K + k0 + kg * 8) = o;
  }
  __syncthreads();
}

struct TrDesc { const float* src; u16* dst; int K, N, k0, n0; };
__device__ __forceinline__ TrDesc tr_decode(const P& p, int it) {
  TrDesc d;
  int l = it / 1464, r = it % 1464, nt;
  if (r < 304) { d.src = p.in[I_WIN] + (size_t)l * 1024 * IN_DIM; d.dst = (u16*)(p.ws + OFF_WIN_T) + (size_t)l * IN_PAD * 1024; d.K = 1024; d.N = IN_DIM; nt = 38; }
  else if (r < 432) { r -= 304; d.src = p.in[I_WOUT] + (size_t)l * 1024 * 1024; d.dst = (u16*)(p.ws + OFF_WOUT_T) + (size_t)l * 1024 * 1024; d.K = 1024; d.N = 1024; nt = 16; }
  else if (r < 944) { r -= 432; d.src = p.in[I_W1] + (size_t)l * 1024 * 4096; d.dst = (u16*)(p.ws + OFF_W1_T) + (size_t)l * 4096 * 1024; d.K = 1024; d.N = 4096; nt = 64; }
  else if (r < 1456) { r -= 944; d.src = p.in[I_W2] + (size_t)l * 4096 * 1024; d.dst = (u16*)(p.ws + OFF_W2_T) + (size_t)l * 1024 * 4096; d.K = 4096; d.N = 1024; nt = 16; }
  else { r -= 1456; d.src = p.in[I_GLUW] + (size_t)l * 256 * 256; d.dst = (u16*)(p.ws + OFF_GLU_T) + (size_t)l * 256 * 256; d.K = 256; d.N = 256; nt = 4; }
  d.k0 = (r / nt) * 128; d.n0 = (r % nt) * 64;
  return d;
}
__device__ __forceinline__ void tr_load(const TrDesc& d, int tid, f32x4 (&v)[4]) {
#pragma unroll
  for (int i = 0; i < 4; ++i) {
    const int k = (tid >> 4) + 32 * i, n = d.n0 + (tid & 15) * 4;
    v[i] = (f32x4){0.f, 0.f, 0.f, 0.f};
    if (n < d.N) v[i] = *(const f32x4*)(d.src + (size_t)(d.k0 + k) * d.N + n);
  }
}
__device__ __forceinline__ void p0_transposes(const P& p, char* smem) {
  float* tile = (float*)smem;
  const int tid = otid(), nb = gridDim.x;
  int cur = obid();
  if (cur >= 2928) return;
  f32x4 v[4];
  TrDesc d = tr_decode(p, cur);
  tr_load(d, tid, v);
  while (cur < 2928) {
    __syncthreads();
#pragma unroll
    for (int i = 0; i < 4; ++i) {
      float* q = tile + ((tid >> 4) + 32 * i) * 65 + (tid & 15) * 4;
      q[0] = v[i][0]; q[1] = v[i][1]; q[2] = v[i][2]; q[3] = v[i][3];
    }
    __syncthreads();
    const int nxt = cur + nb;
    TrDesc dn = d;
    if (nxt < 2928) { dn = tr_decode(p, nxt); tr_load(dn, tid, v); }
#pragma unroll
    for (int i = 0; i < 2; ++i) {
      const int slot = tid + i * 512;
      const int n = slot >> 4, kg = slot & 15;
      u32x4 o;
#pragma unroll
      for (int j = 0; j < 4; ++j) o[j] = pack2(tile[(kg * 8 + 2 * j) * 65 + n], tile[(kg * 8 + 2 * j + 1) * 65 + n]);
      *(u32x4*)(d.dst + (size_t)(d.n0 + n) * d.K + d.k0 + kg * 8) = o;
    }
    d = dn; cur = nxt;
  }
  __syncthreads();
}
__device__ __forceinline__ void p0_sgu_item(const P& p, int it) {
  const float* src = p.in[I_SGUW] + (size_t)it * 8192;
  u16* dst = (u16*)(p.ws + OFF_SGUW) + (size_t)it * 8192;
  const int tid = otid();
#pragma unroll
  for (int i = 0; i < 2; ++i) {
    int e = (tid + i * 512) * 8;
    f32x4 a = *(const f32x4*)(src + e), b = *(const f32x4*)(src + e + 4);
    u32x4 o = {pack2(a[0], a[1]), pack2(a[2], a[3]), pack2(b[0], b[1]), pack2(b[2], b[3])};
    *(u32x4*)(dst + e) = o;
  }
}

__device__ __forceinline__ float shx(float v, int o, int lane) {
  return __int_as_float(__builtin_amdgcn_ds_bpermute((lane ^ o) << 2, __float_as_int(v)));
}
__device__ __forceinline__ float wave_sum(float v, int lane) {
#pragma unroll
  for (int o = 32; o > 0; o >>= 1) v += shx(v, o, lane);
  return v;
}

__device__ __forceinline__ void norm_phase(const P& p, int l, int mode, const float* xa, const float* xb) {
  const int tid = otid(), w = tid >> 6, lane = tid & 63;
  const float* mod = (const float*)(p.ws + OFF_MOD);
  u16* H = (u16*)(p.ws + OFF_H);
  const float* g = mode == 0 ? p.in[I_N1G] + l * 1024 : mode == 1 ? p.in[I_N2G] + l * 1024 : p.in[I_FNG];
  for (int row = obid() * 8 + w; row < T_TOK; row += gridDim.x * 8) {
    const float* x = row < 4096 ? xa + (size_t)row * 1024 : xb + (size_t)(row - 4096) * 1024;
    f32x4 v[4];
    float ss = 0.f;
#pragma unroll
    for (int i = 0; i < 4; ++i) {
      v[i] = *(const f32x4*)(x + i * 256 + lane * 4);
#pragma unroll
      for (int j = 0; j < 4; ++j) ss += v[i][j] * v[i][j];
    }
    ss = wave_sum(ss, lane);
    float rinv = rsqrtf(ss * (1.f / 1024.f) + 1e-6f);
    int m = row < 4096 ? 0 : 1 + ((row - 4096) >> 10);
    const float* mb = mod + (size_t)(l * 3 + m) * 6144 + (mode == 1 ? 3072 : 0);
#pragma unroll
    for (int i = 0; i < 4; ++i) {
      int c = i * 256 + lane * 4;
      f32x4 gg = *(const f32x4*)(g + c);
      if (mode == 2) {
        f32x4 o;
#pragma unroll
        for (int j = 0; j < 4; ++j) o[j] = v[i][j] * rinv * gg[j];
        *(f32x4*)(p.out + (size_t)row * 1024 + c) = o;
      } else {
        f32x4 sh = *(const f32x4*)(mb + c);
        f32x4 sc = *(const f32x4*)(mb + 1024 + c);
        float o[4];
#pragma unroll
        for (int j = 0; j < 4; ++j) o[j] = v[i][j] * rinv * gg[j] * (1.f + sc[j]) + sh[j];
        u32x2 pk = {pack2(o[0], o[1]), pack2(o[2], o[3])};
        *(u32x2*)(H + (size_t)row * 1024 + c) = pk;
      }
    }
  }
}

struct Epi {
  float* outf;
  u16* outb;
  const float* xa;
  const float* xb;
  const float* gate;
  const u16* y1;
  const float* bias;
};

template <int EPI, int K>
__device__ __forceinline__ void gemm_phase(const u16* A, const u16* Bt, int ntn, const Epi& e, char* smem, int bid, int nb) {
  constexpr int LS = 72;
  constexpr int nk = K >> 6;
  u16* sA = (u16*)smem;
  u16* sB = sA + 2 * 192 * LS;
  const int tid = otid(), w = tid >> 6, lane = tid & 63, quad = lane >> 4, l15 = lane & 15;
  const int wm = w >> 1, wn = w & 1;
  const int lrow = tid >> 3, lkc = tid & 7;
  const int ntiles = 32 * ntn;
  if (bid >= ntiles) return;
  const int total = ((ntiles - bid + nb - 1) / nb) * nk;
  u32x4 ra0[3], rb0[2], ra1[3], rb1[2];
  f32x4 acc[3][4];
#pragma unroll
  for (int i = 0; i < 3; ++i)
#pragma unroll
    for (int j = 0; j < 4; ++j) acc[i][j] = (f32x4){0.f, 0.f, 0.f, 0.f};
  auto issue = [&](u32x4 (&ra)[3], u32x4 (&rb)[2], int pos) {
    const int t = bid + (pos / nk) * nb, ks = pos % nk;
    const u16* ap = A + (size_t)((t & 31) * 192 + lrow) * K + lkc * 8 + ks * 64;
    const u16* bp = Bt + (size_t)((t >> 5) * 128 + lrow) * K + lkc * 8 + ks * 64;
#pragma unroll
    for (int i = 0; i < 3; ++i) ra[i] = *(const u32x4*)(ap + (size_t)i * 64 * K);
#pragma unroll
    for (int i = 0; i < 2; ++i) rb[i] = *(const u32x4*)(bp + (size_t)i * 64 * K);
  };
  auto stash = [&](u32x4 (&ra)[3], u32x4 (&rb)[2], int buf) {
#pragma unroll
    for (int i = 0; i < 3; ++i) *(u32x4*)(sA + buf * 192 * LS + (lrow + i * 64) * LS + lkc * 8) = ra[i];
#pragma unroll
    for (int i = 0; i < 2; ++i) *(u32x4*)(sB + buf * 128 * LS + (lrow + i * 64) * LS + lkc * 8) = rb[i];
  };
  auto body = [&](u32x4 (&ra)[3], u32x4 (&rb)[2], int pos) {
    if (pos + 1 < total) stash(ra, rb, (pos + 1) & 1);
    if (pos + 3 < total) issue(ra, rb, pos + 3);
    const int buf = pos & 1;
    const u16* cA = sA + buf * 192 * LS + (wm * 48 + l15) * LS + quad * 8;
    const u16* cB = sB + buf * 128 * LS + (wn * 64 + l15) * LS + quad * 8;
    {
      __builtin_amdgcn_iglp_opt(0);
      bf16x8 af[2][3], bq[2][4];
#pragma unroll
      for (int kk = 0; kk < 2; ++kk) {
#pragma unroll
        for (int i = 0; i < 3; ++i) af[kk][i] = ld_frag(cA + i * 16 * LS + kk * 32);
#pragma unroll
        for (int j = 0; j < 4; ++j) bq[kk][j] = ld_frag(cB + j * 16 * LS + kk * 32);
      }
      __builtin_amdgcn_s_setprio(1);
#pragma unroll
      for (int kk = 0; kk < 2; ++kk)
#pragma unroll
        for (int j = 0; j < 4; ++j)
#pragma unroll
          for (int i = 0; i < 3; ++i) acc[i][j] = mfma16(af[kk][i], bq[kk][j], acc[i][j]);
      __builtin_amdgcn_s_setprio(0);
    }
    if ((pos % nk) == nk - 1) {
      const int t = bid + (pos / nk) * nb;
      const int m0 = (t & 31) * 192, n0 = (t >> 5) * 128;
#pragma unroll
      for (int i = 0; i < 3; ++i)
#pragma unroll
        for (int j = 0; j < 4; ++j) {
#pragma unroll
          for (int r = 0; r < 4; ++r) {
            const int row = m0 + wm * 48 + i * 16 + quad * 4 + r;
            const int col = n0 + wn * 64 + j * 16 + l15;
            const float a = acc[i][j][r];
            if (EPI == 0) {
              if (col < IN_DIM) e.outf[(size_t)row * IN_DIM + col] = a;
            } else if (EPI == 1) {
              const float x = row < 4096 ? e.xa[(size_t)row * 1024 + col] : e.xb[(size_t)(row - 4096) * 1024 + col];
              const int m = row < 4096 ? 0 : 1 + ((row - 4096) >> 10);
              e.outf[(size_t)row * 1024 + col] = x + e.gate[m * 6144 + col] * a;
            } else if (EPI == 2) {
              const float rl = a > 0.f ? a : 0.f;
              e.outb[(size_t)row * DFF + col] = f2bf(rl * rl);
            } else {
              const float g = sigmoid_f(a + e.bias[col]);
              const float y = bf2f(e.y1[(size_t)row * 256 + col]);
              e.outb[(size_t)row * 1024 + 768 + col] = f2bf(y * g);
            }
          }
          acc[i][j] = (f32x4){0.f, 0.f, 0.f, 0.f};
        }
    }
    __syncthreads();
  };
  issue(ra0, rb0, 0);
  if (1 < total) issue(ra1, rb1, 1);
  stash(ra0, rb0, 0);
  if (2 < total) issue(ra0, rb0, 2);
  __syncthreads();
  for (int pos = 0; pos < total; pos += 2) {
    body(ra1, rb1, pos);
    if (pos + 1 < total) body(ra0, rb0, pos + 1);
  }
}

__device__ __forceinline__ void prep_conv(const P& p, int l, int ck, int s, char* smem) {
  float* tile = (float*)smem;
  const int tid = otid();
  const int row0 = ck * 128;
  int seq_lo, seq_hi;
  if (ck < 32) { seq_lo = (ck >> 1) * 256; seq_hi = seq_lo + 256; }
  else { seq_lo = 4096 + ((ck - 32) >> 3) * 1024; seq_hi = seq_lo + 1024; }
  const float* proj = (const float*)(p.ws + OFF_PROJ);
  const int c0 = s * 64;
  for (int id = tid; id < 132 * 16; id += 512) {
    int r = id >> 4, c4 = id & 15;
    int row = row0 - 2 + r;
    f32x4 v = {0.f, 0.f, 0.f, 0.f};
    if (row >= seq_lo && row < seq_hi) v = *(const f32x4*)(proj + (size_t)row * IN_DIM + 512 + c0 + c4 * 4);
    float* d = tile + r * 65 + c4 * 4;
    d[0] = v[0]; d[1] = v[1]; d[2] = v[2]; d[3] = v[3];
  }
  __syncthreads();
  const float* cw = p.in[I_CONVW] + (size_t)l * 5 * 1024;
  const float* cb = p.in[I_CONVB] + (size_t)l * 1024;
  if (s < 12) {
    u16* dstbase;
    if (s < 8) dstbase = (u16*)(p.ws + OFF_XST) + (size_t)(ck * 8 + s) * 64 * 128;
    else dstbase = (u16*)(p.ws + OFF_BMT) + ((size_t)(ck * 2 + ((s - 8) >> 1)) * 128 + ((s - 8) & 1) * 64) * 128;
#pragma unroll
    for (int it = 0; it < 2; ++it) {
      int slot = tid + it * 512;
      int pl = slot & 63, ig = slot >> 6;
      int c = c0 + pl;
      float w0 = cw[c], w1 = cw[1024 + c], w2 = cw[2048 + c], w3 = cw[3072 + c], w4 = cw[4096 + c], bb = cb[c];
      float o[8];
#pragma unroll
      for (int j = 0; j < 8; ++j) {
        int i = ig * 8 + j;
        float a = bb + tile[i * 65 + pl] * w0 + tile[(i + 1) * 65 + pl] * w1 + tile[(i + 2) * 65 + pl] * w2 +
                  tile[(i + 3) * 65 + pl] * w3 + tile[(i + 4) * 65 + pl] * w4;
        o[j] = silu_f(a);
      }
      u32x4 pk = {pack2(o[0], o[1]), pack2(o[2], o[3]), pack2(o[4], o[5]), pack2(o[6], o[7])};
      *(u32x4*)(dstbase + (size_t)pl * 128 + ig * 8) = pk;
    }
  }
  if (s >= 8) {
    u16* dstbase = s < 12 ? (u16*)(p.ws + OFF_BM) + (s - 8) * 64 : (u16*)(p.ws + OFF_CM) + (s - 12) * 64;
#pragma unroll
    for (int it = 0; it < 2; ++it) {
      int slot = tid + it * 512;
      int cg8 = slot & 7, i = slot >> 3;
      float o[8];
#pragma unroll
      for (int j = 0; j < 8; ++j) {
        int pl = cg8 * 8 + j;
        int c = c0 + pl;
        float a = cb[c] + tile[i * 65 + pl] * cw[c] + tile[(i + 1) * 65 + pl] * cw[1024 + c] +
                  tile[(i + 2) * 65 + pl] * cw[2048 + c] + tile[(i + 3) * 65 + pl] * cw[3072 + c] +
                  tile[(i + 4) * 65 + pl] * cw[4096 + c];
        o[j] = silu_f(a);
      }
      u32x4 pk = {pack2(o[0], o[1]), pack2(o[2], o[3]), pack2(o[4], o[5]), pack2(o[6], o[7])};
      *(u32x4*)(dstbase + (size_t)(row0 + i) * 256 + cg8 * 8) = pk;
    }
  }
  __syncthreads();
}

__device__ __forceinline__ void prep_dt(const P& p, int l, int ck, char* smem) {
  float* dts = (float*)smem;
  const int tid = otid();
  const float* proj = (const float*)(p.ws + OFF_PROJ);
  const int row0 = ck * 128;
#pragma unroll
  for (int it = 0; it < 4; ++it) {
    int i = (tid >> 4) + it * 32, col = tid & 15;
    float x = proj[(size_t)(row0 + i) * IN_DIM + 1536 + col] + p.in[I_DTB][l * 16 + col];
    dts[i * 16 + col] = softplus_f(x);
  }
  __syncthreads();
  if (tid < 16) {
    const int dir = tid >> 3, h = tid & 7;
    const float a = -expf(p.in[I_ALOG][l * 16 + tid]);
    float* DT = (float*)(p.ws + OFF_DT) + (size_t)((ck * 2 + dir) * 8 + h) * 128;
    float* CUM = (float*)(p.ws + OFF_CUM) + (size_t)((ck * 2 + dir) * 8 + h) * 128;
    float* WD = (float*)(p.ws + OFF_WDEC) + (size_t)((ck * 2 + dir) * 8 + h) * 128;
    float run = 0.f;
    if (dir == 0) {
      for (int i = 0; i < 128; ++i) { float d = dts[i * 16 + tid]; run += d * a; DT[i] = d; CUM[i] = run; dts[i * 16 + tid] = run; }
    } else {
      for (int i = 127; i >= 0; --i) { float d = dts[i * 16 + tid]; run += d * a; DT[i] = d; CUM[i] = run; dts[i * 16 + tid] = run; }
    }
    for (int i = 0; i < 128; ++i) WD[i] = DT[i] * __expf(run - dts[i * 16 + tid]);
  }
  __syncthreads();
}

__device__ __forceinline__ void prep_v(const P& p, int l, int ck, char* smem) {
  u16* tl = (u16*)smem;
  const int tid = otid(), w = tid >> 6, lane = tid & 63;
  const float* proj = (const float*)(p.ws + OFF_PROJ);
  const int row0 = ck * 128;
  const f32x4 g = *(const f32x4*)(p.in[I_SGUNG] + l * 256 + lane * 4);
  for (int rr = 0; rr < 16; ++rr) {
    int i = w * 16 + rr;
    f32x4 v = *(const f32x4*)(proj + (size_t)(row0 + i) * IN_DIM + 1552 + 256 + lane * 4);
    float ss = 0.f;
#pragma unroll
    for (int j = 0; j < 4; ++j) { v[j] = gelu_t(v[j]); ss += v[j] * v[j]; }
    ss = wave_sum(ss, lane);
    float rinv = rsqrtf(ss * (1.f / 256.f) + 1e-6f);
    u32x2 pk = {pack2(v[0] * rinv * g[0], v[1] * rinv * g[1]), pack2(v[2] * rinv * g[2], v[3] * rinv * g[3])};
    *(u32x2*)(tl + i * 264 + lane * 4) = pk;
  }
  __syncthreads();
  u16* VT = (u16*)(p.ws + OFF_VT) + (size_t)ck * 256 * 128;
#pragma unroll
  for (int it = 0; it < 8; ++it) {
    int c = tid & 255, ig = (tid >> 8) + 2 * it;
    u32x4 pk;
#pragma unroll
    for (int j = 0; j < 4; ++j)
      pk[j] = (unsigned)tl[(ig * 8 + 2 * j) * 264 + c] | ((unsigned)tl[(ig * 8 + 2 * j + 1) * 264 + c] << 16);
    *(u32x4*)(VT + (size_t)c * 128 + ig * 8) = pk;
  }
  __syncthreads();
}

template <int NT, bool PIPE>
__device__ __forceinline__ void ssd_state_chain(const P& p, int l, int sq, int h, int dir, int pt, int ntile0) {
  const int g = h >> 2;
  const bool lat = sq >= 16;
  const int nck = lat ? 8 : 2;
  const int ck0 = lat ? 32 + (sq - 16) * 8 : sq * 2;
  const int tid = otid(), w = tid >> 6, lane = tid & 63, quad = lane >> 4, l15 = lane & 15;
  const int lane_off = (pt * 16 + quad * 4) * 128 + ntile0 * 16 + l15;
  f32x4 acc[NT];
  if (lat) {
    const float* s0 = p.in[I_SSSD] + ((size_t)((((sq - 16) * 2 + l) * 2 + dir) * 8 + h) * 64) * 128;
#pragma unroll
    for (int nt = 0; nt < NT; ++nt)
#pragma unroll
      for (int r = 0; r < 4; ++r) acc[nt][r] = (s0 + lane_off)[r * 128 + nt * 16];
  } else {
#pragma unroll
    for (int nt = 0; nt < NT; ++nt) acc[nt] = (f32x4){0.f, 0.f, 0.f, 0.f};
  }
  const u16* XST = (const u16*)(p.ws + OFF_XST);
  const u16* BMT = (const u16*)(p.ws + OFF_BMT);
  u16* HPREV = (u16*)(p.ws + OFF_HPREV);
  u32x4 xr[4];
  f32x4 ww[4][2];
  bf16x8 bfr[4][NT];
  float cum_end = 0.f;
  auto issue = [&](int step) {
    const int ck = dir == 0 ? ck0 + step : ck0 + nck - 1 - step;
    const float* WD = (const float*)(p.ws + OFF_WDEC) + (size_t)((ck * 2 + dir) * 8 + h) * 128;
    const float* CUM = (const float*)(p.ws + OFF_CUM) + (size_t)((ck * 2 + dir) * 8 + h) * 128;
    cum_end = CUM[dir == 0 ? 127 : 0];
    const u16* xa = XST + ((size_t)(ck * 8 + h) * 64 + pt * 16 + l15) * 128;
    const u16* bb = BMT + ((size_t)(ck * 2 + g) * 128 + ntile0 * 16 + l15) * 128;
#pragma unroll
    for (int ks = 0; ks < 4; ++ks) {
      const int k0 = ks * 32 + quad * 8;
      xr[ks] = *(const u32x4*)(xa + k0);
      ww[ks][0] = *(const f32x4*)(WD + k0); ww[ks][1] = *(const f32x4*)(WD + k0 + 4);
#pragma unroll
      for (int nt = 0; nt < NT; ++nt) bfr[ks][nt] = ld_frag(bb + (size_t)nt * 16 * 128 + k0);
    }
  };
  if (PIPE) issue(0);
  for (int step = 0; step < nck; ++step) {
    const int ck = dir == 0 ? ck0 + step : ck0 + nck - 1 - step;
    u16* hp = HPREV + ((size_t)((ck * 2 + dir) * 8 + h) * 64) * 128;
    if (!PIPE) issue(step);
    const float decay = __expf(cum_end);
    bf16x8 af[4];
    bf16x8 bcur[4][NT];
#pragma unroll
    for (int ks = 0; ks < 4; ++ks) {
      u32x4 xs;
#pragma unroll
      for (int j = 0; j < 4; ++j) {
        float lo = __uint_as_float(xr[ks][j] << 16) * ww[ks][j >> 1][(j & 1) * 2];
        float hi = __uint_as_float(xr[ks][j] & 0xffff0000u) * ww[ks][j >> 1][(j & 1) * 2 + 1];
        xs[j] = pack2(lo, hi);
      }
      af[ks] = __builtin_bit_cast(bf16x8, xs);
#pragma unroll
      for (int nt = 0; nt < NT; ++nt) bcur[ks][nt] = bfr[ks][nt];
    }
    if (PIPE && step + 1 < nck) issue(step + 1);
#pragma unroll
    for (int nt = 0; nt < NT; ++nt)
#pragma unroll
      for (int r = 0; r < 4; ++r) (hp + lane_off)[r * 128 + nt * 16] = f2bf(acc[nt][r]);
#pragma unroll
    for (int nt = 0; nt < NT; ++nt)
#pragma unroll
      for (int r = 0; r < 4; ++r) acc[nt][r] *= decay;
#pragma unroll
    for (int ks = 0; ks < 4; ++ks)
#pragma unroll
      for (int nt = 0; nt < NT; ++nt) acc[nt] = mfma16(af[ks], bcur[ks][nt], acc[nt]);
  }
  if (!lat) {
    float* o = p.out + OUT_SSD + ((size_t)(((sq * 2 + l) * 2 + dir) * 8 + h) * 64) * 128;
#pragma unroll
    for (int nt = 0; nt < NT; ++nt)
#pragma unroll
      for (int r = 0; r < 4; ++r) (o + lane_off)[r * 128 + nt * 16] = acc[nt][r];
  }
}
__device__ __forceinline__ void ssd_state_item(const P& p, int l, int item) {
  const int w = otid() >> 6;
  if (item < 128) {
    const int idx = item >> 2, nq = item & 3;
    ssd_state_chain<1, false>(p, l, 16 + (idx >> 4), (idx & 15) >> 1, idx & 1, nq, w);
  } else {
    const int idx = item - 128;
    ssd_state_chain<4, false>(p, l, idx >> 4, (idx & 15) >> 1, idx & 1, w & 3, (w >> 2) * 4);
  }
}

__device__ __forceinline__ void s5_table_item(const P& p, int part) {
  const int tid = otid();
  for (int e = part * 512 + tid; e < 4096; e += 4096) {
    const float are = p.in[I_LRE][e], aim = p.in[I_LIM][e];
    const float step = expf(p.in[I_LOGDT][e >> 6]);
    const float er = expf(are * step), th = aim * step;
    const float lr = er * cosf(th), li = er * sinf(th);
    const float nr = lr - 1.f, ni = li;
    const float den = 1.f / (are * are + aim * aim);
    const float kr = (nr * are + ni * aim) * den, ki = (ni * are - nr * aim) * den;
    float pr = lr, pi = li;
#pragma unroll
    for (int k = 0; k < 5; ++k) { float a = pr * pr - pi * pi, b = 2.f * pr * pi; pr = a; pi = b; }
    f32x4* tab = (f32x4*)(p.ws + OFF_S5TAB) + (size_t)e * 2;
    tab[0] = (f32x4){lr, li, kr, ki};
    tab[1] = (f32x4){pr, pi, 0.f, 0.f};
    const int l = e >> 11, g = (e >> 6) & 15, n = e & 63;
    const float* Br = p.in[I_BRE] + ((size_t)(l * 16 + g) * 64 + n) * 16;
    const float* Bi = p.in[I_BIM] + ((size_t)(l * 16 + g) * 64 + n) * 16;
    u16* bb = (u16*)(p.ws + OFF_S5BB) + ((size_t)(e >> 6) * 128 + n * 2) * 16;
#pragma unroll
    for (int c4 = 0; c4 < 4; ++c4) {
      const f32x4 a = *(const f32x4*)(Br + c4 * 4), b = *(const f32x4*)(Bi + c4 * 4);
      u32x2 re = {pack2(kr * a[0] - ki * b[0], kr * a[1] - ki * b[1]), pack2(kr * a[2] - ki * b[2], kr * a[3] - ki * b[3])};
      u32x2 im = {pack2(kr * b[0] + ki * a[0], kr * b[1] + ki * a[1]), pack2(kr * b[2] + ki * a[2], kr * b[3] + ki * a[3])};
      *(u32x2*)(bb + c4 * 4) = re;
      *(u32x2*)(bb + 16 + c4 * 4) = im;
    }
  }
}
__device__ __forceinline__ void s5_sc_info(int sc, int& sq, int& j, int& nsc, int& sc0, int& row0) {
  if (sc < 128) { sq = sc >> 3; j = sc & 7; nsc = 8; sc0 = sq * 8; row0 = sq * 256; }
  else { int lb = (sc - 128) >> 5; sq = 16 + lb; j = (sc - 128) & 31; nsc = 32; sc0 = 128 + lb * 32; row0 = 4096 + lb * 1024; }
}
__device__ __forceinline__ int s5_row(bool lat, int row0, int s) { return lat ? row0 + (s & 15) * 64 + (s >> 4) : row0 + s; }

__device__ __forceinline__ void s5_load_u(const P& p, int sc, int gq, float* us) {
  int sq, j, nsc, sc0, row0;
  s5_sc_info(sc, sq, j, nsc, sc0, row0);
  const int tid = otid();
  const int gi = tid >> 7, i = (tid & 127) >> 2, c4 = tid & 3;
  const int row = s5_row(sq >= 16, row0, j * 32 + i);
  const float* proj = (const float*)(p.ws + OFF_PROJ);
  f32x4 v = *(const f32x4*)(proj + (size_t)row * IN_DIM + 2064 + (gq * 4 + gi) * 16 + c4 * 4);
  *(f32x4*)(us + (gi * 32 + i) * 16 + c4 * 4) = v;
}
__device__ __forceinline__ void s5_bu_mfma(const P& p, int l, int dir, int g, const float* us_g, float* hb, int lane) {
  const int quad = lane >> 4, l15 = lane & 15;
  bf16x8 af[2];
#pragma unroll
  for (int mt = 0; mt < 2; ++mt) {
    u32x4 pk = {0u, 0u, 0u, 0u};
    if (quad < 2) {
      const f32x4 a = *(const f32x4*)(us_g + (mt * 16 + l15) * 16 + quad * 8), b = *(const f32x4*)(us_g + (mt * 16 + l15) * 16 + quad * 8 + 4);
      pk = (u32x4){pack2(a[0], a[1]), pack2(a[2], a[3]), pack2(b[0], b[1]), pack2(b[2], b[3])};
    }
    af[mt] = __builtin_bit_cast(bf16x8, pk);
  }
  const u16* bb = (const u16*)(p.ws + OFF_S5BB) + ((size_t)((l * 2 + dir) * 16 + g) * 128 + l15) * 16 + (quad & 1) * 8;
#pragma unroll
  for (int nt = 0; nt < 8; ++nt) {
    u32x4 bv = *(const u32x4*)(bb + (size_t)nt * 16 * 16);
    if (quad >= 2) bv = (u32x4){0u, 0u, 0u, 0u};
    const bf16x8 bq = __builtin_bit_cast(bf16x8, bv);
#pragma unroll
    for (int mt = 0; mt < 2; ++mt) {
      f32x4 acc = {0.f, 0.f, 0.f, 0.f};
      acc = mfma16(af[mt], bq, acc);
#pragma unroll
      for (int r = 0; r < 4; ++r) hb[(mt * 16 + quad * 4 + r) * 132 + nt * 16 + l15] = acc[r];
    }
  }
}

__device__ __forceinline__ void s5_local_item(const P& p, int l, int item, char* smem) {
  float* us = (float*)smem;
  float* HB = (float*)(smem + 8192);
  const int sc = item >> 2, gq = item & 3;
  s5_load_u(p, sc, gq, us);
  __syncthreads();
  const int tid = otid(), w = tid >> 6, n = tid & 63;
  const int gi = w >> 1, dir = w & 1, g = gq * 4 + gi;
  float* hb = HB + (gi * 2 + dir) * 32 * 132;
  s5_bu_mfma(p, l, dir, g, us + gi * 32 * 16, hb, n);
  __syncthreads();
  const f32x4 t0 = *((const f32x4*)(p.ws + OFF_S5TAB) + (size_t)(((l * 2 + dir) * 16 + g) * 64 + n) * 2);
  const float lr = t0[0], li = t0[1];
  float hr = 0.f, hi = 0.f;
#pragma unroll 8
  for (int ii = 0; ii < 32; ++ii) {
    const int i = dir == 0 ? ii : 31 - ii;
    const float2 bu = *(const float2*)(hb + i * 132 + n * 2);
    const float a = lr * hr - li * hi + bu.x, b = lr * hi + li * hr + bu.y;
    hr = a; hi = b;
  }
  float* E = (float*)(p.ws + OFF_S5E);
  *(float2*)(E + ((size_t)((sc * 16 + g) * 2 + dir) * 64 + n) * 2) = make_float2(hr, hi);
  __syncthreads();
}

__device__ __forceinline__ void s5_out_item(const P& p, int l, int item, char* smem) {
  float* us = (float*)smem;
  float* HB = (float*)(smem + 8192);
  const int sc = item >> 2, gq = item & 3;
  int sq, j, nsc, sc0, row0;
  s5_sc_info(sc, sq, j, nsc, sc0, row0);
  const bool lat = sq >= 16;
  s5_load_u(p, sc, gq, us);
  __syncthreads();
  const int tid = otid(), w = tid >> 6, lane = tid & 63;
  {
    const int n = lane;
    const int gi = w >> 1, dir = w & 1, g = gq * 4 + gi;
    float* hb = HB + (gi * 2 + dir) * 32 * 132;
    s5_bu_mfma(p, l, dir, g, us + gi * 32 * 16, hb, lane);
    __syncthreads();
    const f32x4* tab = (const f32x4*)(p.ws + OFF_S5TAB) + (size_t)(((l * 2 + dir) * 16 + g) * 64 + n) * 2;
    const f32x4 t0 = tab[0], t1 = tab[1];
    const float lr = t0[0], li = t0[1], pr = t1[0], pi = t1[1];
    float hr = 0.f, hi = 0.f;
    if (lat) {
      const int si = ((((sq - 16) * 2 + l) * 2 + dir) * 16 + g) * 64 + n;
      hr = p.in[I_SS5R][si];
      hi = p.in[I_SS5I][si];
    }
    const float* E = (const float*)(p.ws + OFF_S5E);
    const int nprev = dir == 0 ? j : nsc - 1 - j;
    for (int jj0 = 0; jj0 < nprev; jj0 += 8) {
      float2 ev[8];
#pragma unroll
      for (int u = 0; u < 8; ++u) {
        const int jj = jj0 + u < nprev ? jj0 + u : nprev - 1;
        const int scp = dir == 0 ? sc0 + jj : sc0 + nsc - 1 - jj;
        ev[u] = *(const float2*)(E + ((size_t)((scp * 16 + g) * 2 + dir) * 64 + n) * 2);
      }
#pragma unroll
      for (int u = 0; u < 8; ++u) {
        if (jj0 + u < nprev) {
          const float a = pr * hr - pi * hi + ev[u].x, b = pr * hi + pi * hr + ev[u].y;
          hr = a; hi = b;
        }
      }
    }
#pragma unroll 8
    for (int ii = 0; ii < 32; ++ii) {
      const int i = dir == 0 ? ii : 31 - ii;
      float2* cell = (float2*)(hb + i * 132 + n * 2);
      const float2 bu = *cell;
      const float a = lr * hr - li * hi + bu.x, b = lr * hi + li * hr + bu.y;
      hr = a; hi = b;
      *cell = make_float2(hr, hi);
    }
    if (!lat && ((dir == 0 && j == nsc - 1) || (dir == 1 && j == 0))) {
      const int oi = (((sq * 2 + l) * 2 + dir) * 16 + g) * 64 + n;
      p.out[OUT_S5RE + oi] = hr;
      p.out[OUT_S5IM + oi] = hi;
    }
  }
  __syncthreads();
  {
    const int quad = lane >> 4, l15 = lane & 15;
    const int gi = w >> 1, mt = w & 1, g = gq * 4 + gi;
    const float* Cr = p.in[I_CRE] + ((size_t)(l * 16 + g) * 16 + l15) * 64;
    const float* Ci = p.in[I_CIM] + ((size_t)(l * 16 + g) * 16 + l15) * 64;
    bf16x8 bfr[4];
#pragma unroll
    for (int k4 = 0; k4 < 4; ++k4) {
      f32x4 cr = *(const f32x4*)(Cr + k4 * 16 + quad * 4), ci = *(const f32x4*)(Ci + k4 * 16 + quad * 4);
      u32x4 pk = {pack2(cr[0], -ci[0]), pack2(cr[1], -ci[1]), pack2(cr[2], -ci[2]), pack2(cr[3], -ci[3])};
      bfr[k4] = __builtin_bit_cast(bf16x8, pk);
    }
    f32x4 acc = {0.f, 0.f, 0.f, 0.f};
#pragma unroll
    for (int ks = 0; ks < 8; ++ks) {
      const float* ha = HB + ((gi * 2 + (ks >> 2)) * 32 + mt * 16 + l15) * 132 + (ks & 3) * 32 + quad * 8;
      const f32x4 h0 = *(const f32x4*)ha, h1 = *(const f32x4*)(ha + 4);
      u32x4 pk = {pack2(h0[0], h0[1]), pack2(h0[2], h0[3]), pack2(h1[0], h1[1]), pack2(h1[2], h1[3])};
      acc = mfma16(__builtin_bit_cast(bf16x8, pk), bfr[ks & 3], acc);
    }
    const float dsk = p.in[I_S5D][l * 256 + g * 16 + l15];
    u16* Y1B = (u16*)(p.ws + OFF_Y1B);
#pragma unroll
    for (int r = 0; r < 4; ++r) {
      const int i = mt * 16 + quad * 4 + r;
      const float y = acc[r] + dsk * us[(gi * 32 + i) * 16 + l15];
      const int row = s5_row(lat, row0, j * 32 + i);
      Y1B[(size_t)row * 256 + g * 16 + l15] = f2bf(gelu_t(y));
    }
  }
  __syncthreads();
}

__device__ __forceinline__ void sgu_item(const P& p, int l, int item) {
  const int ck = item >> 2, hd = item & 3;
  const int tid = otid(), w = tid >> 6, lane = tid & 63, quad = lane >> 4, l15 = lane & 15;
  const u16* W = (const u16*)(p.ws + OFF_SGUW) + ((size_t)(l * 4 + hd) * 128 + w * 16 + l15) * 128;
  const u16* VT = (const u16*)(p.ws + OFF_VT) + ((size_t)ck * 256 + hd * 64 + l15) * 128;
  f32x4 acc[4];
#pragma unroll
  for (int d = 0; d < 4; ++d) acc[d] = (f32x4){0.f, 0.f, 0.f, 0.f};
#pragma unroll
  for (int ks = 0; ks < 4; ++ks) {
    const int k0 = ks * 32 + quad * 8;
    bf16x8 af = ld_frag(W + k0);
#pragma unroll
    for (int d = 0; d < 4; ++d) acc[d] = mfma16(af, ld_frag(VT + (size_t)d * 16 * 128 + k0), acc[d]);
  }
  const float* proj = (const float*)(p.ws + OFF_PROJ);
  u16* MIX = (u16*)(p.ws + OFF_MIXED);
#pragma unroll
  for (int r = 0; r < 4; ++r) {
    const int q = w * 16 + quad * 4 + r;
    const float b = p.in[I_SGUB][(l * 4 + hd) * 128 + q];
    const size_t row = (size_t)ck * 128 + q;
#pragma unroll
    for (int d = 0; d < 4; ++d) {
      const int col = hd * 64 + d * 16 + l15;
      const float u = gelu_t(proj[row * IN_DIM + 1552 + col]);
      MIX[row * 1024 + 512 + col] = f2bf(u * (acc[d][r] + b));
    }
  }
}

__device__ __forceinline__ void ssd_out_item(const P& p, int l, int item, char* smem) {
  float* red = (float*)smem;
  const int ck = item >> 2, qb2 = item & 3;
  const int tid = otid(), h = tid >> 6, lane = tid & 63, quad = lane >> 4, l15 = lane & 15;
  const int g = h >> 2, q0 = qb2 * 32;
  const size_t row0 = (size_t)ck * 128;
  const u16* BM = (const u16*)(p.ws + OFF_BM);
  const u16* CM = (const u16*)(p.ws + OFF_CM);
  const float* DTf = (const float*)(p.ws + OFF_DT) + (size_t)((ck * 2 + 0) * 8 + h) * 128;
  const float* DTb = (const float*)(p.ws + OFF_DT) + (size_t)((ck * 2 + 1) * 8 + h) * 128;
  const float* CF = (const float*)(p.ws + OFF_CUM) + (size_t)((ck * 2 + 0) * 8 + h) * 128;
  const float* CB = (const float*)(p.ws + OFF_CUM) + (size_t)((ck * 2 + 1) * 8 + h) * 128;
  bf16x8 cmf[2][4];
#pragma unroll
  for (int t = 0; t < 2; ++t)
#pragma unroll
    for (int ns = 0; ns < 4; ++ns) cmf[t][ns] = ld_frag(CM + (row0 + q0 + t * 16 + l15) * 256 + g * 128 + ns * 32 + quad * 8);
  float cfq[2], cbq[2], dsum[2];
#pragma unroll
  for (int t = 0; t < 2; ++t) {
    const int q = q0 + t * 16 + l15;
    cfq[t] = CF[q]; cbq[t] = CB[q]; dsum[t] = DTf[q] + DTb[q];
  }
  const float Dh = p.in[I_SSDD][l * 8 + h];
  u32x4 As[2][4];
#pragma unroll
  for (int kt = 0; kt < 8; ++kt) {
    f32x4 aT[2] = {{0.f, 0.f, 0.f, 0.f}, {0.f, 0.f, 0.f, 0.f}};
#pragma unroll
    for (int ns = 0; ns < 4; ++ns) {
      const bf16x8 bmf = ld_frag(BM + (row0 + kt * 16 + l15) * 256 + g * 128 + ns * 32 + quad * 8);
      aT[0] = mfma16(bmf, cmf[0][ns], aT[0]);
      aT[1] = mfma16(bmf, cmf[1][ns], aT[1]);
    }
    const int kb = kt * 16 + quad * 4;
    f32x4 c = {0.f, 0.f, 0.f, 0.f}, d = c, c2 = c, d2 = c;
    if (kt <= qb2 * 2 + 1) { c = *(const f32x4*)(CF + kb); d = *(const f32x4*)(DTf + kb); }
    if (kt >= qb2 * 2) { c2 = *(const f32x4*)(CB + kb); d2 = *(const f32x4*)(DTb + kb); }
#pragma unroll
    for (int t = 0; t < 2; ++t) {
      const int qt = qb2 * 2 + t;
      const int q = q0 + t * 16 + l15;
      float m[4];
      if (kt < qt) {
#pragma unroll
        for (int r = 0; r < 4; ++r) m[r] = aT[t][r] * __expf(cfq[t] - c[r]) * d[r];
      } else if (kt > qt) {
#pragma unroll
        for (int r = 0; r < 4; ++r) m[r] = aT[t][r] * __expf(cbq[t] - c2[r]) * d2[r];
      } else {
#pragma unroll
        for (int r = 0; r < 4; ++r) {
          const int k = kb + r;
          float f;
          if (k < q) f = __expf(cfq[t] - c[r]) * d[r];
          else if (k > q) f = __expf(cbq[t] - c2[r]) * d2[r];
          else f = dsum[t];
          m[r] = aT[t][r] * f + (k == q ? Dh : 0.f);
        }
      }
      As[t][kt >> 1][(kt & 1) * 2 + 0] = pack2(m[0], m[1]);
      As[t][kt >> 1][(kt & 1) * 2 + 1] = pack2(m[2], m[3]);
    }
    if (kt & 1) asm volatile("" ::: "memory");
  }
  const u16* XST = (const u16*)(p.ws + OFF_XST) + ((size_t)(ck * 8 + h) * 64 + l15) * 128;
  const u16* HPf = (const u16*)(p.ws + OFF_HPREV) + ((size_t)((ck * 2 + 0) * 8 + h) * 64 + l15) * 128;
  const u16* HPb = (const u16*)(p.ws + OFF_HPREV) + ((size_t)((ck * 2 + 1) * 8 + h) * 64 + l15) * 128;
  const float* proj = (const float*)(p.ws + OFF_PROJ);
  float* ybuf = (float*)(smem + 1024) + (h * 32 + quad * 4) * 65 + l15;
  float ss[2][4] = {{0.f, 0.f, 0.f, 0.f}, {0.f, 0.f, 0.f, 0.f}};
#pragma unroll 1
  for (int pt = 0; pt < 4; ++pt) {
    f32x4 aY[2] = {{0.f, 0.f, 0.f, 0.f}, {0.f, 0.f, 0.f, 0.f}};
    f32x4 aF[2] = {{0.f, 0.f, 0.f, 0.f}, {0.f, 0.f, 0.f, 0.f}};
    f32x4 aB[2] = {{0.f, 0.f, 0.f, 0.f}, {0.f, 0.f, 0.f, 0.f}};
#pragma unroll
    for (int s2 = 0; s2 < 4; ++s2) {
      u32x2 lo = *(const u32x2*)(XST + (size_t)pt * 16 * 128 + (2 * s2) * 16 + quad * 4);
      u32x2 hi = *(const u32x2*)(XST + (size_t)pt * 16 * 128 + (2 * s2 + 1) * 16 + quad * 4);
      const bf16x8 bv = __builtin_bit_cast(bf16x8, (u32x4){lo[0], lo[1], hi[0], hi[1]});
      aY[0] = mfma16(__builtin_bit_cast(bf16x8, As[0][s2]), bv, aY[0]);
      aY[1] = mfma16(__builtin_bit_cast(bf16x8, As[1][s2]), bv, aY[1]);
    }
#pragma unroll
    for (int ns = 0; ns < 4; ++ns) {
      const bf16x8 hf = ld_frag(HPf + (size_t)pt * 16 * 128 + ns * 32 + quad * 8);
      const bf16x8 hb = ld_frag(HPb + (size_t)pt * 16 * 128 + ns * 32 + quad * 8);
      aF[0] = mfma16(cmf[0][ns], hf, aF[0]);
      aF[1] = mfma16(cmf[1][ns], hf, aF[1]);
      aB[0] = mfma16(cmf[0][ns], hb, aB[0]);
      aB[1] = mfma16(cmf[1][ns], hb, aB[1]);
    }
#pragma unroll
    for (int t = 0; t < 2; ++t)
#pragma unroll
      for (int r = 0; r < 4; ++r) {
        const int qq = q0 + t * 16 + quad * 4 + r;
        float yv = aY[t][r] + __expf(CF[qq]) * aF[t][r] + __expf(CB[qq]) * aB[t][r];
        const float zv = proj[(row0 + qq) * IN_DIM + h * 64 + pt * 16 + l15];
        yv *= silu_f(zv);
        ybuf[(t * 16 + r) * 65 + pt * 16] = yv;
        ss[t][r] += yv * yv;
      }
  }
  const int lane2 = otid() & 63;
#pragma unroll
  for (int t = 0; t < 2; ++t)
#pragma unroll
    for (int r = 0; r < 4; ++r) {
      float sv = ss[t][r];
#pragma unroll
      for (int o = 1; o < 16; o <<= 1) sv += shx(sv, o, lane2);
      ss[t][r] = sv;
    }
  if (l15 == 0) {
#pragma unroll
    for (int t = 0; t < 2; ++t)
#pragma unroll
      for (int r = 0; r < 4; ++r) red[(t * 16 + quad * 4 + r) * 8 + h] = ss[t][r];
  }
  __syncthreads();
  u16* MIX = (u16*)(p.ws + OFF_MIXED);
  const float* ng = p.in[I_SSDNG] + l * 512 + h * 64;
#pragma unroll
  for (int t = 0; t < 2; ++t)
#pragma unroll
    for (int r = 0; r < 4; ++r) {
      const int qq = q0 + t * 16 + quad * 4 + r;
      float tot = 0.f;
#pragma unroll
      for (int hh = 0; hh < 8; ++hh) tot += red[(t * 16 + quad * 4 + r) * 8 + hh];
      const float rinv = rsqrtf(tot * (1.f / 512.f) + 1e-6f);
#pragma unroll
      for (int pt = 0; pt < 4; ++pt) {
        const int pc = pt * 16 + l15;
        MIX[(row0 + qq) * 1024 + h * 64 + pc] = f2bf(ybuf[(t * 16 + r) * 65 + pt * 16] * rinv * ng[pc]);
      }
    }
  __syncthreads();
}

#define XB_TMO      128
#define XB_XCNT(j)  (256  + 64 * (j))
#define XB_XSUB(j)  (1280 + 64 * (j))
#define XB_XGEN(j)  (2304 + 64 * (j))
#define XB_TOP      3328
#define XB_TOPGEN   3392
#define XCD_BAR_WORDS 3456
#define XB_SPIN_CAP (1u << 18)
#define LAS __attribute__((address_space(3)))
__device__ __forceinline__ unsigned xb_ld(unsigned* p) { return __hip_atomic_load(p, __ATOMIC_RELAXED, __HIP_MEMORY_SCOPE_AGENT); }
__device__ __forceinline__ unsigned xb_add(unsigned* p, unsigned v) { return __hip_atomic_fetch_add(p, v, __ATOMIC_RELAXED, __HIP_MEMORY_SCOPE_AGENT); }
__device__ __forceinline__ unsigned xb_xcc_id() { return (unsigned)__builtin_amdgcn_s_getreg((3 << 11) | 20) & 0xFu; }
#define XB_SPIN(cond, bar) do { unsigned _sp = 0; while (cond) { __builtin_amdgcn_s_sleep(1); \
    if ((++_sp & 255u) == 0u) { if (xb_ld(&(bar)[XB_TMO])) break; if (_sp > XB_SPIN_CAP) { atomicAdd(&(bar)[XB_TMO], 1u); break; } } } } while (0)
struct XcdBarrier { unsigned* bar; unsigned x; volatile LAS unsigned* st; };
__device__ __forceinline__ XcdBarrier xcd_barrier_post(unsigned* bar, volatile LAS unsigned* st) {
  XcdBarrier b; b.bar = bar; b.x = xb_xcc_id(); b.st = st;
  if (threadIdx.x == 0) (void)xb_add(&bar[XB_XCNT(b.x)], 1u);
  return b;
}
__device__ __forceinline__ void xcd_barrier_complete(unsigned* bar, unsigned x, unsigned& nloc, unsigned& nx) {
  const unsigned G = gridDim.x * gridDim.y * gridDim.z;
  unsigned sum, cnt, mine, sp = 0u;
  for (;;) {
    sum = 0u; cnt = 0u; mine = 0u;
#pragma unroll
    for (unsigned j = 0; j < 16; ++j) { const unsigned c = xb_ld(&bar[XB_XCNT(j)]); sum += c; cnt += (c > 0u) ? 1u : 0u; mine = (j == x) ? c : mine; }
    if (sum == G) break;
    __builtin_amdgcn_s_sleep(1);
    if ((++sp & 255u) == 0u) { if (xb_ld(&bar[XB_TMO])) break; if (sp > XB_SPIN_CAP) { atomicAdd(&bar[XB_TMO], 1u); break; } }
  }
  nloc = mine > 0u ? mine : 1u; nx = cnt > 0u ? cnt : 1u;
}
__device__ __forceinline__ void xcd_barrier(const XcdBarrier& b) {
  asm volatile("s_waitcnt vmcnt(0)" ::: "memory");
  __syncthreads();
  if (threadIdx.x == 0) {
    unsigned* bar = b.bar;
    __builtin_amdgcn_s_waitcnt(0);
    unsigned nloc = b.st[0], nx = b.st[1];
    if (nloc == 0u) { xcd_barrier_complete(bar, b.x, nloc, nx); b.st[0] = nloc; b.st[1] = nx; }
    const unsigned old = xb_add(&bar[XB_XSUB(b.x)], 1u);
    const unsigned gen = old / nloc;
    if (old + 1u == (gen + 1u) * nloc) {
      __builtin_amdgcn_fence(__ATOMIC_RELEASE, "agent");
      asm volatile("s_waitcnt vmcnt(0)" ::: "memory");
      const unsigned og = xb_add(&bar[XB_TOP], 1u);
      const unsigned tg = og / nx;
      if (og + 1u == (tg + 1u) * nx) xb_add(&bar[XB_TOPGEN], 1u);
      else XB_SPIN(xb_ld(&bar[XB_TOPGEN]) == tg, bar);
      __builtin_amdgcn_fence(__ATOMIC_ACQUIRE, "agent");
      xb_add(&bar[XB_XGEN(b.x)], 1u);
      asm volatile("s_waitcnt vmcnt(0)" ::: "memory");
    } else {
      XB_SPIN(xb_ld(&bar[XB_XGEN(b.x)]) == gen, bar);
      __builtin_amdgcn_fence(__ATOMIC_ACQUIRE, "agent");
      asm volatile("s_waitcnt vmcnt(0)" ::: "memory");
    }
  }
  __syncthreads();
}

__device__ __forceinline__ int next_item(unsigned* ctr, int* slot) {
  __syncthreads();
  if (threadIdx.x == 0) *slot = (int)xb_add(ctr, 1u);
  __syncthreads();
  return *slot;
}

__device__ __forceinline__ void run_phase(const P& p, int ph, int rep, char* smem, int* qslot) {
  const int nb = gridDim.x, bid = obid();
  unsigned* qctr = (unsigned*)(p.ws + OFF_BAR) + 3520 + 16 * (ph * 2 + rep);
  if (ph == 0) {
    for (int it = bid; it < 192 + 16 + 8; it += nb) {
      if (it < 192) mod_item(p, it, smem);
      else if (it < 208) p0_sgu_item(p, it - 192);
      else s5_table_item(p, it - 208);
    }
    p0_transposes(p, smem);
    return;
  }
  if (ph == 21) {
    norm_phase(p, 0, 2, (const float*)(p.ws + OFF_XB), (const float*)(p.ws + OFF_XB) + (size_t)4096 * 1024);
    return;
  }
  const int l = (ph - 1) / 10, sp = (ph - 1) % 10;
  const float* x0a = l == 0 ? p.in[I_XP] : (const float*)(p.ws + OFF_XB);
  const float* x0b = l == 0 ? p.in[I_XS] : (const float*)(p.ws + OFF_XB) + (size_t)4096 * 1024;
  const float* x1a = (const float*)(p.ws + OFF_XA);
  const float* x1b = x1a + (size_t)4096 * 1024;
  const float* mod = (const float*)(p.ws + OFF_MOD) + (size_t)l * 3 * 6144;
  Epi e{};
  switch (sp) {
    case 0: norm_phase(p, l, 0, x0a, x0b); break;
    case 1:
      e.outf = (float*)(p.ws + OFF_PROJ);
      gemm_phase<0, 1024>((const u16*)(p.ws + OFF_H), (const u16*)(p.ws + OFF_WIN_T) + (size_t)l * IN_PAD * 1024, 19, e, smem, bid, nb);
      break;
    case 2: {
      constexpr int NB = 768 * ((DUP & 16) ? 2 : 1);
      for (int it = next_item(qctr, qslot); it < 864 + NB; it = next_item(qctr, qslot)) {
        if (it < 48) prep_v(p, l, it, smem);
        else if (it < 48 + NB) s5_local_item(p, l, (it - 48) % 768, smem);
        else if (it < 48 + NB + 768) { int k = it - 48 - NB; prep_conv(p, l, k >> 4, k & 15, smem); }
        else prep_dt(p, l, it - 816 - NB, smem);
      }
    } break;
    case 3: {
      constexpr int NA = 384 * ((DUP & 8) ? 2 : 1), NB = 768 * ((DUP & 2) ? 2 : 1), NC = 192 * ((DUP & 4) ? 2 : 1);
      for (int it = next_item(qctr, qslot); it < NA + NB + NC; it = next_item(qctr, qslot)) {
        if (it < NA) ssd_state_item(p, l, it % 384);
        else if (it < NA + NB) s5_out_item(p, l, (it - NA) % 768, smem);
        else sgu_item(p, l, (it - NA - NB) % 192);
      }
    } break;
    case 4: {
      constexpr int NA = 192 * ((DUP & 1) ? 2 : 1);
      Epi ge{};
      ge.outb = (u16*)(p.ws + OFF_MIXED);
      ge.y1 = (const u16*)(p.ws + OFF_Y1B);
      ge.bias = p.in[I_GLUB] + l * 256;
      {
        const int g0 = nb > 64 ? nb - 64 : 0;
        if (bid >= g0) gemm_phase<3, 256>((const u16*)(p.ws + OFF_Y1B), (const u16*)(p.ws + OFF_GLU_T) + (size_t)l * 256 * 256, 2, ge, smem, bid - g0, nb - g0);
      }
      for (int it = next_item(qctr, qslot); it < NA; it = next_item(qctr, qslot)) ssd_out_item(p, l, it % 192, smem);
    } break;
    case 5: break;
    case 6:
      e.outf = (float*)(p.ws + OFF_XA);
      e.xa = x0a; e.xb = x0b; e.gate = mod + 2048;
      gemm_phase<1, 1024>((const u16*)(p.ws + OFF_MIXED), (const u16*)(p.ws + OFF_WOUT_T) + (size_t)l * 1024 * 1024, 8, e, smem, bid, nb);
      break;
    case 7: norm_phase(p, l, 1, x1a, x1b); break;
    case 8:
      e.outb = (u16*)(p.ws + OFF_PROJ);
      gemm_phase<2, 1024>((const u16*)(p.ws + OFF_H), (const u16*)(p.ws + OFF_W1_T) + (size_t)l * 4096 * 1024, 32, e, smem, bid, nb);
      break;
    case 9:
      e.outf = (float*)(p.ws + OFF_XB);
      e.xa = x1a; e.xb = x1b; e.gate = mod + 5120;
      gemm_phase<1, 4096>((const u16*)(p.ws + OFF_PROJ), (const u16*)(p.ws + OFF_W2_T) + (size_t)l * 1024 * 4096, 8, e, smem, bid, nb);
      break;
  }
}

#ifndef REP_MASK
#define REP_MASK 0
#endif
__device__ __forceinline__ int phase_type(int ph) { return ph == 0 ? 10 : ph == 21 ? 11 : (ph - 1) % 10; }

__global__ void __launch_bounds__(512) mega(P p, int ph_lo, int ph_hi, int coop) {
  __shared__ __attribute__((aligned(16))) char smem[SMEM_BYTES];
  __shared__ __attribute__((aligned(16))) unsigned xb_words[4];
  XcdBarrier xb;
  if (coop) {
    if (threadIdx.x < 4) xb_words[threadIdx.x] = 0u;
    __syncthreads();
    xb = xcd_barrier_post((unsigned*)(p.ws + OFF_BAR), (volatile LAS unsigned*)xb_words);
  }
  for (int ph = ph_lo; ph < ph_hi; ++ph) {
    if (phase_type(ph) == 5) continue;
    const int reps = ((REP_MASK >> phase_type(ph)) & 1) ? 2 : 1;
    for (int r = 0; r < reps; ++r) run_phase(p, ph, r, smem, (int*)&xb_words[2]);
    if (coop == 1 && ph + 1 < ph_hi) xcd_barrier(xb);
    if (coop == 2) cg::this_grid().sync();
  }
}

extern "C" void kernel_launch(void* const* d_in, const int* in_sizes, int n_in, void* d_out, int out_size, void* d_ws,
                              size_t ws_size, hipStream_t stream) {
  static int grid_blocks = 0;
  if (!grid_blocks) {
    int dev = 0, cus = 0, per_cu = 0;
    hipGetDevice(&dev);
    hipDeviceGetAttribute(&cus, hipDeviceAttributeMultiprocessorCount, dev);
    hipOccupancyMaxActiveBlocksPerMultiprocessor(&per_cu, mega, 512, 0);
    if (per_cu < 1) per_cu = 1;
    grid_blocks = cus * per_cu;
  }
  P p{};
  for (int i = 0; i < 35; ++i) p.in[i] = (const float*)d_in[i];
  p.out = (float*)d_out;
  p.ws = (char*)d_ws;
  if (ws_size < WS_TOTAL) { fprintf(stderr, "workspace too small: %zu < %zu\n", ws_size, (size_t)WS_TOTAL); return; }
#if COOP
  hipMemsetAsync((char*)d_ws + OFF_BAR, 0, 65536, stream);
  int lo = 0, hi = 22, coop = 1;
  void* args[] = {&p, &lo, &hi, &coop};
  hipError_t err = hipLaunchCooperativeKernel((void*)mega, dim3(grid_blocks), dim3(512), args, 0, stream);
  if (err != hipSuccess) fprintf(stderr, "cooperative launch failed: %s (grid %d)\n", hipGetErrorString(err), grid_blocks);
#else
  for (int ph = 0; ph < 22; ++ph) mega<<<dim3(grid_blocks), dim3(512), 0, stream>>>(p, ph, ph + 1, 0);
#endif
}
```
